# Optimizing an MI355X kernel written in HIP

```python
import math
import jax, jax.numpy as jnp
from jax import lax
import numpy as np

D_MODEL = 4096
BATCH = 4
SEQ = 2048
DEPTH = 2
DEC_BATCH = 8
DEC_SEQ = 2048
PAST_LEN = 128

GRID_W = 64
HEAD_DIM = 128
NA_HEADS = 12
NA_ROWS = 8
NA_COLS = 16
SW_HEADS = 12
SW_KV_HEADS = 4
SW_WINDOW = 128
SW_BLOCK = 128
T5_BUCKETS = 32
T5_MAX_DIST = 128
MEM_TOKENS = 256
MEM_HEADS = 4
MEM_HEAD_DIM = 256
NA_WIDTH = NA_HEADS * HEAD_DIM
SW_WIDTH = SW_HEADS * HEAD_DIM
SW_KV_WIDTH = SW_KV_HEADS * HEAD_DIM
MEM_WIDTH = MEM_HEADS * MEM_HEAD_DIM
IN_SPLITS = (NA_WIDTH, NA_WIDTH, NA_WIDTH, NA_WIDTH,
             SW_WIDTH, SW_KV_WIDTH, SW_KV_WIDTH, SW_WIDTH,
             MEM_WIDTH, MEM_WIDTH,
             D_MODEL, D_MODEL, D_MODEL)
IN_WIDTH = sum(IN_SPLITS)
RMS_EPS = 1e-6
NEG_INF = -1e30

kernel_name = 'hybrid_natten_swa_memory_encoder'


def rms_norm(x, g):
    xf = x.astype(jnp.float32)
    y = xf * lax.rsqrt(jnp.mean(xf * xf, axis=-1, keepdims=True) + RMS_EPS)
    return (y * g.astype(jnp.float32)).astype(x.dtype)


def t5_buckets(rel):
    nb = T5_BUCKETS // 2
    max_exact = nb // 2
    ret = (rel > 0).astype(np.int32) * nb
    n = np.abs(rel)
    large = max_exact + (np.log(np.maximum(n, 1) / max_exact)
                         / np.log(T5_MAX_DIST / max_exact) * (nb - max_exact)).astype(np.int32)
    large = np.minimum(large, nb - 1)
    return (ret + np.where(n < max_exact, n, large)).astype(np.int32)


def neighborhood_attention(q, k, v, rpb):
    B, L, H, dh = q.shape
    R = L // GRID_W
    kr = min(NA_ROWS, R)
    ncb = GRID_W // NA_COLS
    qc = NA_COLS
    kw = 2 * NA_COLS
    qcol = np.arange(GRID_W).reshape(ncb, qc)
    cstart = np.clip(qcol - NA_COLS // 2, 0, GRID_W - NA_COLS)
    kstart = np.clip(np.arange(ncb) * qc - NA_COLS // 2, 0, GRID_W - kw)
    kcol = kstart[:, None] + np.arange(kw)
    col_mask = (kcol[:, None, :] >= cstart[:, :, None]) & (kcol[:, None, :] < cstart[:, :, None] + NA_COLS)
    dc_idx = np.clip(kcol[:, None, :] - qcol[:, :, None], -(NA_COLS - 1), NA_COLS - 1) + NA_COLS - 1
    scale = HEAD_DIM ** -0.5
    qg = (q * scale).reshape(B, R, ncb, qc, H, dh)
    kg = k.reshape(B, R, GRID_W, H, dh)[:, :, kcol]
    vg = v.reshape(B, R, GRID_W, H, dh)[:, :, kcol]
    mask = jnp.asarray(col_mask)[:, :, None, :]
    dc_j = jnp.asarray(dc_idx)[:, :, None, :]

    def row_step(args):
        q_r, r = args
        rs = jnp.clip(r - kr // 2, 0, R - kr)
        k_r = lax.dynamic_slice_in_dim(kg, rs, kr, axis=1)
        v_r = lax.dynamic_slice_in_dim(vg, rs, kr, axis=1)
        dr_idx = (rs + jnp.arange(kr) - r + NA_ROWS - 1)[None, None, :, None]
        bias = rpb[:, dr_idx, dc_j].astype(jnp.float32)
        s = jnp.einsum('bnqhd,bmnkhd->bhnqmk', q_r, k_r).astype(jnp.float32) + bias
        s = jnp.where(mask, s, NEG_INF)
        p = jax.nn.softmax(s.reshape(B, H, ncb, qc, kr * kw), axis=-1).reshape(s.shape).astype(v.dtype)
        return jnp.einsum('bhnqmk,bmnkhd->bnqhd', p, v_r)

    out = lax.map(row_step, (jnp.moveaxis(qg, 1, 0), jnp.arange(R)))
    return jnp.moveaxis(out, 0, 1).reshape(B, L, H * dh)


def window_attention(q, k, v, sink, t5_table):
    B, L, H, dh = q.shape
    G = H // SW_KV_HEADS
    nblk = L // SW_BLOCK
    qb = (q * HEAD_DIM ** -0.5).reshape(B, nblk, SW_BLOCK, SW_KV_HEADS, G, dh)
    pad = ((0, 0), (SW_BLOCK, SW_BLOCK), (0, 0), (0, 0))
    kp = jnp.pad(k, pad)
    vp = jnp.pad(v, pad)
    rel = np.arange(3 * SW_BLOCK)[None, :] - SW_BLOCK - np.arange(SW_BLOCK)[:, None]
    band = jnp.asarray(np.abs(rel) <= SW_WINDOW)
    bias = jnp.transpose(t5_table[jnp.asarray(t5_buckets(rel))], (2, 0, 1)).astype(jnp.float32)
    bias = bias.reshape(SW_KV_HEADS, G, SW_BLOCK, 3 * SW_BLOCK)
    sk = sink.astype(jnp.float32).reshape(SW_KV_HEADS, G)[None, :, :, None, None]

    def block_step(args):
        q_i, i = args
        k_i = lax.dynamic_slice_in_dim(kp, i * SW_BLOCK, 3 * SW_BLOCK, axis=1)
        v_i = lax.dynamic_slice_in_dim(vp, i * SW_BLOCK, 3 * SW_BLOCK, axis=1)
        kpos = i * SW_BLOCK - SW_BLOCK + jnp.arange(3 * SW_BLOCK)
        valid = band & ((kpos >= 0) & (kpos < L))[None, :]
        s = jnp.einsum('bqkgd,bmkd->bkgqm', q_i, k_i).astype(jnp.float32) + bias
        s = jnp.where(valid, s, NEG_INF)
        mx = jnp.maximum(jnp.max(s, axis=-1, keepdims=True), sk)
        e = jnp.exp(s - mx)
        p = (e / (jnp.sum(e, axis=-1, keepdims=True) + jnp.exp(sk - mx))).astype(v.dtype)
        return jnp.einsum('bkgqm,bmkd->bqkgd', p, v_i)

    out = lax.map(block_step, (jnp.moveaxis(qb, 1, 0), jnp.arange(nblk)))
    return jnp.moveaxis(out, 0, 1).reshape(B, L, H * dh)


def memory_attention(q, mem_h, w_kv):
    B, L = q.shape[0], q.shape[1]
    M = mem_h.shape[1]
    k, v = jnp.split(mem_h @ w_kv, 2, axis=-1)
    k = k.reshape(B, M, MEM_HEADS, MEM_HEAD_DIM)
    v = v.reshape(B, M, MEM_HEADS, MEM_HEAD_DIM)
    s = jnp.einsum('blhd,bmhd->bhlm', q * MEM_HEAD_DIM ** -0.5, k).astype(jnp.float32)
    p = jax.nn.softmax(s, axis=-1).astype(v.dtype)
    return jnp.einsum('bhlm,bmhd->blhd', p, v).reshape(B, L, MEM_WIDTH)


def trunk(x, mem, pre_norm, post_norm, mem_norm, w_in, w_mem_kv, w_branch_a, w_branch_b,
          w_branch_m, w_out, na_rpb, attn_sink, t5_bias):
    B, L, _ = x.shape
    split_points = [int(c) for c in np.cumsum(IN_SPLITS)[:-1]]
    for l in range(DEPTH):
        h = rms_norm(x, pre_norm[l])
        (qa, ka, va, za, qb, kb, vb, zb, qm, zm, ga, gb, gm) = jnp.split(h @ w_in[l], split_points, axis=-1)
        a = neighborhood_attention(qa.reshape(B, L, NA_HEADS, HEAD_DIM), ka.reshape(B, L, NA_HEADS, HEAD_DIM),
                                   va.reshape(B, L, NA_HEADS, HEAD_DIM), na_rpb[l]) * jax.nn.silu(za)
        b = window_attention(qb.reshape(B, L, SW_HEADS, HEAD_DIM), kb.reshape(B, L, SW_KV_HEADS, HEAD_DIM),
                             vb.reshape(B, L, SW_KV_HEADS, HEAD_DIM), attn_sink[l], t5_bias) * jax.nn.silu(zb)
        m = memory_attention(qm.reshape(B, L, MEM_HEADS, MEM_HEAD_DIM), rms_norm(mem, mem_norm[l]),
                             w_mem_kv[l]) * jax.nn.silu(zm)
        merged = (jax.nn.sigmoid(ga) * (a @ w_branch_a[l])
                  + jax.nn.sigmoid(gb) * (b @ w_branch_b[l])
                  + jax.nn.sigmoid(gm) * (m @ w_branch_m[l]))
        x = x + rms_norm(merged @ w_out[l], post_norm[l])
    return x


def setup_inputs(seed: int = 0) -> dict:
    key = jax.random.key(seed)
    ks = jax.random.split(key, 16)

    def nrm(k, shape, s):
        return jax.random.normal(k, shape, jnp.float32) * s

    return {
        'x_prompt': nrm(ks[0], (BATCH, SEQ, D_MODEL), 1.0),
        'x_sample': nrm(ks[1], (DEC_BATCH, DEC_SEQ, D_MODEL), 1.0),
        'mem_prompt': nrm(ks[2], (BATCH, MEM_TOKENS, D_MODEL), 1.0),
        'mem_sample': nrm(ks[3], (DEC_BATCH, MEM_TOKENS, D_MODEL), 1.0),
        'pre_norm': 1.0 + nrm(ks[4], (DEPTH, D_MODEL), 0.05),
        'post_norm': 1.0 + nrm(ks[5], (DEPTH, D_MODEL), 0.05),
        'mem_norm': 1.0 + nrm(ks[6], (DEPTH, D_MODEL), 0.05),
        'w_in': nrm(ks[7], (DEPTH, D_MODEL, IN_WIDTH), D_MODEL ** -0.5),
        'w_mem_kv': nrm(ks[8], (DEPTH, D_MODEL, 2 * MEM_WIDTH), D_MODEL ** -0.5),
        'w_branch_a': nrm(ks[9], (DEPTH, NA_WIDTH, D_MODEL), NA_WIDTH ** -0.5),
        'w_branch_b': nrm(ks[10], (DEPTH, SW_WIDTH, D_MODEL), SW_WIDTH ** -0.5),
        'w_branch_m': nrm(ks[11], (DEPTH, MEM_WIDTH, D_MODEL), MEM_WIDTH ** -0.5),
        'w_out': nrm(ks[12], (DEPTH, D_MODEL, D_MODEL), D_MODEL ** -0.5),
        'na_rpb': nrm(ks[13], (DEPTH, NA_HEADS, 2 * NA_ROWS - 1, 2 * NA_COLS - 1), 0.1),
        'attn_sink': nrm(ks[14], (DEPTH, SW_HEADS), 0.5),
        't5_bias': nrm(ks[15], (T5_BUCKETS, SW_HEADS), 0.1),
    }


def reference(x_prompt, x_sample, mem_prompt, mem_sample, pre_norm, post_norm, mem_norm, w_in, w_mem_kv,
              w_branch_a, w_branch_b, w_branch_m, w_out, na_rpb, attn_sink, t5_bias):
    y_prompt = trunk(x_prompt, mem_prompt, pre_norm, post_norm, mem_norm, w_in, w_mem_kv, w_branch_a,
                     w_branch_b, w_branch_m, w_out, na_rpb, attn_sink, t5_bias)
    y_sample = trunk(x_sample, mem_sample, pre_norm, post_norm, mem_norm, w_in, w_mem_kv, w_branch_a,
                     w_branch_b, w_branch_m, w_out, na_rpb, attn_sink, t5_bias)
    return (y_prompt, y_sample)
```

```cpp
#include <hip/hip_runtime.h>
#include <cstdio>
#include <cstdint>

#ifndef FLASH_NA
#define FLASH_NA 1
#endif
#ifndef FLASH_SW
#define FLASH_SW 1
#endif
#ifndef FLASH_MEM
#define FLASH_MEM 1
#endif
#ifndef PROBE_PHASE
#define PROBE_PHASE 0
#endif
#ifndef PROBE_REPS
#define PROBE_REPS 0
#endif
#ifndef GATE_U8
#define GATE_U8 1
#endif
#ifndef GATES_FP8
#define GATES_FP8 1
#endif
#ifndef WGM_IN
#define WGM_IN 4
#endif
#ifndef WGM_SM
#define WGM_SM 4
#endif
#ifndef MK_ONE_LAUNCH
#define MK_ONE_LAUNCH 1
#endif

#define LAS __attribute__((address_space(3)))
#define GAS __attribute__((address_space(1)))
typedef unsigned short bf16_t;
typedef short bf16x8 __attribute__((ext_vector_type(8)));
typedef float f32x4 __attribute__((ext_vector_type(4)));
typedef float f32x2 __attribute__((ext_vector_type(2)));
typedef unsigned u32x4 __attribute__((ext_vector_type(4)));
typedef unsigned u32x2 __attribute__((ext_vector_type(2)));

constexpr int DM = 4096, NSEQ = 12, SEQ = 2048, T = NSEQ * SEQ  , DEPTH = 2, TP = 4 * SEQ  ;
constexpr int INW = 24576;
constexpr int MEMT = 256, MROWS = NSEQ * MEMT;
constexpr int KVW = 2048;
constexpr int QA = 0, KA = 1536, VA = 3072, ZA = 4608, QB = 6144, KB = 7680, VB = 8192, ZB = 8704, QM = 10240, ZM = 11264, GA = 12288;
constexpr float RMS_EPS = 1e-6f;
constexpr float LOG2E = 1.4426950408889634f;

constexpr size_t MiB = 1u << 20;
constexpr size_t WS_CTL = 0, CTL_ZERO_BYTES = 64 * 1024;
constexpr size_t WS_WIN = 1 * MiB;
constexpr size_t WS_WKV = WS_WIN + 2 * 192 * MiB;
constexpr size_t WS_WCAT = WS_WKV + 2 * 16 * MiB;
constexpr size_t WS_WOUT = WS_WCAT + 2 * 32 * MiB;
constexpr size_t WS_H = WS_WOUT + 2 * 32 * MiB;
constexpr size_t WS_X = WS_H + 192 * MiB;
constexpr size_t WS_P = WS_X + 192 * MiB;
constexpr size_t WS_MEMH = WS_P + 1152 * MiB;
constexpr size_t WS_KVM = WS_MEMH + 24 * MiB;
constexpr size_t WS_RSQ = WS_KVM + 2 * 12 * MiB;
constexpr size_t WS_H8 = WS_RSQ + 6 * MiB;
constexpr size_t WS_W8 = WS_H8 + 96 * MiB;
constexpr size_t WS_END = WS_W8 + 2 * 48 * MiB;
constexpr size_t WS_KNA = WS_WIN + 96 * MiB, WS_KSW = WS_KNA + 72 * MiB;
constexpr size_t WS_VNA = WS_WIN + 192 * MiB + 96 * MiB, WS_VSW = WS_VNA + 72 * MiB;
constexpr float H8_SCALE = 8.f, W8_SCALE = 256.f, G8_DESCALE = 1.0f / (8.f * 256.f);
constexpr int NGATE = 3 * DM;
constexpr int CW_BAR = 4096;

constexpr int RING_BYTES = 131072;
constexpr int LDSCTL_OFF = RING_BYTES, MISC_OFF = LDSCTL_OFF + 320;
constexpr int LDS_BYTES = 163840;
constexpr int NWAVES = 8;

__device__ __forceinline__ int lane_id_hw() { int l; asm volatile("v_mbcnt_lo_u32_b32 %0, -1, 0\n\tv_mbcnt_hi_u32_b32 %0, -1, %0" : "=v"(l)); return l; }
typedef float f32x2_t_ __attribute__((ext_vector_type(2))); typedef __bf16 bf16x2_t_ __attribute__((ext_vector_type(2)));
__device__ __forceinline__ unsigned cvt_pk_bf16(float lo, float hi) { const f32x2_t_ v = {lo, hi}; const bf16x2_t_ b = __builtin_convertvector(v, bf16x2_t_); return __builtin_bit_cast(unsigned, b); }
__device__ __forceinline__ unsigned pk4_fp8(float a, float b, float c, float d) { int w = __builtin_amdgcn_cvt_pk_fp8_f32(a, b, 0, false); w = __builtin_amdgcn_cvt_pk_fp8_f32(c, d, w, true); return (unsigned)w; }
__device__ __forceinline__ float bf_lo(unsigned w) { return __uint_as_float(w << 16); }
__device__ __forceinline__ float bf_hi(unsigned w) { return __uint_as_float(w & 0xffff0000u); }
__device__ __forceinline__ float sigmoid_f(float x) { return __builtin_amdgcn_rcpf(1.0f + __builtin_amdgcn_exp2f(-x * LOG2E)); }
__device__ __forceinline__ unsigned gate_q8(float g) { return (unsigned)fmaxf(g * 255.0f + 0.5f, 1.0f); }
__device__ __forceinline__ unsigned gate_pk4(const f32x4& g) { return gate_q8(g[0]) | (gate_q8(g[1]) << 8) | (gate_q8(g[2]) << 16) | (gate_q8(g[3]) << 24); }
__device__ __forceinline__ float ub0(unsigned w) { return (float)(w & 0xffu); }
__device__ __forceinline__ float ub1(unsigned w) { return (float)((w >> 8) & 0xffu); }
__device__ __forceinline__ float ub2(unsigned w) { return (float)((w >> 16) & 0xffu); }
__device__ __forceinline__ float ub3(unsigned w) { return (float)(w >> 24); }
__device__ __forceinline__ void gate_ratio4(f32x4& v, unsigned n, unsigned d) {
    v[0] *= ub0(n) * __builtin_amdgcn_rcpf(ub0(d)); v[1] *= ub1(n) * __builtin_amdgcn_rcpf(ub1(d)); v[2] *= ub2(n) * __builtin_amdgcn_rcpf(ub2(d)); v[3] *= ub3(n) * __builtin_amdgcn_rcpf(ub3(d)); }
__device__ __forceinline__ void gate_mul4(f32x4& v, unsigned g) { const float s = 1.0f / 255.0f; v[0] *= ub0(g) * s; v[1] *= ub1(g) * s; v[2] *= ub2(g) * s; v[3] *= ub3(g) * s; }

namespace pg8 {
constexpr int BM = 256, BK = 64, HALF = 128, HTB = HALF * BK * 2, STAGE_BYTES = 8 * HTB, NXCD = 8, WGM = 8;
constexpr size_t KSTEP = (size_t)BK * 2;
constexpr size_t TSTEP16 = (size_t)256 * 4096 * 2, TSTEP8 = (size_t)256 * 4096;
typedef int i32x4 __attribute__((ext_vector_type(4)));
typedef int i32x8 __attribute__((ext_vector_type(8)));
__device__ __forceinline__ i32x8 cat8(bf16x8 lo, bf16x8 hi) { return __builtin_shufflevector(__builtin_bit_cast(i32x4, lo), __builtin_bit_cast(i32x4, hi), 0, 1, 2, 3, 4, 5, 6, 7); }
__host__ __device__ __forceinline__ int lds_byte(int r, int c) { const int st = (r >> 4) * 2 + (c >> 5), rr = r & 15, cc = c & 31, ob = rr * 64 + cc * 2; return st * 1024 + (ob ^ (((ob >> 9) & 1) << 5)); }
__host__ __device__ __forceinline__ void stage_rc(int b, int& R, int& C) { const int st = b / 1024, sb = b % 1024, swz = sb ^ (((sb >> 9) & 1) << 5); R = (st >> 1) * 16 + swz / 64; C = (st & 1) * 32 + (swz % 64) / 2; }
__host__ __device__ __forceinline__ int perm32(int rho) { const int n = rho >> 4, i = rho & 15; return 8 * (i >> 2) + 4 * n + (i & 3); }

struct GUnit { unsigned ao, bo; int nt, pm, pn, kind; };

template <int WGM_> __device__ __forceinline__ void tile_of(int L, int nM, int nN, int& pm, int& pn) {
    const int nwg = nM * nN; int wgid = L;
    { const int q = nwg / NXCD, r = nwg % NXCD, xcd = wgid % NXCD, off = wgid / NXCD; wgid = (xcd < r ? xcd * (q + 1) : r * (q + 1) + (xcd - r) * q) + off; }
    const int nig = WGM_ * nN, gid = wgid / nig, fm = gid * WGM_, gsz = (nM - fm) < WGM_ ? (nM - fm) : WGM_;
    pm = fm + ((wgid % nig) % gsz); pn = (wgid % nig) / gsz;
}

#ifndef PG8_SP2
#define PG8_SP2 true
#endif
template <class Epi, class Sched, int PITCH = 8192, bool F8 = false, bool SP2 = PG8_SP2>
__device__ __forceinline__ void gemm_phase(LAS unsigned char* lds, const char* wsb, const Sched& S, const Epi& E, int wave_s) {
    const int lane = lane_id_hw(), wid = wave_s, tid = wid * 64 + lane;
    const int wr = wid >> 2, wc = wid & 3, fr = lane & 15, fq = lane >> 4;
    unsigned voffA[2], voffB[2];
#pragma unroll
    for (int i = 0; i < 2; ++i) { int R, C; stage_rc(tid * 16 + i * 8192, R, C); const int Rb = (R & ~31) + perm32(R & 31);
        voffA[i] = (unsigned)(R * PITCH + C * 2); voffB[i] = (unsigned)(Rb * PITCH + C * 2); }
    const unsigned kstep = (unsigned)KSTEP, hstep = (unsigned)HALF * PITCH;
    const unsigned ldsw = (unsigned)wid * 1024u;
    const int aoff = lds_byte(wr * 64 + fr, fq * 8), boff = lds_byte(wc * 32 + fr, fq * 8);
#define PG8_SA(b, h) (((b) * 2 + (h)) * HTB)
#define PG8_SB(b, h) ((4 + (b) * 2 + (h)) * HTB)
#define PG8_STAGE(bufoff, gbase, voff) do { unsigned _g = (gbase); asm volatile("" : "+s"(_g));   _Pragma("unroll") for (int _i = 0; _i < 2; ++_i) \
        __builtin_amdgcn_global_load_lds((const unsigned*)(wsb + (size_t)(unsigned)(_g + (voff)[_i])), (LAS unsigned*)(lds + (bufoff) + ldsw + _i * 8192), 16, 0, 0); } while (0)
#define PG8_LDA(dst, b, h) do { if constexpr (F8) { _Pragma("unroll") for (int m = 0; m < 4; ++m) dst##8[m] = cat8(*(const LAS bf16x8*)(lds + PG8_SA(b, h) + aoff + m * 2048), *(const LAS bf16x8*)(lds + PG8_SA(b, h) + aoff + m * 2048 + 1024)); } \
      else { _Pragma("unroll") for (int m = 0; m < 4; ++m) _Pragma("unroll") for (int k = 0; k < 2; ++k) dst[m][k] = *(const LAS bf16x8*)(lds + PG8_SA(b, h) + aoff + m * 2048 + k * 1024); } } while (0)
#define PG8_LDB(dst, b, h) do { if constexpr (F8) { _Pragma("unroll") for (int n = 0; n < 2; ++n) dst##8[n] = cat8(*(const LAS bf16x8*)(lds + PG8_SB(b, h) + boff + n * 2048), *(const LAS bf16x8*)(lds + PG8_SB(b, h) + boff + n * 2048 + 1024)); } \
      else { _Pragma("unroll") for (int n = 0; n < 2; ++n) _Pragma("unroll") for (int k = 0; k < 2; ++k) dst[n][k] = *(const LAS bf16x8*)(lds + PG8_SB(b, h) + boff + n * 2048 + k * 1024); } } while (0)
#define PG8_MMA(ai, bj, At, Bt) do { __builtin_amdgcn_s_setprio(1); if constexpr (F8) { _Pragma("unroll") for (int m = 0; m < 4; ++m) _Pragma("unroll") for (int n = 0; n < 2; ++n) \
        acc[ai][bj][m][n] = __builtin_amdgcn_mfma_scale_f32_16x16x128_f8f6f4(Bt##8[n], At##8[m], acc[ai][bj][m][n], 0, 0, 0, 0, 0, 0); } \
      else { _Pragma("unroll") for (int m = 0; m < 4; ++m) _Pragma("unroll") for (int n = 0; n < 2; ++n) _Pragma("unroll") for (int k = 0; k < 2; ++k) \
        acc[ai][bj][m][n] = __builtin_amdgcn_mfma_f32_16x16x32_bf16(Bt[n][k], At[m][k], acc[ai][bj][m][n], 0, 0, 0); } __builtin_amdgcn_s_setprio(0); } while (0)
#define PG8_WAIT_V(n) asm volatile("s_waitcnt vmcnt(" #n ")" ::: "memory")
#define PG8_WAIT_L(n) asm volatile("s_waitcnt lgkmcnt(" #n ")" ::: "memory")
#define PG8_BAR __builtin_amdgcn_s_barrier()
#define PG8_SCHED __builtin_amdgcn_sched_barrier(0)
    GUnit cur, nxt; int ui = 0;
    if (!S.next(0, cur)) return;
    f32x4 acc[2][2][4][2];
#pragma unroll
    for (int a = 0; a < 2; ++a)
#pragma unroll
        for (int b = 0; b < 2; ++b)
#pragma unroll
            for (int m = 0; m < 4; ++m)
#pragma unroll
                for (int n = 0; n < 2; ++n) acc[a][b][m][n] = (f32x4){0.f, 0.f, 0.f, 0.f};
    bf16x8 At[4][2], B0[2][2], B1[2][2]; i32x8 At8[4], B08[2], B18[2];
    unsigned cA = cur.ao, cB = cur.bo;
    if constexpr (SP2) {
        PG8_STAGE(PG8_SB(0, 0), cB, voffB); PG8_STAGE(PG8_SB(0, 1), cB + hstep, voffB); PG8_STAGE(PG8_SA(0, 0), cA, voffA); PG8_STAGE(PG8_SA(0, 1), cA + hstep, voffA);
        if (wr == 1) PG8_BAR;
        PG8_WAIT_V(2); PG8_BAR;
        PG8_STAGE(PG8_SB(1, 0), cB + kstep, voffB); PG8_STAGE(PG8_SA(1, 0), cA + kstep, voffA); PG8_STAGE(PG8_SB(1, 1), cB + hstep + kstep, voffB);
        PG8_WAIT_V(6); PG8_BAR;
    } else {
    PG8_STAGE(PG8_SB(0, 0), cB, voffB); PG8_STAGE(PG8_SA(0, 0), cA, voffA); PG8_STAGE(PG8_SB(0, 1), cB + hstep, voffB); PG8_STAGE(PG8_SA(0, 1), cA + hstep, voffA);
    if (wr == 1) PG8_BAR;
    PG8_WAIT_V(4); PG8_BAR;
    PG8_STAGE(PG8_SB(1, 0), cB + kstep, voffB); PG8_STAGE(PG8_SA(1, 0), cA + kstep, voffA); PG8_STAGE(PG8_SB(1, 1), cB + hstep + kstep, voffB);
    PG8_WAIT_V(6); PG8_BAR;
    }
    for (;;) {
        const bool has_next = S.next(ui + 1, nxt);
        const unsigned nA = has_next ? nxt.ao : cA, nB = has_next ? nxt.bo : cB;
        const int nt = cur.nt;
        for (int t = 0; t < nt; t += 2) {
            if constexpr (Epi::HAS_MID) { if (t == Epi::MID0 || t == Epi::MID1) { const int l2 = lane_id_hw(); E.mid(acc, cur, t == Epi::MID0 ? 0 : 1, wr, wc, l2 & 15, l2 >> 4); } }
            const bool last = (t == nt - 2);
            const unsigned a1 = cA + (unsigned)(t + 1) * kstep;
            const unsigned a2 = last ? nA : cA + (unsigned)(t + 2) * kstep, b2 = last ? nB : cB + (unsigned)(t + 2) * kstep;
            const unsigned a3 = a2 + kstep, b3 = b2 + kstep;
            if constexpr (SP2) {
            PG8_LDB(B0, 0, 0); PG8_LDB(B1, 0, 1); PG8_SCHED; PG8_LDA(At, 0, 0); PG8_STAGE(PG8_SA(1, 1), a1 + hstep, voffA);
            PG8_WAIT_V(8); PG8_WAIT_L(0); PG8_BAR; PG8_MMA(0, 0, At, B0); PG8_MMA(0, 1, At, B1); PG8_BAR; PG8_SCHED;
            PG8_LDA(At, 0, 1); PG8_STAGE(PG8_SB(0, 0), b2, voffB); PG8_STAGE(PG8_SB(0, 1), b2 + hstep, voffB); PG8_STAGE(PG8_SA(0, 0), a2, voffA);
            PG8_WAIT_V(8); PG8_WAIT_L(0); PG8_BAR; PG8_MMA(1, 0, At, B0); PG8_MMA(1, 1, At, B1); PG8_BAR; PG8_SCHED;
            PG8_LDB(B0, 1, 0); PG8_LDB(B1, 1, 1); PG8_SCHED; PG8_LDA(At, 1, 0); PG8_STAGE(PG8_SA(0, 1), a2 + hstep, voffA);
            PG8_WAIT_V(8); PG8_WAIT_L(0); PG8_BAR; PG8_MMA(0, 0, At, B0); PG8_MMA(0, 1, At, B1); PG8_BAR; PG8_SCHED;
            PG8_LDA(At, 1, 1); PG8_STAGE(PG8_SB(1, 0), b3, voffB); PG8_STAGE(PG8_SB(1, 1), b3 + hstep, voffB); PG8_STAGE(PG8_SA(1, 0), a3, voffA);
            PG8_WAIT_V(8); PG8_WAIT_L(0); PG8_BAR; PG8_MMA(1, 0, At, B0); PG8_MMA(1, 1, At, B1); PG8_BAR; PG8_SCHED;
            } else {
            PG8_LDB(B0, 0, 0); PG8_SCHED; PG8_LDA(At, 0, 0); PG8_STAGE(PG8_SA(1, 1), a1 + hstep, voffA);
            PG8_WAIT_L(8); PG8_BAR; PG8_WAIT_L(0); PG8_MMA(0, 0, At, B0); PG8_BAR; PG8_SCHED;
            PG8_LDB(B1, 0, 1); PG8_STAGE(PG8_SB(0, 0), b2, voffB);
            PG8_BAR; PG8_WAIT_L(0); PG8_MMA(0, 1, At, B1); PG8_BAR;
            PG8_LDA(At, 0, 1); PG8_STAGE(PG8_SA(0, 0), a2, voffA);
            PG8_BAR; PG8_WAIT_L(0); PG8_MMA(1, 0, At, B0); PG8_BAR; PG8_SCHED;
            PG8_STAGE(PG8_SB(0, 1), b2 + hstep, voffB);
            PG8_WAIT_V(6); PG8_BAR; PG8_MMA(1, 1, At, B1); PG8_BAR;
            PG8_LDB(B0, 1, 0); PG8_SCHED; PG8_LDA(At, 1, 0); PG8_STAGE(PG8_SA(0, 1), a2 + hstep, voffA);
            PG8_WAIT_L(8); PG8_BAR; PG8_WAIT_L(0); PG8_MMA(0, 0, At, B0); PG8_BAR; PG8_SCHED;
            PG8_LDB(B1, 1, 1); PG8_STAGE(PG8_SB(1, 0), b3, voffB);
            PG8_BAR; PG8_WAIT_L(0); PG8_MMA(0, 1, At, B1); PG8_BAR;
            PG8_LDA(At, 1, 1); PG8_STAGE(PG8_SA(1, 0), a3, voffA);
            PG8_BAR; PG8_WAIT_L(0); PG8_MMA(1, 0, At, B0); PG8_BAR; PG8_SCHED;
            PG8_STAGE(PG8_SB(1, 1), b3 + hstep, voffB);
            PG8_WAIT_V(6); PG8_BAR; PG8_MMA(1, 1, At, B1); PG8_BAR;
            }
        }
        { const int l2 = lane_id_hw(); E(acc, cur, wr, wc, l2 & 15, l2 >> 4); }
        if (!has_next) break;
#pragma unroll
        for (int a = 0; a < 2; ++a)
#pragma unroll
            for (int b = 0; b < 2; ++b)
#pragma unroll
                for (int m = 0; m < 4; ++m)
#pragma unroll
                    for (int n = 0; n < 2; ++n) acc[a][b][m][n] = (f32x4){0.f, 0.f, 0.f, 0.f};
        cur = nxt; cA = nA; cB = nB; ++ui;
    }
    PG8_WAIT_V(0);
    if (wr == 0) PG8_BAR;
    PG8_BAR;
#undef PG8_SA
#undef PG8_SB
#undef PG8_STAGE
#undef PG8_LDA
#undef PG8_LDB
#undef PG8_MMA
#undef PG8_WAIT_V
#undef PG8_WAIT_L
#undef PG8_BAR
#undef PG8_SCHED
}
}

struct SchedIn {
    int G, c, nextra; unsigned A, B, memA, memB0, memB1;
    __device__ __forceinline__ bool next(int i, pg8::GUnit& u) const {
        int L = i * G + c;
        constexpr int NN = GATES_FP8 ? 48 : 96;
        if (L < 96 * NN) { int pm, pn; pg8::tile_of<WGM_IN>(L, 96, NN, pm, pn); u.ao = A + (unsigned)pm * (unsigned)pg8::TSTEP16; u.bo = B + (unsigned)pn * (unsigned)pg8::TSTEP16; u.nt = 64; u.pm = pm; u.pn = pn; u.kind = 0; return true; }
        L -= 96 * NN; if (L >= nextra) return false;
        const int le = L / 96, r = L % 96, pm = r % 12, pn = r / 12;
        u.ao = memA + (unsigned)pm * (unsigned)pg8::TSTEP16; u.bo = (le ? memB1 : memB0) + (unsigned)pn * (unsigned)pg8::TSTEP16; u.nt = 64; u.pm = pm; u.pn = pn; u.kind = 1 + le; return true;
    }
};
struct EpiIn {   static constexpr bool HAS_MID = false; static constexpr int MID0 = -1, MID1 = -1;
    bf16_t* P; bf16_t* KVM0; bf16_t* KVM1; bf16_t* wsb16;
    __device__ __forceinline__ void operator()(const f32x4 (&acc)[2][2][4][2], const pg8::GUnit& u, int wr, int wc, int fr, int fq) const {
        bf16_t* base; int ldc, mode = 0, bjs = 128; int rowb = u.pm * 256 + wr * 64 + fr, colb = u.pn * 256 + wc * 32 + 8 * fq;
        if (u.kind == 0) { base = P; ldc = INW; const int pn = u.pn; if (pn >= GA / 256) mode = 1; else if ((pn >= ZA / 256 && pn < QB / 256) || (pn >= ZB / 256 && pn < QM / 256) || (pn >= ZM / 256)) mode = 2;
            if (GATES_FP8) {
                int nh = 0, hp = 0; size_t off = 0;
                if (pn >= KA / 256 && pn < VA / 256) { nh = 12; hp = pn - KA / 256; off = WS_KNA; } else if (pn >= VA / 256 && pn < ZA / 256) { nh = 12; hp = pn - VA / 256; off = WS_VNA; }
                else if (pn >= KB / 256 && pn < VB / 256) { nh = 4; hp = pn - KB / 256; off = WS_KSW; } else if (pn >= VB / 256 && pn < ZB / 256) { nh = 4; hp = pn - VB / 256; off = WS_VSW; }
                if (nh) { const int b = u.pm >> 3; base = wsb16 + off / 2; ldc = 128; bjs = SEQ * 128; rowb = (b * nh + 2 * hp) * SEQ + (u.pm & 7) * 256 + wr * 64 + fr; colb = wc * 32 + 8 * fq; } } }
        else { base = (u.kind == 1) ? KVM0 : KVM1; ldc = KVW; }
#pragma unroll
        for (int ai = 0; ai < 2; ++ai)
#pragma unroll
            for (int m = 0; m < 4; ++m) { GAS bf16_t* rowp = (GAS bf16_t*)base + (size_t)(rowb + ai * 128 + m * 16) * ldc + colb;
#pragma unroll
                for (int bj = 0; bj < 2; ++bj) { f32x4 v0 = acc[ai][bj][m][0], v1 = acc[ai][bj][m][1];
                    if (mode == 1) {
#pragma unroll
                        for (int j = 0; j < 4; ++j) { v0[j] = sigmoid_f(v0[j]); v1[j] = sigmoid_f(v1[j]); } }
                    else if (mode == 2) {
#pragma unroll
                        for (int j = 0; j < 4; ++j) { v0[j] = v0[j] * sigmoid_f(v0[j]); v1[j] = v1[j] * sigmoid_f(v1[j]); } }
                    u32x4 w; w.x = cvt_pk_bf16(v0[0], v0[1]); w.y = cvt_pk_bf16(v0[2], v0[3]); w.z = cvt_pk_bf16(v1[0], v1[1]); w.w = cvt_pk_bf16(v1[2], v1[3]);
                    *(GAS u32x4*)(rowp + (size_t)bj * bjs) = w; } }
    }
};
struct SchedIn8 {
    int G, c; unsigned A, B;
    __device__ __forceinline__ bool next(int i, pg8::GUnit& u) const {
        const int L = i * G + c; if (L >= 96 * 48) return false;
        int pm, pn; pg8::tile_of<WGM_IN>(L, 96, 48, pm, pn);
        u.ao = A + (unsigned)pm * (unsigned)pg8::TSTEP8; u.bo = B + (unsigned)pn * (unsigned)pg8::TSTEP8; u.nt = 32; u.pm = pm; u.pn = pn; u.kind = 0; return true;
    }
};
struct EpiIn8 {   static constexpr bool HAS_MID = false; static constexpr int MID0 = -1, MID1 = -1;
    bf16_t* P;
    __device__ __forceinline__ void operator()(const f32x4 (&acc)[2][2][4][2], const pg8::GUnit& u, int wr, int wc, int fr, int fq) const {
#if GATE_U8
        GAS unsigned char* gb = (GAS unsigned char*)P + (size_t)(u.pm * 256 + (wr * 4 + wc) * 32 + fq) * (INW * 2) + (GA * 2 + u.pn * 256 + fr * 16);
#pragma unroll
        for (int ai = 0; ai < 2; ++ai)
#pragma unroll
            for (int m = 0; m < 4; ++m) { u32x4 w; unsigned wq[4];
#pragma unroll
                for (int bj = 0; bj < 2; ++bj)
#pragma unroll
                    for (int n = 0; n < 2; ++n) { f32x4 v = acc[ai][bj][m][n];
#pragma unroll
                        for (int j = 0; j < 4; ++j) v[j] = __builtin_amdgcn_rcpf(1.0f + __builtin_amdgcn_exp2f(v[j] * (-LOG2E * G8_DESCALE)));
                        wq[bj * 2 + n] = gate_pk4(v); }
                w.x = wq[0]; w.y = wq[1]; w.z = wq[2]; w.w = wq[3];
                *(GAS u32x4*)(gb + (size_t)((ai * 4 + m) * 4) * (INW * 2)) = w; }
#else
        const int row0 = u.pm * 256 + wr * 64 + fr, col0 = GA + u.pn * 256 + wc * 32 + 8 * fq;
#pragma unroll
        for (int ai = 0; ai < 2; ++ai)
#pragma unroll
            for (int m = 0; m < 4; ++m) { GAS bf16_t* rowp = (GAS bf16_t*)P + (size_t)(row0 + ai * 128 + m * 16) * INW + col0;
#pragma unroll
                for (int bj = 0; bj < 2; ++bj) { f32x4 v0 = acc[ai][bj][m][0], v1 = acc[ai][bj][m][1];
#pragma unroll
                    for (int j = 0; j < 4; ++j) { v0[j] = __builtin_amdgcn_rcpf(1.0f + __builtin_amdgcn_exp2f(v0[j] * (-LOG2E * G8_DESCALE))); v1[j] = __builtin_amdgcn_rcpf(1.0f + __builtin_amdgcn_exp2f(v1[j] * (-LOG2E * G8_DESCALE))); }
                    u32x4 w; w.x = cvt_pk_bf16(v0[0], v0[1]); w.y = cvt_pk_bf16(v0[2], v0[3]); w.z = cvt_pk_bf16(v1[0], v1[1]); w.w = cvt_pk_bf16(v1[2], v1[3]);
                    *(GAS u32x4*)(rowp + bj * 128) = w; } }
#endif
    }
};
struct SchedBr {
    int G, c; unsigned A, B;
    __device__ __forceinline__ bool next(int i, pg8::GUnit& u) const {
        const int L = i * G + c; if (L >= 96 * 16) return false;
        int pm, pn; pg8::tile_of<WGM_SM>(L, 96, 16, pm, pn);
        u.ao = A + (unsigned)pm * (unsigned)pg8::TSTEP16; u.bo = B + (unsigned)pn * (unsigned)pg8::TSTEP16; u.nt = 64; u.pm = pm; u.pn = pn; u.kind = 0; return true;
    }
};
struct EpiBr {
    static constexpr bool HAS_MID = true; static constexpr int MID0 = 24, MID1 = 48;
    const bf16_t* P; bf16_t* Mg;
    __device__ __forceinline__ void mid(f32x4 (&acc)[2][2][4][2], const pg8::GUnit& u, int b, int wr, int wc, int fr, int fq) const {
#if GATE_U8
        const GAS unsigned char* gp = (const GAS unsigned char*)P + (size_t)(u.pm * 256 + (wr * 4 + wc) * 32 + fq) * (INW * 2) + (GA * 2 + (b * 16 + u.pn) * 256 + fr * 16);
        u32x4 gn[8], gd[8];
#pragma unroll
        for (int k = 0; k < 8; ++k) { const GAS unsigned char* q = gp + (size_t)(k * 4) * (INW * 2); gn[k] = *(const GAS u32x4*)q; gd[k] = *(const GAS u32x4*)(q + DM); }
#pragma unroll
        for (int k = 0; k < 8; ++k) { const int ai = k >> 2, m = k & 3;
            gate_ratio4(acc[ai][0][m][0], gn[k].x, gd[k].x); gate_ratio4(acc[ai][0][m][1], gn[k].y, gd[k].y); gate_ratio4(acc[ai][1][m][0], gn[k].z, gd[k].z); gate_ratio4(acc[ai][1][m][1], gn[k].w, gd[k].w); }
#else
        const int row0 = u.pm * 256 + wr * 64 + fr, col0 = u.pn * 256 + wc * 32 + 8 * fq;
        const GAS bf16_t* gp = (const GAS bf16_t*)P + (size_t)row0 * INW + GA + b * DM + col0;
#pragma unroll
        for (int ai = 0; ai < 2; ++ai) {
            u32x4 gn[4][2], gd[4][2];
#pragma unroll
            for (int m = 0; m < 4; ++m)
#pragma unroll
                for (int bj = 0; bj < 2; ++bj) { const GAS bf16_t* q = gp + (size_t)(ai * 128 + m * 16) * INW + bj * 128; gn[m][bj] = *(const GAS u32x4*)q; gd[m][bj] = *(const GAS u32x4*)(q + DM); }
#pragma unroll
            for (int m = 0; m < 4; ++m)
#pragma unroll
                for (int bj = 0; bj < 2; ++bj) { const u32x4 n4 = gn[m][bj], d4 = gd[m][bj];
                    f32x4& v0 = acc[ai][bj][m][0]; f32x4& v1 = acc[ai][bj][m][1];
                    v0[0] *= bf_lo(n4.x) * __builtin_amdgcn_rcpf(fmaxf(bf_lo(d4.x), 1e-30f)); v0[1] *= bf_hi(n4.x) * __builtin_amdgcn_rcpf(fmaxf(bf_hi(d4.x), 1e-30f));
                    v0[2] *= bf_lo(n4.y) * __builtin_amdgcn_rcpf(fmaxf(bf_lo(d4.y), 1e-30f)); v0[3] *= bf_hi(n4.y) * __builtin_amdgcn_rcpf(fmaxf(bf_hi(d4.y), 1e-30f));
                    v1[0] *= bf_lo(n4.z) * __builtin_amdgcn_rcpf(fmaxf(bf_lo(d4.z), 1e-30f)); v1[1] *= bf_hi(n4.z) * __builtin_amdgcn_rcpf(fmaxf(bf_hi(d4.z), 1e-30f));
                    v1[2] *= bf_lo(n4.w) * __builtin_amdgcn_rcpf(fmaxf(bf_lo(d4.w), 1e-30f)); v1[3] *= bf_hi(n4.w) * __builtin_amdgcn_rcpf(fmaxf(bf_hi(d4.w), 1e-30f)); }
        }
#endif
    }
    __device__ __forceinline__ void operator()(const f32x4 (&acc)[2][2][4][2], const pg8::GUnit& u, int wr, int wc, int fr, int fq) const {
        const int row0 = u.pm * 256 + wr * 64 + fr, col0 = u.pn * 256 + wc * 32 + 8 * fq;
        GAS bf16_t* mp0 = (GAS bf16_t*)Mg + (size_t)row0 * DM + col0;
#if GATE_U8
        const GAS unsigned char* gp = (const GAS unsigned char*)P + (size_t)(u.pm * 256 + (wr * 4 + wc) * 32 + fq) * (INW * 2) + (GA * 2 + (2 * 16 + u.pn) * 256 + fr * 16);
        u32x4 g[8];
#pragma unroll
        for (int k = 0; k < 8; ++k) g[k] = *(const GAS u32x4*)(gp + (size_t)(k * 4) * (INW * 2));
#pragma unroll
        for (int k = 0; k < 8; ++k) { const int ai = k >> 2, m = k & 3;
#pragma unroll
            for (int bj = 0; bj < 2; ++bj) { f32x4 v0 = acc[ai][bj][m][0], v1 = acc[ai][bj][m][1];
                gate_mul4(v0, bj ? g[k].z : g[k].x); gate_mul4(v1, bj ? g[k].w : g[k].y);
                u32x4 w; w.x = cvt_pk_bf16(v0[0], v0[1]); w.y = cvt_pk_bf16(v0[2], v0[3]); w.z = cvt_pk_bf16(v1[0], v1[1]); w.w = cvt_pk_bf16(v1[2], v1[3]);
                *(GAS u32x4*)(mp0 + (size_t)(ai * 128 + m * 16) * DM + bj * 128) = w; } }
#else
        const GAS bf16_t* gp = (const GAS bf16_t*)P + (size_t)row0 * INW + GA + 2 * DM + col0;
#pragma unroll
        for (int ai = 0; ai < 2; ++ai) {
            u32x4 g[4][2];
#pragma unroll
            for (int m = 0; m < 4; ++m)
#pragma unroll
                for (int bj = 0; bj < 2; ++bj) g[m][bj] = *(const GAS u32x4*)(gp + (size_t)(ai * 128 + m * 16) * INW + bj * 128);
#pragma unroll
            for (int m = 0; m < 4; ++m)
#pragma unroll
                for (int bj = 0; bj < 2; ++bj) { const u32x4 gg = g[m][bj];
                    f32x4 v0 = acc[ai][bj][m][0], v1 = acc[ai][bj][m][1];
                    v0[0] *= bf_lo(gg.x); v0[1] *= bf_hi(gg.x); v0[2] *= bf_lo(gg.y); v0[3] *= bf_hi(gg.y); v1[0] *= bf_lo(gg.z); v1[1] *= bf_hi(gg.z); v1[2] *= bf_lo(gg.w); v1[3] *= bf_hi(gg.w);
                    u32x4 w; w.x = cvt_pk_bf16(v0[0], v0[1]); w.y = cvt_pk_bf16(v0[2], v0[3]); w.z = cvt_pk_bf16(v1[0], v1[1]); w.w = cvt_pk_bf16(v1[2], v1[3]);
                    *(GAS u32x4*)(mp0 + (size_t)(ai * 128 + m * 16) * DM + bj * 128) = w; }
        }
#endif
    }
};
struct SchedOut {
    int G, c; unsigned A, B;
    __device__ __forceinline__ bool next(int i, pg8::GUnit& u) const {
        const int L = i * G + c; if (L >= 96 * 16) return false;
        int pm, pn; pg8::tile_of<WGM_SM>(L, 96, 16, pm, pn);
        u.ao = A + (unsigned)pm * (unsigned)pg8::TSTEP16; u.bo = B + (unsigned)pn * (unsigned)pg8::TSTEP16; u.nt = 64; u.pm = pm; u.pn = pn; u.kind = 0; return true;
    }
};
struct EpiOut {  static constexpr bool HAS_MID = false; static constexpr int MID0 = -1, MID1 = -1;
    bf16_t* O; float* RSQ;
    __device__ __forceinline__ void operator()(const f32x4 (&acc)[2][2][4][2], const pg8::GUnit& u, int wr, int wc, int fr, int fq) const {
        const int row0 = u.pm * 256 + wr * 64 + fr, col0 = u.pn * 256 + wc * 32 + 8 * fq;
#pragma unroll
        for (int ai = 0; ai < 2; ++ai)
#pragma unroll
            for (int m = 0; m < 4; ++m) { const size_t row = (size_t)(row0 + ai * 128 + m * 16); float s = 0.f;
#pragma unroll
                for (int bj = 0; bj < 2; ++bj) { const f32x4 v0 = acc[ai][bj][m][0], v1 = acc[ai][bj][m][1];
                    s += (v0[0] * v0[0] + v0[1] * v0[1]) + (v0[2] * v0[2] + v0[3] * v0[3]) + (v1[0] * v1[0] + v1[1] * v1[1]) + (v1[2] * v1[2] + v1[3] * v1[3]);
                    u32x4 w; w.x = cvt_pk_bf16(v0[0], v0[1]); w.y = cvt_pk_bf16(v0[2], v0[3]); w.z = cvt_pk_bf16(v1[0], v1[1]); w.w = cvt_pk_bf16(v1[2], v1[3]);
                    *(GAS u32x4*)((GAS bf16_t*)O + row * DM + col0 + bj * 128) = w; }
                { const int ln = fr + 16 * fq; s += __int_as_float(__builtin_amdgcn_ds_bpermute((ln ^ 16) << 2, __float_as_int(s))); s += __int_as_float(__builtin_amdgcn_ds_bpermute((ln ^ 32) << 2, __float_as_int(s))); }
                if (fq == 0) ((GAS float*)RSQ)[row * 64 + u.pn * 4 + wc] = s; }
    }
};

static_assert(!GATE_U8 || GATES_FP8, "GATE_U8 lives in the fp8 gate GEMM epilogue");
#define XB_TMO      128
#define XB_XCNT(j)  (256  + 64 * (j))
#define XB_XSUB(j)  (1280 + 64 * (j))
#define XB_XGEN(j)  (2304 + 64 * (j))
#define XB_TOP      3328
#define XB_TOPGEN   3392
#define XCD_BAR_WORDS 3456
#define XB_SPIN_CAP (1u << 18)
__device__ __forceinline__ unsigned xb_ld(unsigned* p)              { return __hip_atomic_load(p, __ATOMIC_RELAXED, __HIP_MEMORY_SCOPE_AGENT); }
__device__ __forceinline__ unsigned xb_add(unsigned* p, unsigned v) { return __hip_atomic_fetch_add(p, v, __ATOMIC_RELAXED, __HIP_MEMORY_SCOPE_AGENT); }
__device__ __forceinline__ unsigned xb_xcc_id() { return (unsigned)__builtin_amdgcn_s_getreg((3 << 11) | 20) & 0xFu; }
#define XB_SPIN(cond, bar) do { unsigned _sp = 0; while (cond) { __builtin_amdgcn_s_sleep(1); \
    if ((++_sp & 255u) == 0u) { if (xb_ld(&(bar)[XB_TMO])) break; if (_sp > XB_SPIN_CAP) { atomicAdd(&(bar)[XB_TMO], 1u); break; } } } } while (0)
struct XcdBarrier { unsigned* bar; unsigned x; volatile LAS unsigned* st; };
__device__ __forceinline__ XcdBarrier xcd_barrier_post(unsigned* bar, volatile LAS unsigned* st, bool leader) {
    XcdBarrier b; b.bar = bar; b.x = xb_xcc_id(); b.st = st;
    if (leader) (void)xb_add(&bar[XB_XCNT(b.x)], 1u);
    return b;
}
__device__ __forceinline__ void xcd_barrier_complete(unsigned* bar, unsigned x, unsigned& nloc, unsigned& nx) {
    const unsigned G = gridDim.x * gridDim.y * gridDim.z;
    unsigned sum, cnt, mine, sp = 0u;
    for (;;) {
        sum = 0u; cnt = 0u; mine = 0u;
#pragma unroll
        for (unsigned j = 0; j < 16; ++j) { const unsigned c = xb_ld(&bar[XB_XCNT(j)]); sum += c; cnt += (c > 0u) ? 1u : 0u; mine = (j == x) ? c : mine; }
        if (sum == G) break;
        __builtin_amdgcn_s_sleep(1);
        if ((++sp & 255u) == 0u) { if (xb_ld(&bar[XB_TMO])) break; if (sp > XB_SPIN_CAP) { atomicAdd(&bar[XB_TMO], 1u); break; } }
    }
    nloc = mine > 0u ? mine : 1u; nx = cnt > 0u ? cnt : 1u;
}
__device__ __forceinline__ void xcd_barrier(const XcdBarrier& b, bool leader) {
    asm volatile("s_waitcnt vmcnt(0)" ::: "memory");
    __syncthreads();
    if (leader) {
        unsigned* bar = b.bar;
        __builtin_amdgcn_s_waitcnt(0);
        unsigned nloc = b.st[0], nx = b.st[1];
        if (nloc == 0u) { xcd_barrier_complete(bar, b.x, nloc, nx); b.st[0] = nloc; b.st[1] = nx; }
        const unsigned old = xb_add(&bar[XB_XSUB(b.x)], 1u);
        const unsigned gen = old / nloc;
        if (old + 1u == (gen + 1u) * nloc) {
            __builtin_amdgcn_fence(__ATOMIC_RELEASE, "agent");
            asm volatile("s_waitcnt vmcnt(0)" ::: "memory");
            const unsigned og = xb_add(&bar[XB_TOP], 1u);
            const unsigned tg = og / nx;
            if (og + 1u == (tg + 1u) * nx) xb_add(&bar[XB_TOPGEN], 1u);
            else XB_SPIN(xb_ld(&bar[XB_TOPGEN]) == tg, bar);
            __builtin_amdgcn_fence(__ATOMIC_ACQUIRE, "agent");
            xb_add(&bar[XB_XGEN(b.x)], 1u);
            asm volatile("s_waitcnt vmcnt(0)" ::: "memory");
        } else {
            XB_SPIN(xb_ld(&bar[XB_XGEN(b.x)]) == gen, bar);
            __builtin_amdgcn_fence(__ATOMIC_ACQUIRE, "agent");
            asm volatile("s_waitcnt vmcnt(0)" ::: "memory");
        }
    }
    __syncthreads();
}

__device__ __forceinline__ float shfl_xor_l(float v, int mask, int lane) { return __int_as_float(__builtin_amdgcn_ds_bpermute((lane ^ mask) << 2, __float_as_int(v))); }
__device__ __forceinline__ float wave_sum(float v, int lane) {
#pragma unroll
    for (int o = 1; o < 64; o <<= 1) v += shfl_xor_l(v, o, lane);
    return v;
}
__device__ __forceinline__ unsigned f2bf(float f) { unsigned u = __builtin_bit_cast(unsigned, f); return (u + 0x7fffu + ((u >> 16) & 1u)) >> 16; }
__device__ __forceinline__ unsigned pk2(float lo, float hi) { return f2bf(lo) | (f2bf(hi) << 16); }

__device__ __forceinline__ void transpose_item(const float* W, int N, bf16_t* WT, int ldwt, int koff, const float* gain, LAS float* scr, int item, int lane, unsigned char* W8 = nullptr, int n8 = 0) {
    const int nblk = N / 32, kb = item / nblk, nb = item % nblk, k0 = 64 * kb, n0 = 32 * nb;
    const GAS float* wp = (const GAS float*)W + (size_t)(k0 + (lane >> 5)) * N + n0 + (lane & 31); float v[32];
#pragma unroll
    for (int i = 0; i < 32; ++i) v[i] = wp[(size_t)(2 * i) * N];
    if (gain) {
#pragma unroll
        for (int i = 0; i < 32; ++i) v[i] *= ((const GAS float*)gain)[k0 + 2 * i + (lane >> 5)]; }
#pragma unroll
    for (int i = 0; i < 32; ++i) scr[(2 * i + (lane >> 5)) * 33 + (lane & 31)] = v[i];
    asm volatile("s_waitcnt lgkmcnt(0)" ::: "memory");
    const int c = lane & 7;
    if (W8 && n0 >= n8) {
#pragma unroll
        for (int j = 0; j < 4; ++j) { const int n = (lane >> 3) + 8 * j; const LAS float* s = scr + (8 * c) * 33 + n;
            u32x2 o; o.x = pk4_fp8(s[0 * 33] * W8_SCALE, s[1 * 33] * W8_SCALE, s[2 * 33] * W8_SCALE, s[3 * 33] * W8_SCALE); o.y = pk4_fp8(s[4 * 33] * W8_SCALE, s[5 * 33] * W8_SCALE, s[6 * 33] * W8_SCALE, s[7 * 33] * W8_SCALE);
            *(GAS u32x2*)(W8 + (size_t)(n0 - n8 + n) * DM + k0 + 8 * c) = o; }
    } else {
#pragma unroll
    for (int j = 0; j < 4; ++j) { const int n = (lane >> 3) + 8 * j; const LAS float* s = scr + (8 * c) * 33 + n;
        u32x4 o; o.x = pk2(s[0 * 33], s[1 * 33]); o.y = pk2(s[2 * 33], s[3 * 33]); o.z = pk2(s[4 * 33], s[5 * 33]); o.w = pk2(s[6 * 33], s[7 * 33]);
        *(GAS u32x4*)(WT + (size_t)(n0 + n) * ldwt + koff + k0 + 8 * c) = o; }
    }
    asm volatile("s_waitcnt lgkmcnt(0)" ::: "memory");
}
__device__ __forceinline__ void rms_row_to_bf16(const float* xrow, const float* gain, bf16_t* orow, int lane, unsigned char* o8row = nullptr) {
    const GAS f32x4* xr = (const GAS f32x4*)xrow + lane;
    f32x4 v[16]; float s = 0.f;
#pragma unroll
    for (int j = 0; j < 16; ++j) { v[j] = xr[64 * j]; s += (v[j].x * v[j].x + v[j].y * v[j].y) + (v[j].z * v[j].z + v[j].w * v[j].w); }
    const float r = 1.0f / sqrtf(wave_sum(s, lane) * (1.0f / DM) + RMS_EPS);
    GAS u32x2* o8 = (GAS u32x2*)orow + lane;
#pragma unroll
    for (int j = 0; j < 16; ++j) { f32x4 g = gain ? ((const GAS f32x4*)gain)[lane + 64 * j] : (f32x4){1.f, 1.f, 1.f, 1.f};
        const float y0 = v[j].x * r * g.x, y1 = v[j].y * r * g.y, y2 = v[j].z * r * g.z, y3 = v[j].w * r * g.w;
        u32x2 w; w.x = cvt_pk_bf16(y0, y1); w.y = cvt_pk_bf16(y2, y3); o8[64 * j] = w;
        if (o8row) ((GAS unsigned*)o8row)[lane + 64 * j] = pk4_fp8(y0 * H8_SCALE, y1 * H8_SCALE, y2 * H8_SCALE, y3 * H8_SCALE); }
}

__device__ __forceinline__ int t5_bucket(int rel) {
    const int n = rel < 0 ? -rel : rel;
    const int b = n < 8 ? n : 8 + (n >= 12) + (n >= 16) + (n >= 23) + (n >= 32) + (n >= 46) + (n >= 64) + (n >= 91);
    return b + (rel > 0 ? 16 : 0);
}

struct Args { const float* in[16]; float* out; unsigned char* ws; int ph_lo, ph_hi, probe_phase, probe_reps; };
struct Frame {
    LAS unsigned char* lds;
    int tid, lane, wave, vcu, G;
    const float *xp, *xs, *memp, *mems, *pre_norm, *post_norm, *mem_norm, *w_in, *w_kv, *w_a, *w_b, *w_m, *w_out, *rpb, *sink, *t5;
    float* out;
    bf16_t *WinT, *WkvT, *WcatT, *WoutT, *H, *X, *P, *MEMH, *KVM; float* RSQ; unsigned char *H8, *W8, *ws;
};
__device__ __forceinline__ void make_frame(Frame& F, LAS unsigned char* lds, int wave_s) {
    const Args* ka = (const Args*)__builtin_amdgcn_kernarg_segment_ptr(); asm volatile("" : "+s"(ka));
    const int lane = lane_id_hw();
    F.lds = lds; F.lane = lane; F.wave = wave_s; F.tid = wave_s * 64 + lane;
    F.G = gridDim.x; { const int bx = blockIdx.x; F.vcu = (F.G % 8 == 0) ? (bx % 8) * (F.G / 8) + bx / 8 : bx; }
    F.xp = ka->in[0]; F.xs = ka->in[1]; F.memp = ka->in[2]; F.mems = ka->in[3]; F.pre_norm = ka->in[4]; F.post_norm = ka->in[5]; F.mem_norm = ka->in[6];
    F.w_in = ka->in[7]; F.w_kv = ka->in[8]; F.w_a = ka->in[9]; F.w_b = ka->in[10]; F.w_m = ka->in[11]; F.w_out = ka->in[12]; F.rpb = ka->in[13]; F.sink = ka->in[14]; F.t5 = ka->in[15];
    F.out = ka->out; unsigned char* ws = ka->ws; F.ws = ws;
    F.WinT = (bf16_t*)(ws + WS_WIN); F.WkvT = (bf16_t*)(ws + WS_WKV); F.WcatT = (bf16_t*)(ws + WS_WCAT); F.WoutT = (bf16_t*)(ws + WS_WOUT);
    F.H = (bf16_t*)(ws + WS_H); F.X = (bf16_t*)(ws + WS_X); F.P = (bf16_t*)(ws + WS_P); F.MEMH = (bf16_t*)(ws + WS_MEMH); F.KVM = (bf16_t*)(ws + WS_KVM); F.RSQ = (float*)(ws + WS_RSQ); F.H8 = ws + WS_H8; F.W8 = ws + WS_W8;
}

__device__ __forceinline__ void naive_attention(Frame& F, int l) {
    const int gw = F.vcu * NWAVES + F.wave, NGW = F.G * NWAVES, lane = F.lane;
    const bf16_t* P = F.P; bf16_t* X = F.X;
    if (!FLASH_NA) for (int it = gw; it < NSEQ * 12 * SEQ; it += NGW) {
        const int p = it % SEQ, h = (it / SEQ) % 12, b = it / (SEQ * 12);
        const int r = p >> 6, c = p & 63; int rs = r - 4; rs = rs < 0 ? 0 : (rs > 24 ? 24 : rs); int cs = c - 8; cs = cs < 0 ? 0 : (cs > 48 ? 48 : cs);
        const size_t row = (size_t)b * SEQ + p;
        const unsigned qw = *(const unsigned*)(P + row * INW + QA + h * 128 + 2 * lane); const float q0 = bf_lo(qw), q1 = bf_hi(qw);
        const float* rp = F.rpb + (size_t)(l * 12 + h) * 15 * 31;
        float m = -1e30f, ls = 0.f, o0 = 0.f, o1 = 0.f;
        for (int kr = rs; kr < rs + 8; ++kr)
#pragma unroll 4
          for (int kc = cs; kc < cs + 16; ++kc) {
            const size_t krow = (size_t)b * SEQ + kr * 64 + kc;
            const unsigned kw = *(const unsigned*)(P + krow * INW + KA + h * 128 + 2 * lane), vw = *(const unsigned*)(P + krow * INW + VA + h * 128 + 2 * lane);
            const float s = wave_sum(q0 * bf_lo(kw) + q1 * bf_hi(kw), lane) * 0.08838834764831845f + rp[(kr - r + 7) * 31 + (kc - c + 15)];
            const float mn = fmaxf(m, s), a = __expf(m - mn), pe = __expf(s - mn);
            ls = ls * a + pe; o0 = o0 * a + pe * bf_lo(vw); o1 = o1 * a + pe * bf_hi(vw); m = mn;
        }
        const unsigned zw = *(const unsigned*)(P + row * INW + ZA + h * 128 + 2 * lane); const float inv = 1.0f / ls;
        *(unsigned*)(X + row * DM + h * 128 + 2 * lane) = cvt_pk_bf16(o0 * inv * bf_lo(zw), o1 * inv * bf_hi(zw));
    }
    if (!FLASH_SW) for (int it = gw; it < NSEQ * 12 * SEQ; it += NGW) {
        const int p = it % SEQ, h = (it / SEQ) % 12, b = it / (SEQ * 12), kvh = h / 3;
        const size_t row = (size_t)b * SEQ + p;
        const unsigned qw = *(const unsigned*)(P + row * INW + QB + h * 128 + 2 * lane); const float q0 = bf_lo(qw), q1 = bf_hi(qw);
        float m = F.sink[l * 12 + h], ls = 1.f, o0 = 0.f, o1 = 0.f;
        const int j0 = p - 128 < 0 ? 0 : p - 128, j1 = p + 128 > SEQ - 1 ? SEQ - 1 : p + 128;
#pragma unroll 4
        for (int j = j0; j <= j1; ++j) {
            const size_t krow = (size_t)b * SEQ + j;
            const unsigned kw = *(const unsigned*)(P + krow * INW + KB + kvh * 128 + 2 * lane), vw = *(const unsigned*)(P + krow * INW + VB + kvh * 128 + 2 * lane);
            const float s = wave_sum(q0 * bf_lo(kw) + q1 * bf_hi(kw), lane) * 0.08838834764831845f + F.t5[t5_bucket(j - p) * 12 + h];
            const float mn = fmaxf(m, s), a = __expf(m - mn), pe = __expf(s - mn);
            ls = ls * a + pe; o0 = o0 * a + pe * bf_lo(vw); o1 = o1 * a + pe * bf_hi(vw); m = mn;
        }
        const unsigned zw = *(const unsigned*)(P + row * INW + ZB + h * 128 + 2 * lane); const float inv = 1.0f / ls;
        *(unsigned*)(X + row * DM + 1536 + h * 128 + 2 * lane) = cvt_pk_bf16(o0 * inv * bf_lo(zw), o1 * inv * bf_hi(zw));
    }
    const bf16_t* KV = F.KVM + (size_t)l * MROWS * KVW;
    if (!FLASH_MEM) for (int it = gw; it < NSEQ * 4 * SEQ; it += NGW) {
        const int p = it % SEQ, h = (it / SEQ) % 4, b = it / (SEQ * 4);
        const size_t row = (size_t)b * SEQ + p;
        const u32x2 qw = *(const u32x2*)(P + row * INW + QM + h * 256 + 4 * lane); const float q0 = bf_lo(qw.x), q1 = bf_hi(qw.x), q2 = bf_lo(qw.y), q3 = bf_hi(qw.y);
        float m = -1e30f, ls = 0.f, o0 = 0.f, o1 = 0.f, o2 = 0.f, o3 = 0.f;
#pragma unroll 4
        for (int j = 0; j < MEMT; ++j) {
            const size_t krow = (size_t)b * MEMT + j;
            const u32x2 kw = *(const u32x2*)(KV + krow * KVW + h * 256 + 4 * lane), vw = *(const u32x2*)(KV + krow * KVW + 1024 + h * 256 + 4 * lane);
            const float s = wave_sum((q0 * bf_lo(kw.x) + q1 * bf_hi(kw.x)) + (q2 * bf_lo(kw.y) + q3 * bf_hi(kw.y)), lane) * 0.0625f;
            const float mn = fmaxf(m, s), a = __expf(m - mn), pe = __expf(s - mn);
            ls = ls * a + pe; o0 = o0 * a + pe * bf_lo(vw.x); o1 = o1 * a + pe * bf_hi(vw.x); o2 = o2 * a + pe * bf_lo(vw.y); o3 = o3 * a + pe * bf_hi(vw.y); m = mn;
        }
        const u32x2 zw = *(const u32x2*)(P + row * INW + ZM + h * 256 + 4 * lane); const float inv = 1.0f / ls;
        u32x2 w; w.x = cvt_pk_bf16(o0 * inv * bf_lo(zw.x), o1 * inv * bf_hi(zw.x)); w.y = cvt_pk_bf16(o2 * inv * bf_lo(zw.y), o3 * inv * bf_hi(zw.y));
        *(u32x2*)(X + row * DM + 3072 + h * 256 + 4 * lane) = w;
    }
}


namespace fa {
typedef float f32x16 __attribute__((ext_vector_type(16)));
typedef short s16x4 __attribute__((ext_vector_type(4)));
constexpr int SHM_V = 16384, SHM_K = 16384;
constexpr int OFF_V = 0, OFF_K = 32768, OFF_OST = 65536  , OFF_WS = RING_BYTES + 2048, OFF_TBL = RING_BYTES + 4096, TBL_PAD = 256;
constexpr int OFF_WS_MEM = RING_BYTES + 1024, OFF_OST_MEM = RING_BYTES + 16384;
constexpr float THR2 = 11.5f;
constexpr float NEG = -1e30f;
#define FA_KSWZ(row, colB) ((row) * 256 + ((colB) ^ (((row) & 7) << 4)))
#define FA_SBAR() __builtin_amdgcn_sched_barrier(0)
__device__ __forceinline__ int crow(int r, int hi) { return (r & 3) + 8 * (r >> 2) + 4 * hi; }
__device__ __forceinline__ int v_st(int k, int c) { const int kk = (k & ~0xC) | ((k & 4) << 1) | ((k & 8) >> 1); return ((kk >> 3) * 4 + (c >> 5)) * 512 + ((kk & 7) * 32 + (c & 31)) * 2; }
__device__ __forceinline__ int v_rd_base(int lane) { return ((lane & 3) << 3) | (((lane >> 2) & 3) << 6) | (((lane >> 4) & 1) << 5) | (((lane >> 5) & 1) << 8); }
constexpr int v_rd_off(int d0, int ks, int half) { return d0 * 512 + ks * 4096 + half * 2048; }
template <int OFF> __device__ __forceinline__ s16x4 tr_read(int vb) { s16x4 r; asm volatile("ds_read_b64_tr_b16 %0, %1 offset:%2" : "=&v"(r) : "v"(vb), "i"(OFF) : "memory"); return r; }
template <int D0> __device__ __forceinline__ void pv_one(f32x16& od, int vb, bf16x8 pa0, bf16x8 pa1, bf16x8 pa2, bf16x8 pa3) {
    const s16x4 l0 = tr_read<v_rd_off(D0, 0, 0)>(vb), h0 = tr_read<v_rd_off(D0, 0, 1)>(vb), l1 = tr_read<v_rd_off(D0, 1, 0)>(vb), h1 = tr_read<v_rd_off(D0, 1, 1)>(vb);
    const s16x4 l2 = tr_read<v_rd_off(D0, 2, 0)>(vb), h2 = tr_read<v_rd_off(D0, 2, 1)>(vb), l3 = tr_read<v_rd_off(D0, 3, 0)>(vb), h3 = tr_read<v_rd_off(D0, 3, 1)>(vb);
    asm volatile("s_waitcnt lgkmcnt(0)" ::: "memory"); FA_SBAR();
#define FA_PK(L, H) (bf16x8){L[0], L[1], L[2], L[3], H[0], H[1], H[2], H[3]}
    od = __builtin_amdgcn_mfma_f32_32x32x16_bf16(pa0, FA_PK(l0, h0), od, 0, 0, 0);
    od = __builtin_amdgcn_mfma_f32_32x32x16_bf16(pa1, FA_PK(l1, h1), od, 0, 0, 0);
    od = __builtin_amdgcn_mfma_f32_32x32x16_bf16(pa2, FA_PK(l2, h2), od, 0, 0, 0);
    od = __builtin_amdgcn_mfma_f32_32x32x16_bf16(pa3, FA_PK(l3, h3), od, 0, 0, 0);
#undef FA_PK
}
__device__ __forceinline__ void pv_d0(f32x16* o, int vb, bf16x8 pa0, bf16x8 pa1, bf16x8 pa2, bf16x8 pa3) {
    pv_one<0>(o[0], vb, pa0, pa1, pa2, pa3); pv_one<1>(o[1], vb, pa0, pa1, pa2, pa3); pv_one<2>(o[2], vb, pa0, pa1, pa2, pa3); pv_one<3>(o[3], vb, pa0, pa1, pa2, pa3);
}
template <int P1T> __device__ __forceinline__ void qkt(f32x16& p0, f32x16& p1, const LAS unsigned char* Ks, const bf16x8* qr, int r32, int hi, const LAS float* tb) {
#pragma unroll
    for (int r = 0; r < 16; ++r) { const int k0 = (r & 3) + 8 * (r >> 2); p0[r] = tb[k0]; p1[r] = tb[P1T + k0]; }
#ifndef FA_KBATCH
#define FA_KBATCH 2
#endif
#pragma unroll
    for (int g = 0; g < 8 / FA_KBATCH; ++g) { bf16x8 kf0[FA_KBATCH], kf1[FA_KBATCH];
#pragma unroll
        for (int d = 0; d < FA_KBATCH; ++d) { const int cb = ((g * FA_KBATCH + d) * 16 + hi * 8) * 2; kf0[d] = *(const LAS bf16x8*)(Ks + FA_KSWZ(r32, cb)); kf1[d] = *(const LAS bf16x8*)(Ks + FA_KSWZ(32 + r32, cb)); }
        FA_SBAR();
#pragma unroll
        for (int d = 0; d < FA_KBATCH; ++d) { p0 = __builtin_amdgcn_mfma_f32_32x32x16_bf16(kf0[d], qr[g * FA_KBATCH + d], p0, 0, 0, 0); p1 = __builtin_amdgcn_mfma_f32_32x32x16_bf16(kf1[d], qr[g * FA_KBATCH + d], p1, 0, 0, 0); }
        FA_SBAR(); }
}
template <int P1V> __device__ __forceinline__ void apply_bias(f32x16& p0, f32x16& p1, int vb, unsigned vl0, unsigned vl1, float C) {
#pragma unroll
    for (int r = 0; r < 16; ++r) { const int k0 = (r & 3) + 8 * (r >> 2);
        const float x0 = p0[r] * C, x1 = p1[r] * C;
        p0[r] = ((unsigned)(vb + k0) < vl0) ? x0 : NEG; p1[r] = ((unsigned)(vb + P1V + k0) < vl1) ? x1 : NEG; }
}
__device__ __forceinline__ void partialSM(f32x16& p0, f32x16& p1, float& m_reg, float& alpha) {
    float pmax = p0[0];
#pragma unroll
    for (int r = 1; r < 16; ++r) pmax = fmaxf(pmax, p0[r]);
#pragma unroll
    for (int r = 0; r < 16; ++r) pmax = fmaxf(pmax, p1[r]);
    { auto rr = __builtin_amdgcn_permlane32_swap(__float_as_uint(pmax), __float_as_uint(pmax), false, false); pmax = fmaxf(__uint_as_float(rr[0]), __uint_as_float(rr[1])); }
    if (__builtin_expect(__all(pmax - m_reg <= THR2), 1)) { alpha = 1.f; }
    else { const float mn = fmaxf(m_reg, pmax); alpha = __builtin_amdgcn_exp2f(m_reg - mn); m_reg = mn; }
#pragma unroll
    for (int r = 0; r < 16; ++r) { p0[r] = __builtin_amdgcn_exp2f(p0[r] - m_reg); p1[r] = p1[r] - m_reg; }
}
#define FA_PK4(P, BASE, OUT) do { const unsigned a0 = cvt_pk_bf16(P[BASE + 0], P[BASE + 1]), a1 = cvt_pk_bf16(P[BASE + 2], P[BASE + 3]);   \
    const unsigned b0 = cvt_pk_bf16(P[BASE + 4], P[BASE + 5]), b1 = cvt_pk_bf16(P[BASE + 6], P[BASE + 7]);                              \
    auto r0 = __builtin_amdgcn_permlane32_swap(a0, b0, false, false); auto r1 = __builtin_amdgcn_permlane32_swap(a1, b1, false, false); \
    u32x4 w = {r0[0], r1[0], r0[1], r1[1]}; OUT = __builtin_bit_cast(bf16x8, w); } while (0)
__device__ __forceinline__ void finishSM(f32x16& p0, f32x16& p1, float alpha, float& l_reg, bf16x8& pa0, bf16x8& pa1, bf16x8& pa2, bf16x8& pa3) {
#pragma unroll
    for (int r = 0; r < 16; ++r) p1[r] = __builtin_amdgcn_exp2f(p1[r]);
    float ps = 0.f;
#pragma unroll
    for (int r = 0; r < 16; ++r) ps += p0[r];
#pragma unroll
    for (int r = 0; r < 16; ++r) ps += p1[r];
    { auto rr = __builtin_amdgcn_permlane32_swap(__float_as_uint(ps), __float_as_uint(ps), false, false); ps = __uint_as_float(rr[0]) + __uint_as_float(rr[1]); }
    l_reg = l_reg * alpha + ps;
    FA_PK4(p0, 0, pa0); FA_PK4(p0, 8, pa1); FA_PK4(p1, 0, pa2); FA_PK4(p1, 8, pa3);
}

struct FlashUnit {
    const bf16_t *Q, *K, *V, *Z; bf16_t* O;
    int NT, jlo, jhi;
    int tblo;
    float tv; int tcnt;
    int rsl;
    int lane_off, jstride, vbase, vstride; unsigned vlim;
    float m_init, l_init, C;
};
template <bool NA2>
__device__ __forceinline__ void flash_unit(LAS unsigned char* lds, const FlashUnit& U, int tid) {
    const int wid = __builtin_amdgcn_readfirstlane(tid >> 6), lane = tid & 63, r32 = lane & 31, hi = lane >> 5;
    constexpr int EHI = NA2 ? 64 : 16, KROW1 = NA2 ? 64 : 32, KTILE = NA2 ? 128 : 64, P1T = NA2 ? 31 : 32, P1V = NA2 ? 0 : 32;
    constexpr int KP = GATES_FP8 ? 128 : INW;
    const int ebase = NA2 ? wid * 128 : wid * 32;
    LAS unsigned char* V_lds = lds + OFF_V; LAS unsigned char* K_lds = lds + OFF_K;
    LAS float* wsx = (LAS float*)(lds + OFF_WS) + wid * 64; LAS float* li_l = wsx; LAS float* al_l = wsx + 32;
    const LAS float* tbl = (const LAS float*)(lds + U.tblo) + TBL_PAD + U.lane_off;
    float m_reg = U.m_init, l_reg = U.l_init; f32x16 o[4] = {}; bf16x8 qr[8];
    { const GAS char* Qw = (const GAS char*)U.Q; const unsigned qo = (unsigned)((ebase + (r32 & 15) + (r32 >> 4) * EHI) * INW + hi * 8) * 2u;
#pragma unroll
      for (int d0 = 0; d0 < 8; ++d0) qr[d0] = *(const GAS bf16x8*)(Qw + qo + d0 * 32); }
    const int sr = tid >> 4, sc = (tid & 15) * 8, vst0 = v_st(sr, sc), vst1 = v_st(32 + sr, sc), kst0 = FA_KSWZ(sr, sc * 2), kst1 = FA_KSWZ(32 + sr, sc * 2);
    const int vb0 = (int)(unsigned)(size_t)V_lds + v_rd_base(lane);
    const unsigned go0 = (unsigned)(sr * KP + sc) * 2u, go1 = (unsigned)((KROW1 + sr) * KP + sc) * 2u;
    constexpr size_t TILE_B = (size_t)KTILE * KP * 2;
    bf16x8 sv0[2], sv1[2], sk0[2], sk1[2];
#define FA_SLOAD(i, j) do { const GAS char* kt = (const GAS char*)U.K + (size_t)(j) * TILE_B; const GAS char* vt = (const GAS char*)U.V + (size_t)(j) * TILE_B; \
    sv0[i] = *(const GAS bf16x8*)(vt + go0); sv1[i] = *(const GAS bf16x8*)(vt + go1); sk0[i] = *(const GAS bf16x8*)(kt + go0); sk1[i] = *(const GAS bf16x8*)(kt + go1); } while (0)
#define FA_SWRITE(b, i) do { *(LAS bf16x8*)(V_lds + (b) * SHM_V + vst0) = sv0[i]; *(LAS bf16x8*)(V_lds + (b) * SHM_V + vst1) = sv1[i]; \
    *(LAS bf16x8*)(K_lds + (b) * SHM_K + kst0) = sk0[i]; *(LAS bf16x8*)(K_lds + (b) * SHM_K + kst1) = sk1[i]; } while (0)
    const int NT = U.NT;
    FA_SLOAD(0, 0); if (1 < NT) FA_SLOAD(1, 1);
    __builtin_amdgcn_sched_barrier(0);
    if (tid < U.tcnt) ((LAS float*)(lds + U.tblo))[TBL_PAD + tid] = U.tv * 11.313708498984761f;
#define FA_TILE(j, BUF) do { \
    FA_SWRITE(BUF, BUF); __syncthreads(); \
    if ((j) + 2 < NT) FA_SLOAD(BUF, (j) + 2); \
    if ((j) >= U.jlo && (j) < U.jhi) { f32x16 p0, p1; float alpha; bf16x8 pa0, pa1, pa2, pa3; \
        qkt<P1T>(p0, p1, K_lds + (BUF) * SHM_K, qr, r32, hi, tbl + (j) * U.jstride); \
        unsigned vl0 = U.vlim, vl1 = U.vlim; if constexpr (NA2) { vl0 = ((unsigned)(2 * (j) - U.rsl) < 8u) ? 16u : 0u; vl1 = ((unsigned)(2 * (j) + 1 - U.rsl) < 8u) ? 16u : 0u; } \
        apply_bias<P1V>(p0, p1, U.vbase + (j) * U.vstride, vl0, vl1, U.C); \
        partialSM(p0, p1, m_reg, alpha); finishSM(p0, p1, alpha, l_reg, pa0, pa1, pa2, pa3); \
        if (__any(alpha < 1.f)) { if (hi == 0) al_l[r32] = alpha; asm volatile("s_waitcnt lgkmcnt(0)" ::: "memory"); \
            _Pragma("unroll") for (int d = 0; d < 4; ++d) _Pragma("unroll") for (int r = 0; r < 16; ++r) o[d][r] *= al_l[crow(r, hi)]; } \
        pv_d0(o, vb0 + (BUF) * SHM_V, pa0, pa1, pa2, pa3); } } while (0)
    int j = 0;
    for (; j + 1 < NT; j += 2) { FA_TILE(j, 0); FA_TILE(j + 1, 1); }
    if (j < NT) FA_TILE(j, 0);
    { const GAS bf16_t* zb = (const GAS bf16_t*)U.Z + (size_t)ebase * INW; GAS bf16_t* ob = (GAS bf16_t*)U.O + (size_t)ebase * DM;
      int ln2 = lane; asm volatile("" : "+v"(ln2));
      u32x4 zv[8];
#pragma unroll
      for (int k = 0; k < 8; ++k) { const int ch = ln2 + 64 * k, row = ch >> 4, c16 = ch & 15, grow = (row & 15) + (row >> 4) * EHI; zv[k] = *(const GAS u32x4*)(zb + (size_t)grow * INW + c16 * 8); }
      if (hi == 0) li_l[r32] = l_reg; asm volatile("s_waitcnt lgkmcnt(0)" ::: "memory");
      LAS unsigned char* stg = lds + OFF_OST + wid * 8192;
#pragma unroll
      for (int r = 0; r < 16; ++r) { const int lr = crow(r, hi); const float rl = __builtin_amdgcn_rcpf(li_l[lr]);
#pragma unroll
          for (int d0 = 0; d0 < 4; ++d0) *(LAS bf16_t*)(stg + lr * 256 + (d0 * 32 + r32) * 2) = (bf16_t)f2bf(o[d0][r] * rl); }
      asm volatile("s_waitcnt lgkmcnt(0)" ::: "memory"); __builtin_amdgcn_sched_barrier(0);
#pragma unroll
      for (int k = 0; k < 8; ++k) { const int ch = ln2 + 64 * k, row = ch >> 4, c16 = ch & 15, grow = (row & 15) + (row >> 4) * EHI; const u32x4 ov = *(const LAS u32x4*)(stg + row * 256 + c16 * 16); const u32x4 z = zv[k];
          u32x4 w; w.x = cvt_pk_bf16(bf_lo(ov.x) * bf_lo(z.x), bf_hi(ov.x) * bf_hi(z.x)); w.y = cvt_pk_bf16(bf_lo(ov.y) * bf_lo(z.y), bf_hi(ov.y) * bf_hi(z.y));
          w.z = cvt_pk_bf16(bf_lo(ov.z) * bf_lo(z.z), bf_hi(ov.z) * bf_hi(z.z)); w.w = cvt_pk_bf16(bf_lo(ov.w) * bf_lo(z.w), bf_hi(ov.w) * bf_hi(z.w));
          *(GAS u32x4*)(ob + (size_t)grow * DM + c16 * 8) = w; } }
#undef FA_SLOAD
#undef FA_SWRITE
#undef FA_TILE
}

__device__ __forceinline__ void mem_unit(LAS unsigned char* lds, const bf16_t* Qb, const bf16_t* KVg, const bf16_t* Zb, bf16_t* Ob, int tid) {
    const int wid = __builtin_amdgcn_readfirstlane(tid >> 6), lane = tid & 63, r32 = lane & 31, hi = lane >> 5;
    bf16x8 kv[16];
#pragma unroll
    for (int i = 0; i < 16; ++i) { const int ch = i * 512 + tid, key = ch >> 5, c16 = ch & 31; kv[i] = *(const GAS bf16x8*)((const GAS bf16_t*)KVg + (size_t)key * KVW + c16 * 8); }
    __syncthreads();
#pragma unroll
    for (int i = 0; i < 16; ++i) { const int ch = i * 512 + tid, key = ch >> 5, c16 = ch & 31; *(LAS bf16x8*)(lds + key * 512 + ((c16 * 16) ^ ((key & 7) << 4))) = kv[i]; }
    __syncthreads();
    f32x16 p[8];
#pragma unroll
    for (int kb = 0; kb < 8; ++kb) p[kb] = (f32x16){};
    const GAS bf16_t* Qw = (const GAS bf16_t*)Qb + (size_t)(wid * 32 + r32) * INW + hi * 8;
#pragma unroll
    for (int d0 = 0; d0 < 16; ++d0) { const bf16x8 qf = *(const GAS bf16x8*)(Qw + d0 * 16); const int cb = (d0 * 32 + hi * 16) ^ ((r32 & 7) << 4);
#pragma unroll
        for (int kb = 0; kb < 8; ++kb) { const bf16x8 kf = *(const LAS bf16x8*)(lds + (kb * 32 + r32) * 512 + cb); p[kb] = __builtin_amdgcn_mfma_f32_32x32x16_bf16(kf, qf, p[kb], 0, 0, 0); } }
#pragma unroll
    for (int i = 0; i < 16; ++i) { const int ch = i * 512 + tid, key = ch >> 5, c16 = ch & 31; kv[i] = *(const GAS bf16x8*)((const GAS bf16_t*)KVg + (size_t)key * KVW + 1024 + c16 * 8); }
    constexpr float C2 = 0.0625f * LOG2E;
    float mx = p[0][0];
#pragma unroll
    for (int kb = 0; kb < 8; ++kb)
#pragma unroll
        for (int r = 0; r < 16; ++r) mx = fmaxf(mx, p[kb][r]);
    { auto rr = __builtin_amdgcn_permlane32_swap(__float_as_uint(mx), __float_as_uint(mx), false, false); mx = fmaxf(__uint_as_float(rr[0]), __uint_as_float(rr[1])); }
    const float mc = -mx * C2; float ls = 0.f;
#pragma unroll
    for (int kb = 0; kb < 8; ++kb)
#pragma unroll
        for (int r = 0; r < 16; ++r) { const float e = __builtin_amdgcn_exp2f(fmaf(p[kb][r], C2, mc)); p[kb][r] = e; ls += e; }
    { auto rr = __builtin_amdgcn_permlane32_swap(__float_as_uint(ls), __float_as_uint(ls), false, false); ls = __uint_as_float(rr[0]) + __uint_as_float(rr[1]); }
    bf16x8 pa[4][4];
#pragma unroll
    for (int g = 0; g < 4; ++g) { FA_PK4(p[2 * g], 0, pa[g][0]); FA_PK4(p[2 * g], 8, pa[g][1]); FA_PK4(p[2 * g + 1], 0, pa[g][2]); FA_PK4(p[2 * g + 1], 8, pa[g][3]); }
    __syncthreads();
#pragma unroll
    for (int i = 0; i < 16; ++i) { const int ch = i * 512 + tid, key = ch >> 5, c16 = ch & 31, d = c16 * 8;
        *(LAS bf16x8*)(lds + ((key >> 6) * 2 + (d >> 7)) * 16384 + v_st(key & 63, d & 127)) = kv[i]; }
    __syncthreads();
    const int vb0 = (int)(unsigned)(size_t)lds + v_rd_base(lane);
    LAS float* li_l = (LAS float*)(lds + OFF_WS_MEM) + wid * 32;
    if (hi == 0) li_l[r32] = ls; asm volatile("s_waitcnt lgkmcnt(0)" ::: "memory");
    LAS unsigned char* stg = lds + OFF_OST_MEM + wid * 2048;
#pragma unroll
    for (int dh = 0; dh < 2; ++dh) {
        int ln2 = lane; asm volatile("" : "+v"(ln2));
        const GAS bf16_t* zb = (const GAS bf16_t*)Zb + (size_t)(wid * 32) * INW + dh * 128; GAS bf16_t* ob = (GAS bf16_t*)Ob + (size_t)(wid * 32) * DM + dh * 128;
        u32x4 zv[8];
#pragma unroll
        for (int k = 0; k < 8; ++k) { const int ch = ln2 + 64 * k, row = ch >> 4, c16 = ch & 15; zv[k] = *(const GAS u32x4*)(zb + (size_t)row * INW + c16 * 8); }
        f32x16 o[4] = {};
#pragma unroll
        for (int g = 0; g < 4; ++g) pv_d0(o, vb0 + (g * 2 + dh) * 16384, pa[g][0], pa[g][1], pa[g][2], pa[g][3]);
#pragma unroll
        for (int p = 0; p < 4; ++p) {
#pragma unroll
            for (int q = 0; q < 4; ++q) { const int r = 4 * p + q, lr8 = q + 4 * hi; const float rl = __builtin_amdgcn_rcpf(li_l[8 * p + lr8]);
#pragma unroll
                for (int d0 = 0; d0 < 4; ++d0) *(LAS bf16_t*)(stg + lr8 * 256 + (d0 * 32 + r32) * 2) = (bf16_t)f2bf(o[d0][r] * rl); }
            asm volatile("s_waitcnt lgkmcnt(0)" ::: "memory");
#pragma unroll
            for (int k = 0; k < 2; ++k) { const int ch = ln2 + 64 * k, row8 = ch >> 4, c16 = ch & 15; const u32x4 ov = *(const LAS u32x4*)(stg + row8 * 256 + c16 * 16); const u32x4 z = zv[2 * p + k];
                u32x4 w; w.x = cvt_pk_bf16(bf_lo(ov.x) * bf_lo(z.x), bf_hi(ov.x) * bf_hi(z.x)); w.y = cvt_pk_bf16(bf_lo(ov.y) * bf_lo(z.y), bf_hi(ov.y) * bf_hi(z.y));
                w.z = cvt_pk_bf16(bf_lo(ov.z) * bf_lo(z.z), bf_hi(ov.z) * bf_hi(z.z)); w.w = cvt_pk_bf16(bf_lo(ov.w) * bf_lo(z.w), bf_hi(ov.w) * bf_hi(z.w));
                *(GAS u32x4*)(ob + (size_t)(8 * p + row8) * DM + c16 * 8) = w; }
            asm volatile("s_waitcnt lgkmcnt(0)" ::: "memory");
        }
    }
}
}

#ifndef FLASH_NA
#define FLASH_NA 1
#endif
#ifndef FLASH_SW
#define FLASH_SW 1
#endif
#ifndef FLASH_MEM
#define FLASH_MEM 1
#endif
__device__ __forceinline__ void attention_phase(Frame& F, int l, int mask = 7) {
    LAS unsigned char* lds = F.lds; const int tid = F.tid, G = F.G;
    int tpar = 0;
    const int wid = F.wave;
    if (FLASH_NA && (mask & 1)) for (int i = 0;; ++i) {
        int u; if (G == 256) { if (i < 4) u = i * 256 + F.vcu; else if (i == 4 && F.vcu >= 128) u = 1024 + (F.vcu - 128); else break; } else { u = i * G + F.vcu; if (u >= 1152) break; }
        const int bh = u >> 3, blk = u & 7, b = bh / 12, h = bh % 12;
        const int ln = lane_id_hw(), r32 = ln & 31, hi = ln >> 5;
        fa::FlashUnit U; U.C = 0.08838834764831845f * LOG2E; U.tblo = fa::OFF_TBL + tpar * 4096; tpar ^= 1;
        const int rb = blk >> 2, cb = blk & 3, lo = rb ? 12 : 0; U.NT = 10;
        int c0 = 16 * cb - 8; c0 = c0 < 0 ? 0 : (c0 > 32 ? 32 : c0);
        const size_t tok0 = (size_t)b * SEQ + rb * 1024 + cb * 16;
        const int qr = 16 * rb + 2 * wid + (r32 >> 4), qc = 16 * cb + (r32 & 15);
        int rs = qr - 4; rs = rs < 0 ? 0 : (rs > 24 ? 24 : rs); int cs = qc - 8; cs = cs < 0 ? 0 : (cs > 48 ? 48 : cs);
        int rsA = 16 * rb + 2 * wid - 4; rsA = rsA < 0 ? 0 : (rsA > 24 ? 24 : rsA); int rsB = 16 * rb + 2 * wid - 3; rsB = rsB < 0 ? 0 : (rsB > 24 ? 24 : rsB);
        U.Q = F.P + tok0 * INW + QA + h * 128; if (GATES_FP8) { const size_t ko = ((size_t)(b * 12 + h) * SEQ + lo * 64 + c0) * 128; U.K = (const bf16_t*)(F.ws + WS_KNA) + ko; U.V = (const bf16_t*)(F.ws + WS_VNA) + ko; }
        else { U.K = F.P + ((size_t)b * SEQ + lo * 64 + c0) * INW + KA + h * 128; U.V = U.K + (VA - KA); } U.Z = F.P + tok0 * INW + ZA + h * 128; U.O = F.X + tok0 * DM + h * 128;
        U.jlo = (rsA - lo) >> 1; U.jhi = ((rsB + 7 - lo) >> 1) + 1; U.rsl = rs - lo;
        U.lane_off = (lo - qr + 7) * 31 + (c0 - qc + 15) + 4 * hi; U.jstride = 62; U.vbase = c0 - cs + 4 * hi; U.vstride = 0; U.vlim = 16u;
        U.m_init = -30000.f; U.l_init = 0.f;
        const float* rp = F.rpb + (size_t)(l * 12 + h) * 465;
        { const int k = wid * 64 + ln; U.tcnt = 465; U.tv = (k < 465) ? ((const GAS float*)rp)[k] : 0.f; }
        if (mask & 8) U.jhi = U.jlo;
        fa::flash_unit<true>(lds, U, wid * 64 + ln);
    }
    if (FLASH_SW && (mask & 2)) for (int i = 0;; ++i) {
        int u; if (G == 256) { if (i < 3) u = i * 256 + F.vcu; else if (i < 6 && F.vcu < 128) u = 768 + (i - 3) * 128 + F.vcu; else break; } else { u = i * G + F.vcu; if (u >= 1152) break; }
        int bh, blk;
        if (u < 864) { bh = u / 6; blk = 1 + u % 6; } else { u -= 864; bh = u >> 1; blk = (u & 1) * 7; }
        const int b = bh / 12, h = bh % 12;
        const int ln = lane_id_hw(), r32 = ln & 31, hi = ln >> 5;
        fa::FlashUnit U; U.C = 0.08838834764831845f * LOG2E; U.tblo = fa::OFF_TBL + tpar * 4096; tpar ^= 1; const size_t row0 = (size_t)b * SEQ + blk * 256;
        const int t0 = 256 * blk, kt0 = (blk == 0) ? 0 : t0 - 128; U.NT = (blk == 0 || blk == 7) ? 6 : 8;
        const int tq = t0 + 32 * wid + r32;
        U.Q = F.P + row0 * INW + QB + h * 128; if (GATES_FP8) { const size_t ko = ((size_t)(b * 4 + h / 3) * SEQ + kt0) * 128; U.K = (const bf16_t*)(F.ws + WS_KSW) + ko; U.V = (const bf16_t*)(F.ws + WS_VSW) + ko; }
        else { U.K = F.P + ((size_t)b * SEQ + kt0) * INW + KB + (h / 3) * 128; U.V = U.K + (VB - KB); } U.Z = F.P + row0 * INW + ZB + h * 128; U.O = F.X + row0 * DM + 1536 + h * 128;
        const int a = t0 + 32 * wid - 128 - kt0, bnd = t0 + 32 * wid + 159 - kt0; U.jlo = a <= 0 ? 0 : (a >> 6); { const int jh = (bnd >> 6) + 1; U.jhi = jh < U.NT ? jh : U.NT; }
        U.lane_off = kt0 - tq + 128 + 4 * hi; U.jstride = 64; U.vbase = U.lane_off; U.vstride = 64; U.vlim = 257u;
        U.m_init = F.sink[l * 12 + h] * LOG2E; U.l_init = 1.f; U.rsl = 0;
        { const int k = wid * 64 + ln; U.tcnt = 257; U.tv = (k < 257) ? ((const GAS float*)F.t5)[t5_bucket(k - 128) * 12 + h] : 0.f; }
        if (mask & 8) U.jhi = U.jlo;
        fa::flash_unit<false>(lds, U, wid * 64 + ln);
    }
    __syncthreads();
#if FLASH_MEM
    const bf16_t* KV = F.KVM + (size_t)l * MROWS * KVW;
    if (mask & 4) for (int i = 0;; ++i) {
        const int u = i * G + (G - 1 - F.vcu); if (u >= 384) break;
        const int bh = u >> 3, qb = u & 7, b = bh >> 2, h = bh & 3; const size_t row0 = (size_t)b * SEQ + qb * 256;
        fa::mem_unit(lds, F.P + row0 * INW + QM + h * 256, KV + (size_t)b * MEMT * KVW + h * 256, F.P + row0 * INW + ZM + h * 256, F.X + row0 * DM + 3072 + h * 256, F.wave * 64 + lane_id_hw());
    }
    __syncthreads();
#endif
}

__device__ __forceinline__ const float* x_row(const Frame& F, int m) { return m < TP ? F.xp + (size_t)m * DM : F.xs + (size_t)(m - TP) * DM; }

__device__ __forceinline__ void p0_prologue(Frame& F) {
    LAS float* scr = (LAS float*)(F.lds + F.wave * 16384);
    const int gw = F.vcu * NWAVES + F.wave, NGW = F.G * NWAVES;
    constexpr int I_IN = (DM / 64) * (INW / 32), I_KV = (DM / 64) * (KVW / 32), I_A = (1536 / 64) * (DM / 32), I_M = (1024 / 64) * (DM / 32), I_O = (DM / 64) * (DM / 32);
    constexpr int PER_L = I_IN + I_KV + 2 * I_A + I_M + I_O;
    for (int it = gw; it < DEPTH * PER_L; it += NGW) {
        const int l = it / PER_L; int r = it - l * PER_L;
        if (r < I_IN) { transpose_item(F.w_in + (size_t)l * DM * INW, INW, F.WinT + (size_t)l * INW * DM, DM, 0, nullptr, scr, r, F.lane, GATES_FP8 ? F.W8 + (size_t)l * NGATE * DM : nullptr, GA); continue; } r -= I_IN;
        if (r < I_KV) { transpose_item(F.w_kv + (size_t)l * DM * KVW, KVW, F.WkvT + (size_t)l * KVW * DM, DM, 0, F.mem_norm + l * DM, scr, r, F.lane); continue; } r -= I_KV;
        bf16_t* wc = F.WcatT + (size_t)l * DM * DM;
        if (r < I_A) { transpose_item(F.w_a + (size_t)l * 1536 * DM, DM, wc, DM, 0, nullptr, scr, r, F.lane); continue; } r -= I_A;
        if (r < I_A) { transpose_item(F.w_b + (size_t)l * 1536 * DM, DM, wc, DM, 1536, nullptr, scr, r, F.lane); continue; } r -= I_A;
        if (r < I_M) { transpose_item(F.w_m + (size_t)l * 1024 * DM, DM, wc, DM, 3072, nullptr, scr, r, F.lane); continue; } r -= I_M;
        transpose_item(F.w_out + (size_t)l * DM * DM, DM, F.WoutT + (size_t)l * DM * DM, DM, 0, nullptr, scr, r, F.lane);
    }
    for (int m = gw; m < T; m += NGW) rms_row_to_bf16(x_row(F, m), F.pre_norm, F.H + (size_t)m * DM, F.lane, GATES_FP8 ? F.H8 + (size_t)m * DM : nullptr);
    for (int m = gw; m < MROWS; m += NGW) rms_row_to_bf16(m < 4 * MEMT ? F.memp + (size_t)m * DM : F.mems + (size_t)(m - 4 * MEMT) * DM, nullptr, F.MEMH + (size_t)m * DM, F.lane);
}
__device__ __forceinline__ void post_norm_phase(Frame& F, int l) {
    const int gw = F.vcu * NWAVES + F.wave, NGW = F.G * NWAVES, lane = F.lane;
    const float* pg = F.post_norm + l * DM; const float* npre = (l + 1 < DEPTH) ? F.pre_norm + (l + 1) * DM : nullptr;
    for (int m = gw; m < T; m += NGW) {
        const float ss = wave_sum(F.RSQ[(size_t)m * 64 + lane], lane);
        const float r = 1.0f / sqrtf(ss * (1.0f / DM) + RMS_EPS);
        const GAS u32x2* orow = (const GAS u32x2*)(F.X + (size_t)m * DM) + lane;
        GAS u32x2* x1row = (GAS u32x2*)(F.P + (size_t)m * INW + 18432) + lane;
        GAS f32x4* yo = (GAS f32x4*)(F.out + (size_t)m * DM) + lane;
        f32x4 v[16]; float s2 = 0.f;
        if (l == 0) { const GAS f32x4* xr = (const GAS f32x4*)x_row(F, m) + lane;
#pragma unroll
            for (int j = 0; j < 16; ++j) { const f32x4 x = xr[64 * j]; const u32x2 ow = orow[64 * j]; const f32x4 g = ((const GAS f32x4*)pg)[lane + 64 * j];
                f32x4 y; y.x = x.x + bf_lo(ow.x) * r * g.x; y.y = x.y + bf_hi(ow.x) * r * g.y; y.z = x.z + bf_lo(ow.y) * r * g.z; y.w = x.w + bf_hi(ow.y) * r * g.w;
                v[j] = y; s2 += (y.x * y.x + y.y * y.y) + (y.z * y.z + y.w * y.w);
                if (npre) { u32x2 w; w.x = cvt_pk_bf16(y.x, y.y); w.y = cvt_pk_bf16(y.z, y.w); x1row[64 * j] = w; } else yo[64 * j] = y; } }
        else {
#pragma unroll
            for (int j = 0; j < 16; ++j) { const u32x2 xw = x1row[64 * j]; const u32x2 ow = orow[64 * j]; const f32x4 g = ((const GAS f32x4*)pg)[lane + 64 * j];
                f32x4 y; y.x = bf_lo(xw.x) + bf_lo(ow.x) * r * g.x; y.y = bf_hi(xw.x) + bf_hi(ow.x) * r * g.y; y.z = bf_lo(xw.y) + bf_lo(ow.y) * r * g.z; y.w = bf_hi(xw.y) + bf_hi(ow.y) * r * g.w;
                v[j] = y; s2 += (y.x * y.x + y.y * y.y) + (y.z * y.z + y.w * y.w);
                if (npre) { u32x2 w; w.x = cvt_pk_bf16(y.x, y.y); w.y = cvt_pk_bf16(y.z, y.w); x1row[64 * j] = w; } else yo[64 * j] = y; } }
        if (npre) {
            const float r2 = 1.0f / sqrtf(wave_sum(s2, lane) * (1.0f / DM) + RMS_EPS);
            GAS u32x2* h8 = (GAS u32x2*)(F.H + (size_t)m * DM) + lane;
#pragma unroll
            for (int j = 0; j < 16; ++j) { const f32x4 g = ((const GAS f32x4*)npre)[lane + 64 * j];
                const float y0 = v[j].x * r2 * g.x, y1 = v[j].y * r2 * g.y, y2 = v[j].z * r2 * g.z, y3 = v[j].w * r2 * g.w;
                u32x2 w; w.x = cvt_pk_bf16(y0, y1); w.y = cvt_pk_bf16(y2, y3); h8[64 * j] = w;
                if (GATES_FP8) ((GAS unsigned*)(F.H8 + (size_t)m * DM))[lane + 64 * j] = pk4_fp8(y0 * H8_SCALE, y1 * H8_SCALE, y2 * H8_SCALE, y3 * H8_SCALE); }
        }
    }
}

constexpr int N_PHASES = 1 + 5 * DEPTH;
__global__ void __launch_bounds__(NWAVES * 64, 2) fwd(Args args) {
    extern __shared__ __attribute__((aligned(16))) unsigned char lds_raw[];
    LAS unsigned char* lds = (LAS unsigned char*)lds_raw;
    const int wave_s = __builtin_amdgcn_readfirstlane((int)threadIdx.x >> 6);
    for (int u = wave_s * 64 + lane_id_hw(); u < (LDS_BYTES - LDSCTL_OFF) / 4; u += NWAVES * 64) ((LAS unsigned*)(lds + LDSCTL_OFF))[u] = 0u;
    __syncthreads();
    unsigned* const barw = (unsigned*)(args.ws + WS_CTL) + CW_BAR;
    XcdBarrier bar; bar.bar = barw; bar.x = 0; bar.st = nullptr;
    if (MK_ONE_LAUNCH) bar = xcd_barrier_post(barw, (volatile LAS unsigned*)(lds + MISC_OFF) + 8, wave_s == 0 && lane_id_hw() == 0);
    const int lo = args.ph_lo, hi = args.ph_hi;
#define IN(k) (lo <= (k) && (k) < hi)
#define SEAM(k) do { if (IN(k) && IN((k) + 1)) xcd_barrier(bar, wave_s == 0 && lane_id_hw() == 0); } while (0)

    const int probe_phase = args.probe_phase, n_iter = DEPTH + args.probe_reps;
    if (IN(0)) { Frame F; make_frame(F, lds, wave_s); p0_prologue(F); SEAM(0); }
    for (int it = 0; it < n_iter; ++it) {
        const bool probing = it >= DEPTH; const int l = probing ? ((it - DEPTH) & 1) : it;
        const int pb = 1 + 5 * l;
        if (probing && it == DEPTH) xcd_barrier(bar, wave_s == 0 && lane_id_hw() == 0);
#define RUN(k) (probing ? (probe_phase == (k)) : IN(pb + (k) - 1))
#define SEAM2(k) do { if (probing || (IN(pb + (k) - 1) && IN(pb + (k)))) xcd_barrier(bar, wave_s == 0 && lane_id_hw() == 0); } while (0)
        if (RUN(1)) {
            Frame F; make_frame(F, lds, wave_s);
            SchedIn S; S.G = F.G; S.c = (int)blockIdx.x; S.nextra = (l == 0) ? 2 * 96 : 0; S.A = (unsigned)WS_H; S.B = (unsigned)(WS_WIN + (size_t)l * INW * DM * 2);
            S.memA = (unsigned)WS_MEMH; S.memB0 = (unsigned)WS_WKV; S.memB1 = (unsigned)(WS_WKV + (size_t)KVW * DM * 2);
            EpiIn E{F.P, F.KVM, F.KVM + (size_t)MROWS * KVW, (bf16_t*)F.ws};
            pg8::gemm_phase<EpiIn, SchedIn>(lds, (const char*)F.ws, S, E, wave_s);
            SEAM2(1);
        }
        if (RUN(2)) { Frame F; make_frame(F, lds, wave_s); attention_phase(F, l); if (!(FLASH_NA && FLASH_SW && FLASH_MEM)) naive_attention(F, l); if (!GATES_FP8) SEAM2(2); }
        if (GATES_FP8 && RUN(2)) {
            Frame F; make_frame(F, lds, wave_s);
            SchedIn8 S8; S8.G = F.G; S8.c = (int)blockIdx.x; S8.A = (unsigned)WS_H8; S8.B = (unsigned)(WS_W8 + (size_t)l * NGATE * DM);
            EpiIn8 E8{F.P};
            pg8::gemm_phase<EpiIn8, SchedIn8, 4096, true>(lds, (const char*)F.ws, S8, E8, wave_s);
            SEAM2(2);
        }
        if (probing && probe_phase >= 6) { Frame F; make_frame(F, lds, wave_s); attention_phase(F, l, probe_phase == 6 ? 1 : probe_phase == 7 ? 2 : probe_phase == 8 ? 4 : probe_phase == 9 ? 9 : 10); xcd_barrier(bar, wave_s == 0 && lane_id_hw() == 0); }
        if (RUN(3)) {
            Frame F; make_frame(F, lds, wave_s);
            SchedBr S; S.G = F.G; S.c = (int)blockIdx.x; S.A = (unsigned)WS_X; S.B = (unsigned)(WS_WCAT + (size_t)l * DM * DM * 2);
            EpiBr E{F.P, F.H};
            pg8::gemm_phase<EpiBr, SchedBr>(lds, (const char*)F.ws, S, E, wave_s);
            SEAM2(3);
        }
        if (RUN(4)) {
            Frame F; make_frame(F, lds, wave_s);
            SchedOut S; S.G = F.G; S.c = (int)blockIdx.x; S.A = (unsigned)WS_H; S.B = (unsigned)(WS_WOUT + (size_t)l * DM * DM * 2);
            EpiOut E{F.X, F.RSQ};
            pg8::gemm_phase<EpiOut, SchedOut>(lds, (const char*)F.ws, S, E, wave_s);
            SEAM2(4);
        }
        if (RUN(5)) { Frame F; make_frame(F, lds, wave_s); if (probing) F.out = (float*)F.P; post_norm_phase(F, probing ? 0 : l); SEAM2(5); }
#undef RUN
#undef SEAM2
    }
#undef IN
#undef SEAM
}

extern "C" void kernel_launch(void* const* d_in, const int* in_sizes, int n_in, void* d_out, int out_size, void* d_ws, size_t ws_size, hipStream_t stream) {
    static int grid = 0;
    if (grid == 0) {
        if (n_in != 16 || in_sizes[0] != TP * DM || in_sizes[1] != (T - TP) * DM || out_size != T * DM || ws_size < WS_END) {
            fprintf(stderr, "kernel_launch: shape mismatch (n_in %d, in0 %d, in1 %d, out %d, ws %zu need %zu); nothing launched\n", n_in, n_in > 0 ? in_sizes[0] : -1, n_in > 1 ? in_sizes[1] : -1, out_size, ws_size, (size_t)WS_END); grid = -1; return; }
        int dev = 0, cus = 0, per_cu = 0;
        if (hipGetDevice(&dev) != hipSuccess || hipDeviceGetAttribute(&cus, hipDeviceAttributeMultiprocessorCount, dev) != hipSuccess) { grid = -1; return; }
        if (hipFuncSetAttribute((const void*)fwd, hipFuncAttributeMaxDynamicSharedMemorySize, LDS_BYTES) != hipSuccess) { fprintf(stderr, "kernel_launch: hipFuncSetAttribute failed\n"); grid = -1; return; }
        if (hipOccupancyMaxActiveBlocksPerMultiprocessor(&per_cu, (const void*)fwd, NWAVES * 64, LDS_BYTES) != hipSuccess || per_cu < 1)
            fprintf(stderr, "kernel_launch: note: occupancy query reports %d workgroups per CU\n", per_cu);
        (void)hipGetLastError();
        grid = cus;
    }
    if (grid < 0) return;
    if (hipMemsetAsync((char*)d_ws + WS_CTL, 0, CTL_ZERO_BYTES, stream) != hipSuccess) { fprintf(stderr, "kernel_launch: memset failed\n"); return; }
    Args a{};
    for (int i = 0; i < 16; ++i) a.in[i] = (const float*)d_in[i];
    a.out = (float*)d_out; a.ws = (unsigned char*)d_ws; a.probe_phase = PROBE_PHASE; a.probe_reps = PROBE_REPS;
#if MK_ONE_LAUNCH
    a.ph_lo = 0; a.ph_hi = N_PHASES;
    hipLaunchKernelGGL(fwd, dim3(grid), dim3(NWAVES * 64), LDS_BYTES, stream, a);
#else
    for (int p = 0; p < N_PHASES; ++p) { a.ph_lo = p; a.ph_hi = p + 1; hipLaunchKernelGGL(fwd, dim3(grid), dim3(NWAVES * 64), LDS_BYTES, stream, a); }
#endif
    const hipError_t le = hipPeekAtLastError();
    if (le != hipSuccess) fprintf(stderr, "kernel_launch: launch failed: %s\n", hipGetErrorName(le));
}
```

```cpp
#include <hip/hip_runtime.h>
#include <cstdio>
#include <cstdint>

#ifndef FLASH_NA
#define FLASH_NA 1
#endif
#ifndef FLASH_SW
#define FLASH_SW 1
#endif
#ifndef FLASH_MEM
#define FLASH_MEM 1
#endif
#ifndef PROBE_PHASE
#define PROBE_PHASE 0
#endif
#ifndef PROBE_REPS
#define PROBE_REPS 0
#endif
#ifndef GATE_U8
#define GATE_U8 1
#endif
#ifndef GATES_FP8
#define GATES_FP8 1
#endif
#ifndef WGM_IN
#define WGM_IN 4
#endif
#ifndef WGM_SM
#define WGM_SM 4
#endif
#ifndef MK_ONE_LAUNCH
#define MK_ONE_LAUNCH 1
#endif

#define LAS __attribute__((address_space(3)))
#define GAS __attribute__((address_space(1)))
typedef unsigned short bf16_t;
typedef short bf16x8 __attribute__((ext_vector_type(8)));
typedef float f32x4 __attribute__((ext_vector_type(4)));
typedef float f32x2 __attribute__((ext_vector_type(2)));
typedef unsigned u32x4 __attribute__((ext_vector_type(4)));
typedef unsigned u32x2 __attribute__((ext_vector_type(2)));

constexpr int DM = 4096, NSEQ = 12, SEQ = 2048, T = NSEQ * SEQ  , DEPTH = 2, TP = 4 * SEQ  ;
constexpr int INW = 24576;
constexpr int MEMT = 256, MROWS = NSEQ * MEMT;
constexpr int KVW = 2048;
constexpr int QA = 0, KA = 1536, VA = 3072, ZA = 4608, QB = 6144, KB = 7680, VB = 8192, ZB = 8704, QM = 10240, ZM = 11264, GA = 12288;
constexpr float RMS_EPS = 1e-6f;
constexpr float LOG2E = 1.4426950408889634f;

constexpr size_t MiB = 1u << 20;
constexpr size_t WS_CTL = 0, CTL_ZERO_BYTES = 64 * 1024;
constexpr size_t WS_WIN = 1 * MiB;
constexpr size_t WS_WKV = WS_WIN + 2 * 192 * MiB;
constexpr size_t WS_WCAT = WS_WKV + 2 * 16 * MiB;
constexpr size_t WS_WOUT = WS_WCAT + 2 * 32 * MiB;
constexpr size_t WS_H = WS_WOUT + 2 * 32 * MiB;
constexpr size_t WS_X = WS_H + 192 * MiB;
constexpr size_t WS_P = WS_X + 192 * MiB;
constexpr size_t WS_MEMH = WS_P + 1152 * MiB;
constexpr size_t WS_KVM = WS_MEMH + 24 * MiB;
constexpr size_t WS_RSQ = WS_KVM + 2 * 12 * MiB;
constexpr size_t WS_H8 = WS_RSQ + 6 * MiB;
constexpr size_t WS_W8 = WS_H8 + 96 * MiB;
constexpr size_t WS_END = WS_W8 + 2 * 48 * MiB;
constexpr size_t WS_KNA = WS_WIN + 96 * MiB, WS_KSW = WS_KNA + 72 * MiB;
constexpr size_t WS_VNA = WS_WIN + 192 * MiB + 96 * MiB, WS_VSW = WS_VNA + 72 * MiB;
constexpr float H8_SCALE = 8.f, W8_SCALE = 256.f, G8_DESCALE = 1.0f / (8.f * 256.f);
constexpr int NGATE = 3 * DM;
constexpr int CW_BAR = 4096;

constexpr int RING_BYTES = 131072;
constexpr int LDSCTL_OFF = RING_BYTES, MISC_OFF = LDSCTL_OFF + 320;
constexpr int LDS_BYTES = 163840;
constexpr int NWAVES = 8;

__device__ __forceinline__ int lane_id_hw() { int l; asm volatile("v_mbcnt_lo_u32_b32 %0, -1, 0\n\tv_mbcnt_hi_u32_b32 %0, -1, %0" : "=v"(l)); return l; }
typedef float f32x2_t_ __attribute__((ext_vector_type(2))); typedef __bf16 bf16x2_t_ __attribute__((ext_vector_type(2)));
__device__ __forceinline__ unsigned cvt_pk_bf16(float lo, float hi) { const f32x2_t_ v = {lo, hi}; const bf16x2_t_ b = __builtin_convertvector(v, bf16x2_t_); return __builtin_bit_cast(unsigned, b); }
__device__ __forceinline__ unsigned pk4_fp8(float a, float b, float c, float d) { int w = __builtin_amdgcn_cvt_pk_fp8_f32(a, b, 0, false); w = __builtin_amdgcn_cvt_pk_fp8_f32(c, d, w, true); return (unsigned)w; }
__device__ __forceinline__ float bf_lo(unsigned w) { return __uint_as_float(w << 16); }
__device__ __forceinline__ float bf_hi(unsigned w) { return __uint_as_float(w & 0xffff0000u); }
__device__ __forceinline__ float sigmoid_f(float x) { return __builtin_amdgcn_rcpf(1.0f + __builtin_amdgcn_exp2f(-x * LOG2E)); }
__device__ __forceinline__ unsigned gate_q8(float g) { return (unsigned)fmaxf(g * 255.0f + 0.5f, 1.0f); }
__device__ __forceinline__ unsigned gate_pk4(const f32x4& g) { return gate_q8(g[0]) | (gate_q8(g[1]) << 8) | (gate_q8(g[2]) << 16) | (gate_q8(g[3]) << 24); }
__device__ __forceinline__ float ub0(unsigned w) { return (float)(w & 0xffu); }
__device__ __forceinline__ float ub1(unsigned w) { return (float)((w >> 8) & 0xffu); }
__device__ __forceinline__ float ub2(unsigned w) { return (float)((w >> 16) & 0xffu); }
__device__ __forceinline__ float ub3(unsigned w) { return (float)(w >> 24); }
__device__ __forceinline__ void gate_ratio4(f32x4& v, unsigned n, unsigned d) {
    v[0] *= ub0(n) * __builtin_amdgcn_rcpf(ub0(d)); v[1] *= ub1(n) * __builtin_amdgcn_rcpf(ub1(d)); v[2] *= ub2(n) * __builtin_amdgcn_rcpf(ub2(d)); v[3] *= ub3(n) * __builtin_amdgcn_rcpf(ub3(d)); }
__device__ __forceinline__ void gate_mul4(f32x4& v, unsigned g) { const float s = 1.0f / 255.0f; v[0] *= ub0(g) * s; v[1] *= ub1(g) * s; v[2] *= ub2(g) * s; v[3] *= ub3(g) * s; }

namespace pg8 {
constexpr int BM = 256, BK = 64, HALF = 128, HTB = HALF * BK * 2, STAGE_BYTES = 8 * HTB, NXCD = 8, WGM = 8;
constexpr size_t KSTEP = (size_t)BK * 2;
constexpr size_t TSTEP16 = (size_t)256 * 4096 * 2, TSTEP8 = (size_t)256 * 4096;
typedef int i32x4 __attribute__((ext_vector_type(4)));
typedef int i32x8 __attribute__((ext_vector_type(8)));
__device__ __forceinline__ i32x8 cat8(bf16x8 lo, bf16x8 hi) { return __builtin_shufflevector(__builtin_bit_cast(i32x4, lo), __builtin_bit_cast(i32x4, hi), 0, 1, 2, 3, 4, 5, 6, 7); }
__host__ __device__ __forceinline__ int lds_byte(int r, int c) { const int st = (r >> 4) * 2 + (c >> 5), rr = r & 15, cc = c & 31, ob = rr * 64 + cc * 2; return st * 1024 + (ob ^ (((ob >> 9) & 1) << 5)); }
__host__ __device__ __forceinline__ void stage_rc(int b, int& R, int& C) { const int st = b / 1024, sb = b % 1024, swz = sb ^ (((sb >> 9) & 1) << 5); R = (st >> 1) * 16 + swz / 64; C = (st & 1) * 32 + (swz % 64) / 2; }
__host__ __device__ __forceinline__ int perm32(int rho) { const int n = rho >> 4, i = rho & 15; return 8 * (i >> 2) + 4 * n + (i & 3); }

struct GUnit { unsigned ao, bo; int nt, pm, pn, kind; };

template <int WGM_> __device__ __forceinline__ void tile_of(int L, int nM, int nN, int& pm, int& pn) {
    const int nwg = nM * nN; int wgid = L;
    { const int q = nwg / NXCD, r = nwg % NXCD, xcd = wgid % NXCD, off = wgid / NXCD; wgid = (xcd < r ? xcd * (q + 1) : r * (q + 1) + (xcd - r) * q) + off; }
    const int nig = WGM_ * nN, gid = wgid / nig, fm = gid * WGM_, gsz = (nM - fm) < WGM_ ? (nM - fm) : WGM_;
    pm = fm + ((wgid % nig) % gsz); pn = (wgid % nig) / gsz;
}

#ifndef PG8_SP2
#define PG8_SP2 true
#endif
template <class Epi, class Sched, int PITCH = 8192, bool F8 = false, bool SP2 = PG8_SP2>
__device__ __forceinline__ void gemm_phase(LAS unsigned char* lds, const char* wsb, const Sched& S, const Epi& E, int wave_s) {
    const int lane = lane_id_hw(), wid = wave_s, tid = wid * 64 + lane;
    const int wr = wid >> 2, wc = wid & 3, fr = lane & 15, fq = lane >> 4;
    unsigned voffA[2], voffB[2];
#pragma unroll
    for (int i = 0; i < 2; ++i) { int R, C; stage_rc(tid * 16 + i * 8192, R, C); const int Rb = (R & ~31) + perm32(R & 31);
        voffA[i] = (unsigned)(R * PITCH + C * 2); voffB[i] = (unsigned)(Rb * PITCH + C * 2); }
    const unsigned kstep = (unsigned)KSTEP, hstep = (unsigned)HALF * PITCH;
    const unsigned ldsw = (unsigned)wid * 1024u;
    const int aoff = lds_byte(wr * 64 + fr, fq * 8), boff = lds_byte(wc * 32 + fr, fq * 8);
#define PG8_SA(b, h) (((b) * 2 + (h)) * HTB)
#define PG8_SB(b, h) ((4 + (b) * 2 + (h)) * HTB)
#define PG8_STAGE(bufoff, gbase, voff) do { unsigned _g = (gbase); asm volatile("" : "+s"(_g));   _Pragma("unroll") for (int _i = 0; _i < 2; ++_i) \
        __builtin_amdgcn_global_load_lds((const unsigned*)(wsb + (size_t)(unsigned)(_g + (voff)[_i])), (LAS unsigned*)(lds + (bufoff) + ldsw + _i * 8192), 16, 0, 0); } while (0)
#define PG8_LDA(dst, b, h) do { if constexpr (F8) { _Pragma("unroll") for (int m = 0; m < 4; ++m) dst##8[m] = cat8(*(const LAS bf16x8*)(lds + PG8_SA(b, h) + aoff + m * 2048), *(const LAS bf16x8*)(lds + PG8_SA(b, h) + aoff + m * 2048 + 1024)); } \
      else { _Pragma("unroll") for (int m = 0; m < 4; ++m) _Pragma("unroll") for (int k = 0; k < 2; ++k) dst[m][k] = *(const LAS bf16x8*)(lds + PG8_SA(b, h) + aoff + m * 2048 + k * 1024); } } while (0)
#define PG8_LDB(dst, b, h) do { if constexpr (F8) { _Pragma("unroll") for (int n = 0; n < 2; ++n) dst##8[n] = cat8(*(const LAS bf16x8*)(lds + PG8_SB(b, h) + boff + n * 2048), *(const LAS bf16x8*)(lds + PG8_SB(b, h) + boff + n * 2048 + 1024)); } \
      else { _Pragma("unroll") for (int n = 0; n < 2; ++n) _Pragma("unroll") for (int k = 0; k < 2; ++k) dst[n][k] = *(const LAS bf16x8*)(lds + PG8_SB(b, h) + boff + n * 2048 + k * 1024); } } while (0)
#define PG8_MMA(ai, bj, At, Bt) do { __builtin_amdgcn_s_setprio(1); if constexpr (F8) { _Pragma("unroll") for (int m = 0; m < 4; ++m) _Pragma("unroll") for (int n = 0; n < 2; ++n) \
        acc[ai][bj][m][n] = __builtin_amdgcn_mfma_scale_f32_16x16x128_f8f6f4(Bt##8[n], At##8[m], acc[ai][bj][m][n], 0, 0, 0, 0, 0, 0); } \
      else { _Pragma("unroll") for (int m = 0; m < 4; ++m) _Pragma("unroll") for (int n = 0; n < 2; ++n) _Pragma("unroll") for (int k = 0; k < 2; ++k) \
        acc[ai][bj][m][n] = __builtin_amdgcn_mfma_f32_16x16x32_bf16(Bt[n][k], At[m][k], acc[ai][bj][m][n], 0, 0, 0); } __builtin_amdgcn_s_setprio(0); } while (0)
#define PG8_WAIT_V(n) asm volatile("s_waitcnt vmcnt(" #n ")" ::: "memory")
#define PG8_WAIT_L(n) asm volatile("s_waitcnt lgkmcnt(" #n ")" ::: "memory")
#define PG8_BAR __builtin_amdgcn_s_barrier()
#define PG8_SCHED __builtin_amdgcn_sched_barrier(0)
    GUnit cur, nxt; int ui = 0;
    if (!S.next(0, cur)) return;
    f32x4 acc[2][2][4][2];
#pragma unroll
    for (int a = 0; a < 2; ++a)
#pragma unroll
        for (int b = 0; b < 2; ++b)
#pragma unroll
            for (int m = 0; m < 4; ++m)
#pragma unroll
                for (int n = 0; n < 2; ++n) acc[a][b][m][n] = (f32x4){0.f, 0.f, 0.f, 0.f};
    bf16x8 At[4][2], B0[2][2], B1[2][2]; i32x8 At8[4], B08[2], B18[2];
    unsigned cA = cur.ao, cB = cur.bo;
    if constexpr (SP2) {
        PG8_STAGE(PG8_SB(0, 0), cB, voffB); PG8_STAGE(PG8_SB(0, 1), cB + hstep, voffB); PG8_STAGE(PG8_SA(0, 0), cA, voffA); PG8_STAGE(PG8_SA(0, 1), cA + hstep, voffA);
        if (wr == 1) PG8_BAR;
        PG8_WAIT_V(2); PG8_BAR;
        PG8_STAGE(PG8_SB(1, 0), cB + kstep, voffB); PG8_STAGE(PG8_SA(1, 0), cA + kstep, voffA); PG8_STAGE(PG8_SB(1, 1), cB + hstep + kstep, voffB);
        PG8_WAIT_V(6); PG8_BAR;
    } else {
    PG8_STAGE(PG8_SB(0, 0), cB, voffB); PG8_STAGE(PG8_SA(0, 0), cA, voffA); PG8_STAGE(PG8_SB(0, 1), cB + hstep, voffB); PG8_STAGE(PG8_SA(0, 1), cA + hstep, voffA);
    if (wr == 1) PG8_BAR;
    PG8_WAIT_V(4); PG8_BAR;
    PG8_STAGE(PG8_SB(1, 0), cB + kstep, voffB); PG8_STAGE(PG8_SA(1, 0), cA + kstep, voffA); PG8_STAGE(PG8_SB(1, 1), cB + hstep + kstep, voffB);
    PG8_WAIT_V(6); PG8_BAR;
    }
    for (;;) {
        const bool has_next = S.next(ui + 1, nxt);
        const unsigned nA = has_next ? nxt.ao : cA, nB = has_next ? nxt.bo : cB;
        const int nt = cur.nt;
        for (int t = 0; t < nt; t += 2) {
            if constexpr (Epi::HAS_MID) { if (t == Epi::MID0 || t == Epi::MID1) { const int l2 = lane_id_hw(); E.mid(acc, cur, t == Epi::MID0 ? 0 : 1, wr, wc, l2 & 15, l2 >> 4); } }
            const bool last = (t == nt - 2);
            const unsigned a1 = cA + (unsigned)(t + 1) * kstep;
            const unsigned a2 = last ? nA : cA + (unsigned)(t + 2) * kstep, b2 = last ? nB : cB + (unsigned)(t + 2) * kstep;
            const unsigned a3 = a2 + kstep, b3 = b2 + kstep;
            if constexpr (SP2) {
            PG8_LDB(B0, 0, 0); PG8_LDB(B1, 0, 1); PG8_SCHED; PG8_LDA(At, 0, 0); PG8_STAGE(PG8_SA(1, 1), a1 + hstep, voffA);
            PG8_WAIT_V(8); PG8_WAIT_L(0); PG8_BAR; PG8_MMA(0, 0, At, B0); PG8_MMA(0, 1, At, B1); PG8_BAR; PG8_SCHED;
            PG8_LDA(At, 0, 1); PG8_STAGE(PG8_SB(0, 0), b2, voffB); PG8_STAGE(PG8_SB(0, 1), b2 + hstep, voffB); PG8_STAGE(PG8_SA(0, 0), a2, voffA);
            PG8_WAIT_V(8); PG8_WAIT_L(0); PG8_BAR; PG8_MMA(1, 0, At, B0); PG8_MMA(1, 1, At, B1); PG8_BAR; PG8_SCHED;
            PG8_LDB(B0, 1, 0); PG8_LDB(B1, 1, 1); PG8_SCHED; PG8_LDA(At, 1, 0); PG8_STAGE(PG8_SA(0, 1), a2 + hstep, voffA);
            PG8_WAIT_V(8); PG8_WAIT_L(0); PG8_BAR; PG8_MMA(0, 0, At, B0); PG8_MMA(0, 1, At, B1); PG8_BAR; PG8_SCHED;
            PG8_LDA(At, 1, 1); PG8_STAGE(PG8_SB(1, 0), b3, voffB); PG8_STAGE(PG8_SB(1, 1), b3 + hstep, voffB); PG8_STAGE(PG8_SA(1, 0), a3, voffA);
            PG8_WAIT_V(8); PG8_WAIT_L(0); PG8_BAR; PG8_MMA(1, 0, At, B0); PG8_MMA(1, 1, At, B1); PG8_BAR; PG8_SCHED;
            } else {
            PG8_LDB(B0, 0, 0); PG8_SCHED; PG8_LDA(At, 0, 0); PG8_STAGE(PG8_SA(1, 1), a1 + hstep, voffA);
            PG8_WAIT_L(8); PG8_BAR; PG8_WAIT_L(0); PG8_MMA(0, 0, At, B0); PG8_BAR; PG8_SCHED;
            PG8_LDB(B1, 0, 1); PG8_STAGE(PG8_SB(0, 0), b2, voffB);
            PG8_BAR; PG8_WAIT_L(0); PG8_MMA(0, 1, At, B1); PG8_BAR;
            PG8_LDA(At, 0, 1); PG8_STAGE(PG8_SA(0, 0), a2, voffA);
            PG8_BAR; PG8_WAIT_L(0); PG8_MMA(1, 0, At, B0); PG8_BAR; PG8_SCHED;
            PG8_STAGE(PG8_SB(0, 1), b2 + hstep, voffB);
            PG8_WAIT_V(6); PG8_BAR; PG8_MMA(1, 1, At, B1); PG8_BAR;
            PG8_LDB(B0, 1, 0); PG8_SCHED; PG8_LDA(At, 1, 0); PG8_STAGE(PG8_SA(0, 1), a2 + hstep, voffA);
            PG8_WAIT_L(8); PG8_BAR; PG8_WAIT_L(0); PG8_MMA(0, 0, At, B0); PG8_BAR; PG8_SCHED;
            PG8_LDB(B1, 1, 1); PG8_STAGE(PG8_SB(1, 0), b3, voffB);
            PG8_BAR; PG8_WAIT_L(0); PG8_MMA(0, 1, At, B1); PG8_BAR;
            PG8_LDA(At, 1, 1); PG8_STAGE(PG8_SA(1, 0), a3, voffA);
            PG8_BAR; PG8_WAIT_L(0); PG8_MMA(1, 0, At, B0); PG8_BAR; PG8_SCHED;
            PG8_STAGE(PG8_SB(1, 1), b3 + hstep, voffB);
            PG8_WAIT_V(6); PG8_BAR; PG8_MMA(1, 1, At, B1); PG8_BAR;
            }
        }
        { const int l2 = lane_id_hw(); E(acc, cur, wr, wc, l2 & 15, l2 >> 4); }
        if (!has_next) break;
#pragma unroll
        for (int a = 0; a < 2; ++a)
#pragma unroll
            for (int b = 0; b < 2; ++b)
#pragma unroll
                for (int m = 0; m < 4; ++m)
#pragma unroll
                    for (int n = 0; n < 2; ++n) acc[a][b][m][n] = (f32x4){0.f, 0.f, 0.f, 0.f};
        cur = nxt; cA = nA; cB = nB; ++ui;
    }
    PG8_WAIT_V(0);
    if (wr == 0) PG8_BAR;
    PG8_BAR;
#undef PG8_SA
#undef PG8_SB
#undef PG8_STAGE
#undef PG8_LDA
#undef PG8_LDB
#undef PG8_MMA
#undef PG8_WAIT_V
#undef PG8_WAIT_L
#undef PG8_BAR
#undef PG8_SCHED
}
}

struct SchedIn {
    int G, c, nextra; unsigned A, B, memA, memB0, memB1;
    __device__ __forceinline__ bool next(int i, pg8::GUnit& u) const {
        int L = i * G + c;
        constexpr int NN = GATES_FP8 ? 48 : 96;
        if (L < 96 * NN) { int pm, pn; pg8::tile_of<WGM_IN>(L, 96, NN, pm, pn); u.ao = A + (unsigned)pm * (unsigned)pg8::TSTEP16; u.bo = B + (unsigned)pn * (unsigned)pg8::TSTEP16; u.nt = 64; u.pm = pm; u.pn = pn; u.kind = 0; return true; }
        L -= 96 * NN; if (L >= nextra) return false;
        const int le = L / 96, r = L % 96, pm = r % 12, pn = r / 12;
        u.ao = memA + (unsigned)pm * (unsigned)pg8::TSTEP16; u.bo = (le ? memB1 : memB0) + (unsigned)pn * (unsigned)pg8::TSTEP16; u.nt = 64; u.pm = pm; u.pn = pn; u.kind = 1 + le; return true;
    }
};
struct EpiIn {   static constexpr bool HAS_MID = false; static constexpr int MID0 = -1, MID1 = -1;
    bf16_t* P; bf16_t* KVM0; bf16_t* KVM1; bf16_t* wsb16;
    __device__ __forceinline__ void operator()(const f32x4 (&acc)[2][2][4][2], const pg8::GUnit& u, int wr, int wc, int fr, int fq) const {
        bf16_t* base; int ldc, mode = 0, bjs = 128; int rowb = u.pm * 256 + wr * 64 + fr, colb = u.pn * 256 + wc * 32 + 8 * fq;
        if (u.kind == 0) { base = P; ldc = INW; const int pn = u.pn; if (pn >= GA / 256) mode = 1; else if ((pn >= ZA / 256 && pn < QB / 256) || (pn >= ZB / 256 && pn < QM / 256) || (pn >= ZM / 256)) mode = 2;
            if (GATES_FP8) {
                int nh = 0, hp = 0; size_t off = 0;
                if (pn >= KA / 256 && pn < VA / 256) { nh = 12; hp = pn - KA / 256; off = WS_KNA; } else if (pn >= VA / 256 && pn < ZA / 256) { nh = 12; hp = pn - VA / 256; off = WS_VNA; }
                else if (pn >= KB / 256 && pn < VB / 256) { nh = 4; hp = pn - KB / 256; off = WS_KSW; } else if (pn >= VB / 256 && pn < ZB / 256) { nh = 4; hp = pn - VB / 256; off = WS_VSW; }
                if (nh) { const int b = u.pm >> 3; base = wsb16 + off / 2; ldc = 128; bjs = SEQ * 128; rowb = (b * nh + 2 * hp) * SEQ + (u.pm & 7) * 256 + wr * 64 + fr; colb = wc * 32 + 8 * fq; } } }
        else { base = (u.kind == 1) ? KVM0 : KVM1; ldc = KVW; }
#pragma unroll
        for (int ai = 0; ai < 2; ++ai)
#pragma unroll
            for (int m = 0; m < 4; ++m) { GAS bf16_t* rowp = (GAS bf16_t*)base + (size_t)(rowb + ai * 128 + m * 16) * ldc + colb;
#pragma unroll
                for (int bj = 0; bj < 2; ++bj) { f32x4 v0 = acc[ai][bj][m][0], v1 = acc[ai][bj][m][1];
                    if (mode == 1) {
#pragma unroll
                        for (int j = 0; j < 4; ++j) { v0[j] = sigmoid_f(v0[j]); v1[j] = sigmoid_f(v1[j]); } }
                    else if (mode == 2) {
#pragma unroll
                        for (int j = 0; j < 4; ++j) { v0[j] = v0[j] * sigmoid_f(v0[j]); v1[j] = v1[j] * sigmoid_f(v1[j]); } }
                    u32x4 w; w.x = cvt_pk_bf16(v0[0], v0[1]); w.y = cvt_pk_bf16(v0[2], v0[3]); w.z = cvt_pk_bf16(v1[0], v1[1]); w.w = cvt_pk_bf16(v1[2], v1[3]);
                    *(GAS u32x4*)(rowp + (size_t)bj * bjs) = w; } }
    }
};
struct SchedIn8 {
    int G, c; unsigned A, B;
    __device__ __forceinline__ bool next(int i, pg8::GUnit& u) const {
        const int L = i * G + c; if (L >= 96 * 48) return false;
        int pm, pn; pg8::tile_of<WGM_IN>(L, 96, 48, pm, pn);
        u.ao = A + (unsigned)pm * (unsigned)pg8::TSTEP8; u.bo = B + (unsigned)pn * (unsigned)pg8::TSTEP8; u.nt = 32; u.pm = pm; u.pn = pn; u.kind = 0; return true;
    }
};
struct EpiIn8 {   static constexpr bool HAS_MID = false; static constexpr int MID0 = -1, MID1 = -1;
    bf16_t* P;
    __device__ __forceinline__ void operator()(const f32x4 (&acc)[2][2][4][2], const pg8::GUnit& u, int wr, int wc, int fr, int fq) const {
#if GATE_U8
        GAS unsigned char* gb = (GAS unsigned char*)P + (size_t)(u.pm * 256 + (wr * 4 + wc) * 32 + fq) * (INW * 2) + (GA * 2 + u.pn * 256 + fr * 16);
#pragma unroll
        for (int ai = 0; ai < 2; ++ai)
#pragma unroll
            for (int m = 0; m < 4; ++m) { u32x4 w; unsigned wq[4];
#pragma unroll
                for (int bj = 0; bj < 2; ++bj)
#pragma unroll
                    for (int n = 0; n < 2; ++n) { f32x4 v = acc[ai][bj][m][n];
#pragma unroll
                        for (int j = 0; j < 4; ++j) v[j] = __builtin_amdgcn_rcpf(1.0f + __builtin_amdgcn_exp2f(v[j] * (-LOG2E * G8_DESCALE)));
                        wq[bj * 2 + n] = gate_pk4(v); }
                w.x = wq[0]; w.y = wq[1]; w.z = wq[2]; w.w = wq[3];
                *(GAS u32x4*)(gb + (size_t)((ai * 4 + m) * 4) * (INW * 2)) = w; }
#else
        const int row0 = u.pm * 256 + wr * 64 + fr, col0 = GA + u.pn * 256 + wc * 32 + 8 * fq;
#pragma unroll
        for (int ai = 0; ai < 2; ++ai)
#pragma unroll
            for (int m = 0; m < 4; ++m) { GAS bf16_t* rowp = (GAS bf16_t*)P + (size_t)(row0 + ai * 128 + m * 16) * INW + col0;
#pragma unroll
                for (int bj = 0; bj < 2; ++bj) { f32x4 v0 = acc[ai][bj][m][0], v1 = acc[ai][bj][m][1];
#pragma unroll
                    for (int j = 0; j < 4; ++j) { v0[j] = __builtin_amdgcn_rcpf(1.0f + __builtin_amdgcn_exp2f(v0[j] * (-LOG2E * G8_DESCALE))); v1[j] = __builtin_amdgcn_rcpf(1.0f + __builtin_amdgcn_exp2f(v1[j] * (-LOG2E * G8_DESCALE))); }
                    u32x4 w; w.x = cvt_pk_bf16(v0[0], v0[1]); w.y = cvt_pk_bf16(v0[2], v0[3]); w.z = cvt_pk_bf16(v1[0], v1[1]); w.w = cvt_pk_bf16(v1[2], v1[3]);
                    *(GAS u32x4*)(rowp + bj * 128) = w; } }
#endif
    }
};
struct SchedBr {
    int G, c; unsigned A, B;
    __device__ __forceinline__ bool next(int i, pg8::GUnit& u) const {
        const int L = i * G + c; if (L >= 96 * 16) return false;
        int pm, pn; pg8::tile_of<WGM_SM>(L, 96, 16, pm, pn);
        u.ao = A + (unsigned)pm * (unsigned)pg8::TSTEP16; u.bo = B + (unsigned)pn * (unsigned)pg8::TSTEP16; u.nt = 64; u.pm = pm; u.pn = pn; u.kind = 0; return true;
    }
};
struct EpiBr {
    static constexpr bool HAS_MID = true; static constexpr int MID0 = 24, MID1 = 48;
    const bf16_t* P; bf16_t* Mg;
    __device__ __forceinline__ void mid(f32x4 (&acc)[2][2][4][2], const pg8::GUnit& u, int b, int wr, int wc, int fr, int fq) const {
#if GATE_U8
        const GAS unsigned char* gp = (const GAS unsigned char*)P + (size_t)(u.pm * 256 + (wr * 4 + wc) * 32 + fq) * (INW * 2) + (GA * 2 + (b * 16 + u.pn) * 256 + fr * 16);
        u32x4 gn[8], gd[8];
#pragma unroll
        for (int k = 0; k < 8; ++k) { const GAS unsigned char* q = gp + (size_t)(k * 4) * (INW * 2); gn[k] = *(const GAS u32x4*)q; gd[k] = *(const GAS u32x4*)(q + DM); }
#pragma unroll
        for (int k = 0; k < 8; ++k) { const int ai = k >> 2, m = k & 3;
            gate_ratio4(acc[ai][0][m][0], gn[k].x, gd[k].x); gate_ratio4(acc[ai][0][m][1], gn[k].y, gd[k].y); gate_ratio4(acc[ai][1][m][0], gn[k].z, gd[k].z); gate_ratio4(acc[ai][1][m][1], gn[k].w, gd[k].w); }
#else
        const int row0 = u.pm * 256 + wr * 64 + fr, col0 = u.pn * 256 + wc * 32 + 8 * fq;
        const GAS bf16_t* gp = (const GAS bf16_t*)P + (size_t)row0 * INW + GA + b * DM + col0;
#pragma unroll
        for (int ai = 0; ai < 2; ++ai) {
            u32x4 gn[4][2], gd[4][2];
#pragma unroll
            for (int m = 0; m < 4; ++m)
#pragma unroll
                for (int bj = 0; bj < 2; ++bj) { const GAS bf16_t* q = gp + (size_t)(ai * 128 + m * 16) * INW + bj * 128; gn[m][bj] = *(const GAS u32x4*)q; gd[m][bj] = *(const GAS u32x4*)(q + DM); }
#pragma unroll
            for (int m = 0; m < 4; ++m)
#pragma unroll
                for (int bj = 0; bj < 2; ++bj) { const u32x4 n4 = gn[m][bj], d4 = gd[m][bj];
                    f32x4& v0 = acc[ai][bj][m][0]; f32x4& v1 = acc[ai][bj][m][1];
                    v0[0] *= bf_lo(n4.x) * __builtin_amdgcn_rcpf(fmaxf(bf_lo(d4.x), 1e-30f)); v0[1] *= bf_hi(n4.x) * __builtin_amdgcn_rcpf(fmaxf(bf_hi(d4.x), 1e-30f));
                    v0[2] *= bf_lo(n4.y) * __builtin_amdgcn_rcpf(fmaxf(bf_lo(d4.y), 1e-30f)); v0[3] *= bf_hi(n4.y) * __builtin_amdgcn_rcpf(fmaxf(bf_hi(d4.y), 1e-30f));
                    v1[0] *= bf_lo(n4.z) * __builtin_amdgcn_rcpf(fmaxf(bf_lo(d4.z), 1e-30f)); v1[1] *= bf_hi(n4.z) * __builtin_amdgcn_rcpf(fmaxf(bf_hi(d4.z), 1e-30f));
                    v1[2] *= bf_lo(n4.w) * __builtin_amdgcn_rcpf(fmaxf(bf_lo(d4.w), 1e-30f)); v1[3] *= bf_hi(n4.w) * __builtin_amdgcn_rcpf(fmaxf(bf_hi(d4.w), 1e-30f)); }
        }
#endif
    }
    __device__ __forceinline__ void operator()(const f32x4 (&acc)[2][2][4][2], const pg8::GUnit& u, int wr, int wc, int fr, int fq) const {
        const int row0 = u.pm * 256 + wr * 64 + fr, col0 = u.pn * 256 + wc * 32 + 8 * fq;
        GAS bf16_t* mp0 = (GAS bf16_t*)Mg + (size_t)row0 * DM + col0;
#if GATE_U8
        const GAS unsigned char* gp = (const GAS unsigned char*)P + (size_t)(u.pm * 256 + (wr * 4 + wc) * 32 + fq) * (INW * 2) + (GA * 2 + (2 * 16 + u.pn) * 256 + fr * 16);
        u32x4 g[8];
#pragma unroll
        for (int k = 0; k < 8; ++k) g[k] = *(const GAS u32x4*)(gp + (size_t)(k * 4) * (INW * 2));
#pragma unroll
        for (int k = 0; k < 8; ++k) { const int ai = k >> 2, m = k & 3;
#pragma unroll
            for (int bj = 0; bj < 2; ++bj) { f32x4 v0 = acc[ai][bj][m][0], v1 = acc[ai][bj][m][1];
                gate_mul4(v0, bj ? g[k].z : g[k].x); gate_mul4(v1, bj ? g[k].w : g[k].y);
                u32x4 w; w.x = cvt_pk_bf16(v0[0], v0[1]); w.y = cvt_pk_bf16(v0[2], v0[3]); w.z = cvt_pk_bf16(v1[0], v1[1]); w.w = cvt_pk_bf16(v1[2], v1[3]);
                *(GAS u32x4*)(mp0 + (size_t)(ai * 128 + m * 16) * DM + bj * 128) = w; } }
#else
        const GAS bf16_t* gp = (const GAS bf16_t*)P + (size_t)row0 * INW + GA + 2 * DM + col0;
#pragma unroll
        for (int ai = 0; ai < 2; ++ai) {
            u32x4 g[4][2];
#pragma unroll
            for (int m = 0; m < 4; ++m)
#pragma unroll
                for (int bj = 0; bj < 2; ++bj) g[m][bj] = *(const GAS u32x4*)(gp + (size_t)(ai * 128 + m * 16) * INW + bj * 128);
#pragma unroll
            for (int m = 0; m < 4; ++m)
#pragma unroll
                for (int bj = 0; bj < 2; ++bj) { const u32x4 gg = g[m][bj];
                    f32x4 v0 = acc[ai][bj][m][0], v1 = acc[ai][bj][m][1];
                    v0[0] *= bf_lo(gg.x); v0[1] *= bf_hi(gg.x); v0[2] *= bf_lo(gg.y); v0[3] *= bf_hi(gg.y); v1[0] *= bf_lo(gg.z); v1[1] *= bf_hi(gg.z); v1[2] *= bf_lo(gg.w); v1[3] *= bf_hi(gg.w);
                    u32x4 w; w.x = cvt_pk_bf16(v0[0], v0[1]); w.y = cvt_pk_bf16(v0[2], v0[3]); w.z = cvt_pk_bf16(v1[0], v1[1]); w.w = cvt_pk_bf16(v1[2], v1[3]);
                    *(GAS u32x4*)(mp0 + (size_t)(ai * 128 + m * 16) * DM + bj * 128) = w; }
        }
#endif
    }
};
struct SchedOut {
    int G, c; unsigned A, B;
    __device__ __forceinline__ bool next(int i, pg8::GUnit& u) const {
        const int L = i * G + c; if (L >= 96 * 16) return false;
        int pm, pn; pg8::tile_of<WGM_SM>(L, 96, 16, pm, pn);
        u.ao = A + (unsigned)pm * (unsigned)pg8::TSTEP16; u.bo = B + (unsigned)pn * (unsigned)pg8::TSTEP16; u.nt = 64; u.pm = pm; u.pn = pn; u.kind = 0; return true;
    }
};
struct EpiOut {  static constexpr bool HAS_MID = false; static constexpr int MID0 = -1, MID1 = -1;
    bf16_t* O; float* RSQ;
    __device__ __forceinline__ void operator()(const f32x4 (&acc)[2][2][4][2], const pg8::GUnit& u, int wr, int wc, int fr, int fq) const {
        const int row0 = u.pm * 256 + wr * 64 + fr, col0 = u.pn * 256 + wc * 32 + 8 * fq;
#pragma unroll
        for (int ai = 0; ai < 2; ++ai)
#pragma unroll
            for (int m = 0; m < 4; ++m) { const size_t row = (size_t)(row0 + ai * 128 + m * 16); float s = 0.f;
#pragma unroll
                for (int bj = 0; bj < 2; ++bj) { const f32x4 v0 = acc[ai][bj][m][0], v1 = acc[ai][bj][m][1];
                    s += (v0[0] * v0[0] + v0[1] * v0[1]) + (v0[2] * v0[2] + v0[3] * v0[3]) + (v1[0] * v1[0] + v1[1] * v1[1]) + (v1[2] * v1[2] + v1[3] * v1[3]);
                    u32x4 w; w.x = cvt_pk_bf16(v0[0], v0[1]); w.y = cvt_pk_bf16(v0[2], v0[3]); w.z = cvt_pk_bf16(v1[0], v1[1]); w.w = cvt_pk_bf16(v1[2], v1[3]);
                    *(GAS u32x4*)((GAS bf16_t*)O + row * DM + col0 + bj * 128) = w; }
                { const int ln = fr + 16 * fq; s += __int_as_float(__builtin_amdgcn_ds_bpermute((ln ^ 16) << 2, __float_as_int(s))); s += __int_as_float(__builtin_amdgcn_ds_bpermute((ln ^ 32) << 2, __float_as_int(s))); }
                if (fq == 0) ((GAS float*)RSQ)[row * 64 + u.pn * 4 + wc] = s; }
    }
};

static_assert(!GATE_U8 || GATES_FP8, "GATE_U8 lives in the fp8 gate GEMM epilogue");
#define XB_TMO      128
#define XB_XCNT(j)  (256  + 64 * (j))
#define XB_XSUB(j)  (1280 + 64 * (j))
#define XB_XGEN(j)  (2304 + 64 * (j))
#define XB_TOP      3328
#define XB_TOPGEN   3392
#define XCD_BAR_WORDS 3456
#define XB_SPIN_CAP (1u << 18)
__device__ __forceinline__ unsigned xb_ld(unsigned* p)              { return __hip_atomic_load(p, __ATOMIC_RELAXED, __HIP_MEMORY_SCOPE_AGENT); }
__device__ __forceinline__ unsigned xb_add(unsigned* p, unsigned v) { return __hip_atomic_fetch_add(p, v, __ATOMIC_RELAXED, __HIP_MEMORY_SCOPE_AGENT); }
__device__ __forceinline__ unsigned xb_xcc_id() { return (unsigned)__builtin_amdgcn_s_getreg((3 << 11) | 20) & 0xFu; }
#define XB_SPIN(cond, bar) do { unsigned _sp = 0; while (cond) { __builtin_amdgcn_s_sleep(1); \
    if ((++_sp & 255u) == 0u) { if (xb_ld(&(bar)[XB_TMO])) break; if (_sp > XB_SPIN_CAP) { atomicAdd(&(bar)[XB_TMO], 1u); break; } } } } while (0)
struct XcdBarrier { unsigned* bar; unsigned x; volatile LAS unsigned* st; };
__device__ __forceinline__ XcdBarrier xcd_barrier_post(unsigned* bar, volatile LAS unsigned* st, bool leader) {
    XcdBarrier b; b.bar = bar; b.x = xb_xcc_id(); b.st = st;
    if (leader) (void)xb_add(&bar[XB_XCNT(b.x)], 1u);
    return b;
}
__device__ __forceinline__ void xcd_barrier_complete(unsigned* bar, unsigned x, unsigned& nloc, unsigned& nx) {
    const unsigned G = gridDim.x * gridDim.y * gridDim.z;
    unsigned sum, cnt, mine, sp = 0u;
    for (;;) {
        sum = 0u; cnt = 0u; mine = 0u;
#pragma unroll
        for (unsigned j = 0; j < 16; ++j) { const unsigned c = xb_ld(&bar[XB_XCNT(j)]); sum += c; cnt += (c > 0u) ? 1u : 0u; mine = (j == x) ? c : mine; }
        if (sum == G) break;
        __builtin_amdgcn_s_sleep(1);
        if ((++sp & 255u) == 0u) { if (xb_ld(&bar[XB_TMO])) break; if (sp > XB_SPIN_CAP) { atomicAdd(&bar[XB_TMO], 1u); break; } }
    }
    nloc = mine > 0u ? mine : 1u; nx = cnt > 0u ? cnt : 1u;
}
__device__ __forceinline__ void xcd_barrier(const XcdBarrier& b, bool leader) {
    asm volatile("s_waitcnt vmcnt(0)" ::: "memory");
    __syncthreads();
    if (leader) {
        unsigned* bar = b.bar;
        __builtin_amdgcn_s_waitcnt(0);
        unsigned nloc = b.st[0], nx = b.st[1];
        if (nloc == 0u) { xcd_barrier_complete(bar, b.x, nloc, nx); b.st[0] = nloc; b.st[1] = nx; }
        const unsigned old = xb_add(&bar[XB_XSUB(b.x)], 1u);
        const unsigned gen = old / nloc;
        if (old + 1u == (gen + 1u) * nloc) {
            __builtin_amdgcn_fence(__ATOMIC_RELEASE, "agent");
            asm volatile("s_waitcnt vmcnt(0)" ::: "memory");
            const unsigned og = xb_add(&bar[XB_TOP], 1u);
            const unsigned tg = og / nx;
            if (og + 1u == (tg + 1u) * nx) xb_add(&bar[XB_TOPGEN], 1u);
            else XB_SPIN(xb_ld(&bar[XB_TOPGEN]) == tg, bar);
            __builtin_amdgcn_fence(__ATOMIC_ACQUIRE, "agent");
            xb_add(&bar[XB_XGEN(b.x)], 1u);
            asm volatile("s_waitcnt vmcnt(0)" ::: "memory");
        } else {
            XB_SPIN(xb_ld(&bar[XB_XGEN(b.x)]) == gen, bar);
            __builtin_amdgcn_fence(__ATOMIC_ACQUIRE, "agent");
            asm volatile("s_waitcnt vmcnt(0)" ::: "memory");
        }
    }
    __syncthreads();
}

__device__ __forceinline__ float shfl_xor_l(float v, int mask, int lane) { return __int_as_float(__builtin_amdgcn_ds_bpermute((lane ^ mask) << 2, __float_as_int(v))); }
__device__ __forceinline__ float wave_sum(float v, int lane) {
#pragma unroll
    for (int o = 1; o < 64; o <<= 1) v += shfl_xor_l(v, o, lane);
    return v;
}
__device__ __forceinline__ unsigned f2bf(float f) { unsigned u = __builtin_bit_cast(unsigned, f); return (u + 0x7fffu + ((u >> 16) & 1u)) >> 16; }
__device__ __forceinline__ unsigned pk2(float lo, float hi) { return f2bf(lo) | (f2bf(hi) << 16); }

__device__ __forceinline__ void transpose_item(const float* W, int N, bf16_t* WT, int ldwt, int koff, const float* gain, LAS float* scr, int item, int lane, unsigned char* W8 = nullptr, int n8 = 0) {
    const int nblk = N / 32, kb = item / nblk, nb = item % nblk, k0 = 64 * kb, n0 = 32 * nb;
    const GAS float* wp = (const GAS float*)W + (size_t)(k0 + (lane >> 5)) * N + n0 + (lane & 31); float v[32];
#pragma unroll
    for (int i = 0; i < 32; ++i) v[i] = wp[(size_t)(2 * i) * N];
    if (gain) {
#pragma unroll
        for (int i = 0; i < 32; ++i) v[i] *= ((const GAS float*)gain)[k0 + 2 * i + (lane >> 5)]; }
#pragma unroll
    for (int i = 0; i < 32; ++i) scr[(2 * i + (lane >> 5)) * 33 + (lane & 31)] = v[i];
    asm volatile("s_waitcnt lgkmcnt(0)" ::: "memory");
    const int c = lane & 7;
    if (W8 && n0 >= n8) {
#pragma unroll
        for (int j = 0; j < 4; ++j) { const int n = (lane >> 3) + 8 * j; const LAS float* s = scr + (8 * c) * 33 + n;
            u32x2 o; o.x = pk4_fp8(s[0 * 33] * W8_SCALE, s[1 * 33] * W8_SCALE, s[2 * 33] * W8_SCALE, s[3 * 33] * W8_SCALE); o.y = pk4_fp8(s[4 * 33] * W8_SCALE, s[5 * 33] * W8_SCALE, s[6 * 33] * W8_SCALE, s[7 * 33] * W8_SCALE);
            *(GAS u32x2*)(W8 + (size_t)(n0 - n8 + n) * DM + k0 + 8 * c) = o; }
    } else {
#pragma unroll
    for (int j = 0; j < 4; ++j) { const int n = (lane >> 3) + 8 * j; const LAS float* s = scr + (8 * c) * 33 + n;
        u32x4 o; o.x = pk2(s[0 * 33], s[1 * 33]); o.y = pk2(s[2 * 33], s[3 * 33]); o.z = pk2(s[4 * 33], s[5 * 33]); o.w = pk2(s[6 * 33], s[7 * 33]);
        *(GAS u32x4*)(WT + (size_t)(n0 + n) * ldwt + koff + k0 + 8 * c) = o; }
    }
    asm volatile("s_waitcnt lgkmcnt(0)" ::: "memory");
}
__device__ __forceinline__ void rms_row_to_bf16(const float* xrow, const float* gain, bf16_t* orow, int lane, unsigned char* o8row = nullptr) {
    const GAS f32x4* xr = (const GAS f32x4*)xrow + lane;
    f32x4 v[16]; float s = 0.f;
#pragma unroll
    for (int j = 0; j < 16; ++j) { v[j] = xr[64 * j]; s += (v[j].x * v[j].x + v[j].y * v[j].y) + (v[j].z * v[j].z + v[j].w * v[j].w); }
    const float r = 1.0f / sqrtf(wave_sum(s, lane) * (1.0f / DM) + RMS_EPS);
    GAS u32x2* o8 = (GAS u32x2*)orow + lane;
#pragma unroll
    for (int j = 0; j < 16; ++j) { f32x4 g = gain ? ((const GAS f32x4*)gain)[lane + 64 * j] : (f32x4){1.f, 1.f, 1.f, 1.f};
        const float y0 = v[j].x * r * g.x, y1 = v[j].y * r * g.y, y2 = v[j].z * r * g.z, y3 = v[j].w * r * g.w;
        u32x2 w; w.x = cvt_pk_bf16(y0, y1); w.y = cvt_pk_bf16(y2, y3); o8[64 * j] = w;
        if (o8row) ((GAS unsigned*)o8row)[lane + 64 * j] = pk4_fp8(y0 * H8_SCALE, y1 * H8_SCALE, y2 * H8_SCALE, y3 * H8_SCALE); }
}

__device__ __forceinline__ int t5_bucket(int rel) {
    const int n = rel < 0 ? -rel : rel;
    const int b = n < 8 ? n : 8 + (n >= 12) + (n >= 16) + (n >= 23) + (n >= 32) + (n >= 46) + (n >= 64) + (n >= 91);
    return b + (rel > 0 ? 16 : 0);
}

struct Args { const float* in[16]; float* out; unsigned char* ws; int ph_lo, ph_hi, probe_phase, probe_reps; };
struct Frame {
    LAS unsigned char* lds;
    int tid, lane, wave, vcu, G;
    const float *xp, *xs, *memp, *mems, *pre_norm, *post_norm, *mem_norm, *w_in, *w_kv, *w_a, *w_b, *w_m, *w_out, *rpb, *sink, *t5;
    float* out;
    bf16_t *WinT, *WkvT, *WcatT, *WoutT, *H, *X, *P, *MEMH, *KVM; float* RSQ; unsigned char *H8, *W8, *ws;
};
__device__ __forceinline__ void make_frame(Frame& F, LAS unsigned char* lds, int wave_s) {
    const Args* ka = (const Args*)__builtin_amdgcn_kernarg_segment_ptr(); asm volatile("" : "+s"(ka));
    const int lane = lane_id_hw();
    F.lds = lds; F.lane = lane; F.wave = wave_s; F.tid = wave_s * 64 + lane;
    F.G = gridDim.x; { const int bx = blockIdx.x; F.vcu = (F.G % 8 == 0) ? (bx % 8) * (F.G / 8) + bx / 8 : bx; }
    F.xp = ka->in[0]; F.xs = ka->in[1]; F.memp = ka->in[2]; F.mems = ka->in[3]; F.pre_norm = ka->in[4]; F.post_norm = ka->in[5]; F.mem_norm = ka->in[6];
    F.w_in = ka->in[7]; F.w_kv = ka->in[8]; F.w_a = ka->in[9]; F.w_b = ka->in[10]; F.w_m = ka->in[11]; F.w_out = ka->in[12]; F.rpb = ka->in[13]; F.sink = ka->in[14]; F.t5 = ka->in[15];
    F.out = ka->out; unsigned char* ws = ka->ws; F.ws = ws;
    F.WinT = (bf16_t*)(ws + WS_WIN); F.WkvT = (bf16_t*)(ws + WS_WKV); F.WcatT = (bf16_t*)(ws + WS_WCAT); F.WoutT = (bf16_t*)(ws + WS_WOUT);
    F.H = (bf16_t*)(ws + WS_H); F.X = (bf16_t*)(ws + WS_X); F.P = (bf16_t*)(ws + WS_P); F.MEMH = (bf16_t*)(ws + WS_MEMH); F.KVM = (bf16_t*)(ws + WS_KVM); F.RSQ = (float*)(ws + WS_RSQ); F.H8 = ws + WS_H8; F.W8 = ws + WS_W8;
}

__device__ __forceinline__ void naive_attention(Frame& F, int l) {
    const int gw = F.vcu * NWAVES + F.wave, NGW = F.G * NWAVES, lane = F.lane;
    const bf16_t* P = F.P; bf16_t* X = F.X;
    if (!FLASH_NA) for (int it = gw; it < NSEQ * 12 * SEQ; it += NGW) {
        const int p = it % SEQ, h = (it / SEQ) % 12, b = it / (SEQ * 12);
        const int r = p >> 6, c = p & 63; int rs = r - 4; rs = rs < 0 ? 0 : (rs > 24 ? 24 : rs); int cs = c - 8; cs = cs < 0 ? 0 : (cs > 48 ? 48 : cs);
        const size_t row = (size_t)b * SEQ + p;
        const unsigned qw = *(const unsigned*)(P + row * INW + QA + h * 128 + 2 * lane); const float q0 = bf_lo(qw), q1 = bf_hi(qw);
        const float* rp = F.rpb + (size_t)(l * 12 + h) * 15 * 31;
        float m = -1e30f, ls = 0.f, o0 = 0.f, o1 = 0.f;
        for (int kr = rs; kr < rs + 8; ++kr)
#pragma unroll 4
          for (int kc = cs; kc < cs + 16; ++kc) {
            const size_t krow = (size_t)b * SEQ + kr * 64 + kc;
            const unsigned kw = *(const unsigned*)(P + krow * INW + KA + h * 128 + 2 * lane), vw = *(const unsigned*)(P + krow * INW + VA + h * 128 + 2 * lane);
            const float s = wave_sum(q0 * bf_lo(kw) + q1 * bf_hi(kw), lane) * 0.08838834764831845f + rp[(kr - r + 7) * 31 + (kc - c + 15)];
            const float mn = fmaxf(m, s), a = __expf(m - mn), pe = __expf(s - mn);
            ls = ls * a + pe; o0 = o0 * a + pe * bf_lo(vw); o1 = o1 * a + pe * bf_hi(vw); m = mn;
        }
        const unsigned zw = *(const unsigned*)(P + row * INW + ZA + h * 128 + 2 * lane); const float inv = 1.0f / ls;
        *(unsigned*)(X + row * DM + h * 128 + 2 * lane) = cvt_pk_bf16(o0 * inv * bf_lo(zw), o1 * inv * bf_hi(zw));
    }
    if (!FLASH_SW) for (int it = gw; it < NSEQ * 12 * SEQ; it += NGW) {
        const int p = it % SEQ, h = (it / SEQ) % 12, b = it / (SEQ * 12), kvh = h / 3;
        const size_t row = (size_t)b * SEQ + p;
        const unsigned qw = *(const unsigned*)(P + row * INW + QB + h * 128 + 2 * lane); const float q0 = bf_lo(qw), q1 = bf_hi(qw);
        float m = F.sink[l * 12 + h], ls = 1.f, o0 = 0.f, o1 = 0.f;
        const int j0 = p - 128 < 0 ? 0 : p - 128, j1 = p + 128 > SEQ - 1 ? SEQ - 1 : p + 128;
#pragma unroll 4
        for (int j = j0; j <= j1; ++j) {
            const size_t krow = (size_t)b * SEQ + j;
            const unsigned kw = *(const unsigned*)(P + krow * INW + KB + kvh * 128 + 2 * lane), vw = *(const unsigned*)(P + krow * INW + VB + kvh * 128 + 2 * lane);
            const float s = wave_sum(q0 * bf_lo(kw) + q1 * bf_hi(kw), lane) * 0.08838834764831845f + F.t5[t5_bucket(j - p) * 12 + h];
            const float mn = fmaxf(m, s), a = __expf(m - mn), pe = __expf(s - mn);
            ls = ls * a + pe; o0 = o0 * a + pe * bf_lo(vw); o1 = o1 * a + pe * bf_hi(vw); m = mn;
        }
        const unsigned zw = *(const unsigned*)(P + row * INW + ZB + h * 128 + 2 * lane); const float inv = 1.0f / ls;
        *(unsigned*)(X + row * DM + 1536 + h * 128 + 2 * lane) = cvt_pk_bf16(o0 * inv * bf_lo(zw), o1 * inv * bf_hi(zw));
    }
    const bf16_t* KV = F.KVM + (size_t)l * MROWS * KVW;
    if (!FLASH_MEM) for (int it = gw; it < NSEQ * 4 * SEQ; it += NGW) {
        const int p = it % SEQ, h = (it / SEQ) % 4, b = it / (SEQ * 4);
        const size_t row = (size_t)b * SEQ + p;
        const u32x2 qw = *(const u32x2*)(P + row * INW + QM + h * 256 + 4 * lane); const float q0 = bf_lo(qw.x), q1 = bf_hi(qw.x), q2 = bf_lo(qw.y), q3 = bf_hi(qw.y);
        float m = -1e30f, ls = 0.f, o0 = 0.f, o1 = 0.f, o2 = 0.f, o3 = 0.f;
#pragma unroll 4
        for (int j = 0; j < MEMT; ++j) {
            const size_t krow = (size_t)b * MEMT + j;
            const u32x2 kw = *(const u32x2*)(KV + krow * KVW + h * 256 + 4 * lane), vw = *(const u32x2*)(KV + krow * KVW + 1024 + h * 256 + 4 * lane);
            const float s = wave_sum((q0 * bf_lo(kw.x) + q1 * bf_hi(kw.x)) + (q2 * bf_lo(kw.y) + q3 * bf_hi(kw.y)), lane) * 0.0625f;
            const float mn = fmaxf(m, s), a = __expf(m - mn), pe = __expf(s - mn);
            ls = ls * a + pe; o0 = o0 * a + pe * bf_lo(vw.x); o1 = o1 * a + pe * bf_hi(vw.x); o2 = o2 * a + pe * bf_lo(vw.y); o3 = o3 * a + pe * bf_hi(vw.y); m = mn;
        }
        const u32x2 zw = *(const u32x2*)(P + row * INW + ZM + h * 256 + 4 * lane); const float inv = 1.0f / ls;
        u32x2 w; w.x = cvt_pk_bf16(o0 * inv * bf_lo(zw.x), o1 * inv * bf_hi(zw.x)); w.y = cvt_pk_bf16(o2 * inv * bf_lo(zw.y), o3 * inv * bf_hi(zw.y));
        *(u32x2*)(X + row * DM + 3072 + h * 256 + 4 * lane) = w;
    }
}


namespace fa {
typedef float f32x16 __attribute__((ext_vector_type(16)));
typedef short s16x4 __attribute__((ext_vector_type(4)));
constexpr int SHM_V = 16384, SHM_K = 16384;
constexpr int OFF_V = 0, OFF_K = 32768, OFF_OST = 65536  , OFF_WS = RING_BYTES + 2048, OFF_TBL = RING_BYTES + 4096, TBL_PAD = 256;
constexpr int OFF_WS_MEM = RING_BYTES + 1024, OFF_OST_MEM = RING_BYTES + 16384;
constexpr float THR2 = 11.5f;
constexpr float NEG = -1e30f;
#define FA_KSWZ(row, colB) ((row) * 256 + ((colB) ^ (((row) & 7) << 4)))
#define FA_SBAR() __builtin_amdgcn_sched_barrier(0)
__device__ __forceinline__ int crow(int r, int hi) { return (r & 3) + 8 * (r >> 2) + 4 * hi; }
__device__ __forceinline__ int v_st(int k, int c) { const int kk = (k & ~0xC) | ((k & 4) << 1) | ((k & 8) >> 1); return ((kk >> 3) * 4 + (c >> 5)) * 512 + ((kk & 7) * 32 + (c & 31)) * 2; }
__device__ __forceinline__ int v_rd_base(int lane) { return ((lane & 3) << 3) | (((lane >> 2) & 3) << 6) | (((lane >> 4) & 1) << 5) | (((lane >> 5) & 1) << 8); }
constexpr int v_rd_off(int d0, int ks, int half) { return d0 * 512 + ks * 4096 + half * 2048; }
template <int OFF> __device__ __forceinline__ s16x4 tr_read(int vb) { s16x4 r; asm volatile("ds_read_b64_tr_b16 %0, %1 offset:%2" : "=&v"(r) : "v"(vb), "i"(OFF) : "memory"); return r; }
template <int D0> __device__ __forceinline__ void pv_one(f32x16& od, int vb, bf16x8 pa0, bf16x8 pa1, bf16x8 pa2, bf16x8 pa3) {
    const s16x4 l0 = tr_read<v_rd_off(D0, 0, 0)>(vb), h0 = tr_read<v_rd_off(D0, 0, 1)>(vb), l1 = tr_read<v_rd_off(D0, 1, 0)>(vb), h1 = tr_read<v_rd_off(D0, 1, 1)>(vb);
    const s16x4 l2 = tr_read<v_rd_off(D0, 2, 0)>(vb), h2 = tr_read<v_rd_off(D0, 2, 1)>(vb), l3 = tr_read<v_rd_off(D0, 3, 0)>(vb), h3 = tr_read<v_rd_off(D0, 3, 1)>(vb);
    asm volatile("s_waitcnt lgkmcnt(0)" ::: "memory"); FA_SBAR();
#define FA_PK(L, H) (bf16x8){L[0], L[1], L[2], L[3], H[0], H[1], H[2], H[3]}
    od = __builtin_amdgcn_mfma_f32_32x32x16_bf16(pa0, FA_PK(l0, h0), od, 0, 0, 0);
    od = __builtin_amdgcn_mfma_f32_32x32x16_bf16(pa1, FA_PK(l1, h1), od, 0, 0, 0);
    od = __builtin_amdgcn_mfma_f32_32x32x16_bf16(pa2, FA_PK(l2, h2), od, 0, 0, 0);
    od = __builtin_amdgcn_mfma_f32_32x32x16_bf16(pa3, FA_PK(l3, h3), od, 0, 0, 0);
#undef FA_PK
}
__device__ __forceinline__ void pv_d0(f32x16* o, int vb, bf16x8 pa0, bf16x8 pa1, bf16x8 pa2, bf16x8 pa3) {
    pv_one<0>(o[0], vb, pa0, pa1, pa2, pa3); pv_one<1>(o[1], vb, pa0, pa1, pa2, pa3); pv_one<2>(o[2], vb, pa0, pa1, pa2, pa3); pv_one<3>(o[3], vb, pa0, pa1, pa2, pa3);
}
template <int P1T> __device__ __forceinline__ void qkt(f32x16& p0, f32x16& p1, const LAS unsigned char* Ks, const bf16x8* qr, int r32, int hi, const LAS float* tb) {
#pragma unroll
    for (int r = 0; r < 16; ++r) { const int k0 = (r & 3) + 8 * (r >> 2); p0[r] = tb[k0]; p1[r] = tb[P1T + k0]; }
#ifndef FA_KBATCH
#define FA_KBATCH 2
#endif
#pragma unroll
    for (int g = 0; g < 8 / FA_KBATCH; ++g) { bf16x8 kf0[FA_KBATCH], kf1[FA_KBATCH];
#pragma unroll
        for (int d = 0; d < FA_KBATCH; ++d) { const int cb = ((g * FA_KBATCH + d) * 16 + hi * 8) * 2; kf0[d] = *(const LAS bf16x8*)(Ks + FA_KSWZ(r32, cb)); kf1[d] = *(const LAS bf16x8*)(Ks + FA_KSWZ(32 + r32, cb)); }
        FA_SBAR();
#pragma unroll
        for (int d = 0; d < FA_KBATCH; ++d) { p0 = __builtin_amdgcn_mfma_f32_32x32x16_bf16(kf0[d], qr[g * FA_KBATCH + d], p0, 0, 0, 0); p1 = __builtin_amdgcn_mfma_f32_32x32x16_bf16(kf1[d], qr[g * FA_KBATCH + d], p1, 0, 0, 0); }
        FA_SBAR(); }
}
template <int P1V> __device__ __forceinline__ void apply_bias(f32x16& p0, f32x16& p1, int vb, unsigned vl0, unsigned vl1, float C) {
#pragma unroll
    for (int r = 0; r < 16; ++r) { const int k0 = (r & 3) + 8 * (r >> 2);
        const float x0 = p0[r] * C, x1 = p1[r] * C;
        p0[r] = ((unsigned)(vb + k0) < vl0) ? x0 : NEG; p1[r] = ((unsigned)(vb + P1V + k0) < vl1) ? x1 : NEG; }
}
__device__ __forceinline__ void partialSM(f32x16& p0, f32x16& p1, float& m_reg, float& alpha) {
    float pmax = p0[0];
#pragma unroll
    for (int r = 1; r < 16; ++r) pmax = fmaxf(pmax, p0[r]);
#pragma unroll
    for (int r = 0; r < 16; ++r) pmax = fmaxf(pmax, p1[r]);
    { auto rr = __builtin_amdgcn_permlane32_swap(__float_as_uint(pmax), __float_as_uint(pmax), false, false); pmax = fmaxf(__uint_as_float(rr[0]), __uint_as_float(rr[1])); }
    if (__builtin_expect(__all(pmax - m_reg <= THR2), 1)) { alpha = 1.f; }
    else { const float mn = fmaxf(m_reg, pmax); alpha = __builtin_amdgcn_exp2f(m_reg - mn); m_reg = mn; }
#pragma unroll
    for (int r = 0; r < 16; ++r) { p0[r] = __builtin_amdgcn_exp2f(p0[r] - m_reg); p1[r] = p1[r] - m_reg; }
}
#define FA_PK4(P, BASE, OUT) do { const unsigned a0 = cvt_pk_bf16(P[BASE + 0], P[BASE + 1]), a1 = cvt_pk_bf16(P[BASE + 2], P[BASE + 3]);   \
    const unsigned b0 = cvt_pk_bf16(P[BASE + 4], P[BASE + 5]), b1 = cvt_pk_bf16(P[BASE + 6], P[BASE + 7]);                              \
    auto r0 = __builtin_amdgcn_permlane32_swap(a0, b0, false, false); auto r1 = __builtin_amdgcn_permlane32_swap(a1, b1, false, false); \
    u32x4 w = {r0[0], r1[0], r0[1], r1[1]}; OUT = __builtin_bit_cast(bf16x8, w); } while (0)
__device__ __forceinline__ void finishSM(f32x16& p0, f32x16& p1, float alpha, float& l_reg, bf16x8& pa0, bf16x8& pa1, bf16x8& pa2, bf16x8& pa3) {
#pragma unroll
    for (int r = 0; r < 16; ++r) p1[r] = __builtin_amdgcn_exp2f(p1[r]);
    float ps = 0.f;
#pragma unroll
    for (int r = 0; r < 16; ++r) ps += p0[r];
#pragma unroll
    for (int r = 0; r < 16; ++r) ps += p1[r];
    { auto rr = __builtin_amdgcn_permlane32_swap(__float_as_uint(ps), __float_as_uint(ps), false, false); ps = __uint_as_float(rr[0]) + __uint_as_float(rr[1]); }
    l_reg = l_reg * alpha + ps;
    FA_PK4(p0, 0, pa0); FA_PK4(p0, 8, pa1); FA_PK4(p1, 0, pa2); FA_PK4(p1, 8, pa3);
}

struct FlashUnit {
    const bf16_t *Q, *K, *V, *Z; bf16_t* O;
    int NT, jlo, jhi;
    int tblo;
    float tv; int tcnt;
    int rsl;
    int lane_off, jstride, vbase, vstride; unsigned vlim;
    float m_init, l_init, C;
};
template <bool NA2>
__device__ __forceinline__ void flash_unit(LAS unsigned char* lds, const FlashUnit& U, int tid) {
    const int wid = __builtin_amdgcn_readfirstlane(tid >> 6), lane = tid & 63, r32 = lane & 31, hi = lane >> 5;
    constexpr int EHI = NA2 ? 64 : 16, KROW1 = NA2 ? 64 : 32, KTILE = NA2 ? 128 : 64, P1T = NA2 ? 31 : 32, P1V = NA2 ? 0 : 32;
    constexpr int KP = GATES_FP8 ? 128 : INW;
    const int ebase = NA2 ? wid * 128 : wid * 32;
    LAS unsigned char* V_lds = lds + OFF_V; LAS unsigned char* K_lds = lds + OFF_K;
    LAS float* wsx = (LAS float*)(lds + OFF_WS) + wid * 64; LAS float* li_l = wsx; LAS float* al_l = wsx + 32;
    const LAS float* tbl = (const LAS float*)(lds + U.tblo) + TBL_PAD + U.lane_off;
    float m_reg = U.m_init, l_reg = U.l_init; f32x16 o[4] = {}; bf16x8 qr[8];
    { const GAS char* Qw = (const GAS char*)U.Q; const unsigned qo = (unsigned)((ebase + (r32 & 15) + (r32 >> 4) * EHI) * INW + hi * 8) * 2u;
#pragma unroll
      for (int d0 = 0; d0 < 8; ++d0) qr[d0] = *(const GAS bf16x8*)(Qw + qo + d0 * 32); }
    const int sr = tid >> 4, sc = (tid & 15) * 8, vst0 = v_st(sr, sc), vst1 = v_st(32 + sr, sc), kst0 = FA_KSWZ(sr, sc * 2), kst1 = FA_KSWZ(32 + sr, sc * 2);
    const int vb0 = (int)(unsigned)(size_t)V_lds + v_rd_base(lane);
    const unsigned go0 = (unsigned)(sr * KP + sc) * 2u, go1 = (unsigned)((KROW1 + sr) * KP + sc) * 2u;
    constexpr size_t TILE_B = (size_t)KTILE * KP * 2;
    bf16x8 sv0[2], sv1[2], sk0[2], sk1[2];
#define FA_SLOAD(i, j) do { const GAS char* kt = (const GAS char*)U.K + (size_t)(j) * TILE_B; const GAS char* vt = (const GAS char*)U.V + (size_t)(j) * TILE_B; \
    sv0[i] = *(const GAS bf16x8*)(vt + go0); sv1[i] = *(const GAS bf16x8*)(vt + go1); sk0[i] = *(const GAS bf16x8*)(kt + go0); sk1[i] = *(const GAS bf16x8*)(kt + go1); } while (0)
#define FA_SWRITE(b, i) do { *(LAS bf16x8*)(V_lds + (b) * SHM_V + vst0) = sv0[i]; *(LAS bf16x8*)(V_lds + (b) * SHM_V + vst1) = sv1[i]; \
    *(LAS bf16x8*)(K_lds + (b) * SHM_K + kst0) = sk0[i]; *(LAS bf16x8*)(K_lds + (b) * SHM_K + kst1) = sk1[i]; } while (0)
    const int NT = U.NT;
    FA_SLOAD(0, 0); if (1 < NT) FA_SLOAD(1, 1);
    __builtin_amdgcn_sched_barrier(0);
    if (tid < U.tcnt) ((LAS float*)(lds + U.tblo))[TBL_PAD + tid] = U.tv * 11.313708498984761f;
#define FA_TILE(j, BUF) do { \
    FA_SWRITE(BUF, BUF); __syncthreads(); \
    if ((j) + 2 < NT) FA_SLOAD(BUF, (j) + 2); \
    if ((j) >= U.jlo && (j) < U.jhi) { f32x16 p0, p1; float alpha; bf16x8 pa0, pa1, pa2, pa3; \
        qkt<P1T>(p0, p1, K_lds + (BUF) * SHM_K, qr, r32, hi, tbl + (j) * U.jstride); \
        unsigned vl0 = U.vlim, vl1 = U.vlim; if constexpr (NA2) { vl0 = ((unsigned)(2 * (j) - U.rsl) < 8u) ? 16u : 0u; vl1 = ((unsigned)(2 * (j) + 1 - U.rsl) < 8u) ? 16u : 0u; } \
        apply_bias<P1V>(p0, p1, U.vbase + (j) * U.vstride, vl0, vl1, U.C); \
        partialSM(p0, p1, m_reg, alpha); finishSM(p0, p1, alpha, l_reg, pa0, pa1, pa2, pa3); \
        if (__any(alpha < 1.f)) { if (hi == 0) al_l[r32] = alpha; asm volatile("s_waitcnt lgkmcnt(0)" ::: "memory"); \
            _Pragma("unroll") for (int d = 0; d < 4; ++d) _Pragma("unroll") for (int r = 0; r < 16; ++r) o[d][r] *= al_l[crow(r, hi)]; } \
        pv_d0(o, vb0 + (BUF) * SHM_V, pa0, pa1, pa2, pa3); } } while (0)
    int j = 0;
    for (; j + 1 < NT; j += 2) { FA_TILE(j, 0); FA_TILE(j + 1, 1); }
    if (j < NT) FA_TILE(j, 0);
    { const GAS bf16_t* zb = (const GAS bf16_t*)U.Z + (size_t)ebase * INW; GAS bf16_t* ob = (GAS bf16_t*)U.O + (size_t)ebase * DM;
      int ln2 = lane; asm volatile("" : "+v"(ln2));
      u32x4 zv[8];
#pragma unroll
      for (int k = 0; k < 8; ++k) { const int ch = ln2 + 64 * k, row = ch >> 4, c16 = ch & 15, grow = (row & 15) + (row >> 4) * EHI; zv[k] = *(const GAS u32x4*)(zb + (size_t)grow * INW + c16 * 8); }
      if (hi == 0) li_l[r32] = l_reg; asm volatile("s_waitcnt lgkmcnt(0)" ::: "memory");
      LAS unsigned char* stg = lds + OFF_OST + wid * 8192;
#pragma unroll
      for (int r = 0; r < 16; ++r) { const int lr = crow(r, hi); const float rl = __builtin_amdgcn_rcpf(li_l[lr]);
#pragma unroll
          for (int d0 = 0; d0 < 4; ++d0) *(LAS bf16_t*)(stg + lr * 256 + (d0 * 32 + r32) * 2) = (bf16_t)f2bf(o[d0][r] * rl); }
      asm volatile("s_waitcnt lgkmcnt(0)" ::: "memory"); __builtin_amdgcn_sched_barrier(0);
#pragma unroll
      for (int k = 0; k < 8; ++k) { const int ch = ln2 + 64 * k, row = ch >> 4, c16 = ch & 15, grow = (row & 15) + (row >> 4) * EHI; const u32x4 ov = *(const LAS u32x4*)(stg + row * 256 + c16 * 16); const u32x4 z = zv[k];
          u32x4 w; w.x = cvt_pk_bf16(bf_lo(ov.x) * bf_lo(z.x), bf_hi(ov.x) * bf_hi(z.x)); w.y = cvt_pk_bf16(bf_lo(ov.y) * bf_lo(z.y), bf_hi(ov.y) * bf_hi(z.y));
          w.z = cvt_pk_bf16(bf_lo(ov.z) * bf_lo(z.z), bf_hi(ov.z) * bf_hi(z.z)); w.w = cvt_pk_bf16(bf_lo(ov.w) * bf_lo(z.w), bf_hi(ov.w) * bf_hi(z.w));
          *(GAS u32x4*)(ob + (size_t)grow * DM + c16 * 8) = w; } }
#undef FA_SLOAD
#undef FA_SWRITE
#undef FA_TILE
}

__device__ __forceinline__ void mem_unit(LAS unsigned char* lds, const bf16_t* Qb, const bf16_t* KVg, const bf16_t* Zb, bf16_t* Ob, int tid) {
    const int wid = __builtin_amdgcn_readfirstlane(tid >> 6), lane = tid & 63, r32 = lane & 31, hi = lane >> 5;
    bf16x8 kv[16];
#pragma unroll
    for (int i = 0; i < 16; ++i) { const int ch = i * 512 + tid, key = ch >> 5, c16 = ch & 31; kv[i] = *(const GAS bf16x8*)((const GAS bf16_t*)KVg + (size_t)key * KVW + c16 * 8); }
    __syncthreads();
#pragma unroll
    for (int i = 0; i < 16; ++i) { const int ch = i * 512 + tid, key = ch >> 5, c16 = ch & 31; *(LAS bf16x8*)(lds + key * 512 + ((c16 * 16) ^ ((key & 7) << 4))) = kv[i]; }
    __syncthreads();
    f32x16 p[8];
#pragma unroll
    for (int kb = 0; kb < 8; ++kb) p[kb] = (f32x16){};
    const GAS bf16_t* Qw = (const GAS bf16_t*)Qb + (size_t)(wid * 32 + r32) * INW + hi * 8;
#pragma unroll
    for (int d0 = 0; d0 < 16; ++d0) { const bf16x8 qf = *(const GAS bf16x8*)(Qw + d0 * 16); const int cb = (d0 * 32 + hi * 16) ^ ((r32 & 7) << 4);
#pragma unroll
        for (int kb = 0; kb < 8; ++kb) { const bf16x8 kf = *(const LAS bf16x8*)(lds + (kb * 32 + r32) * 512 + cb); p[kb] = __builtin_amdgcn_mfma_f32_32x32x16_bf16(kf, qf, p[kb], 0, 0, 0); } }
#pragma unroll
    for (int i = 0; i < 16; ++i) { const int ch = i * 512 + tid, key = ch >> 5, c16 = ch & 31; kv[i] = *(const GAS bf16x8*)((const GAS bf16_t*)KVg + (size_t)key * KVW + 1024 + c16 * 8); }
    constexpr float C2 = 0.0625f * LOG2E;
    float mx = p[0][0];
#pragma unroll
    for (int kb = 0; kb < 8; ++kb)
#pragma unroll
        for (int r = 0; r < 16; ++r) mx = fmaxf(mx, p[kb][r]);
    { auto rr = __builtin_amdgcn_permlane32_swap(__float_as_uint(mx), __float_as_uint(mx), false, false); mx = fmaxf(__uint_as_float(rr[0]), __uint_as_float(rr[1])); }
    const float mc = -mx * C2; float ls = 0.f;
#pragma unroll
    for (int kb = 0; kb < 8; ++kb)
#pragma unroll
        for (int r = 0; r < 16; ++r) { const float e = __builtin_amdgcn_exp2f(fmaf(p[kb][r], C2, mc)); p[kb][r] = e; ls += e; }
    { auto rr = __builtin_amdgcn_permlane32_swap(__float_as_uint(ls), __float_as_uint(ls), false, false); ls = __uint_as_float(rr[0]) + __uint_as_float(rr[1]); }
    bf16x8 pa[4][4];
#pragma unroll
    for (int g = 0; g < 4; ++g) { FA_PK4(p[2 * g], 0, pa[g][0]); FA_PK4(p[2 * g], 8, pa[g][1]); FA_PK4(p[2 * g + 1], 0, pa[g][2]); FA_PK4(p[2 * g + 1], 8, pa[g][3]); }
    __syncthreads();
#pragma unroll
    for (int i = 0; i < 16; ++i) { const int ch = i * 512 + tid, key = ch >> 5, c16 = ch & 31, d = c16 * 8;
        *(LAS bf16x8*)(lds + ((key >> 6) * 2 + (d >> 7)) * 16384 + v_st(key & 63, d & 127)) = kv[i]; }
    __syncthreads();
    const int vb0 = (int)(unsigned)(size_t)lds + v_rd_base(lane);
    LAS float* li_l = (LAS float*)(lds + OFF_WS_MEM) + wid * 32;
    if (hi == 0) li_l[r32] = ls; asm volatile("s_waitcnt lgkmcnt(0)" ::: "memory");
    LAS unsigned char* stg = lds + OFF_OST_MEM + wid * 2048;
#pragma unroll
    for (int dh = 0; dh < 2; ++dh) {
        int ln2 = lane; asm volatile("" : "+v"(ln2));
        const GAS bf16_t* zb = (const GAS bf16_t*)Zb + (size_t)(wid * 32) * INW + dh * 128; GAS bf16_t* ob = (GAS bf16_t*)Ob + (size_t)(wid * 32) * DM + dh * 128;
        u32x4 zv[8];
#pragma unroll
        for (int k = 0; k < 8; ++k) { const int ch = ln2 + 64 * k, row = ch >> 4, c16 = ch & 15; zv[k] = *(const GAS u32x4*)(zb + (size_t)row * INW + c16 * 8); }
        f32x16 o[4] = {};
#pragma unroll
        for (int g = 0; g < 4; ++g) pv_d0(o, vb0 + (g * 2 + dh) * 16384, pa[g][0], pa[g][1], pa[g][2], pa[g][3]);
#pragma unroll
        for (int p = 0; p < 4; ++p) {
#pragma unroll
            for (int q = 0; q < 4; ++q) { const int r = 4 * p + q, lr8 = q + 4 * hi; const float rl = __builtin_amdgcn_rcpf(li_l[8 * p + lr8]);
#pragma unroll
                for (int d0 = 0; d0 < 4; ++d0) *(LAS bf16_t*)(stg + lr8 * 256 + (d0 * 32 + r32) * 2) = (bf16_t)f2bf(o[d0][r] * rl); }
            asm volatile("s_waitcnt lgkmcnt(0)" ::: "memory");
#pragma unroll
            for (int k = 0; k < 2; ++k) { const int ch = ln2 + 64 * k, row8 = ch >> 4, c16 = ch & 15; const u32x4 ov = *(const LAS u32x4*)(stg + row8 * 256 + c16 * 16); const u32x4 z = zv[2 * p + k];
                u32x4 w; w.x = cvt_pk_bf16(bf_lo(ov.x) * bf_lo(z.x), bf_hi(ov.x) * bf_hi(z.x)); w.y = cvt_pk_bf16(bf_lo(ov.y) * bf_lo(z.y), bf_hi(ov.y) * bf_hi(z.y));
                w.z = cvt_pk_bf16(bf_lo(ov.z) * bf_lo(z.z), bf_hi(ov.z) * bf_hi(z.z)); w.w = cvt_pk_bf16(bf_lo(ov.w) * bf_lo(z.w), bf_hi(ov.w) * bf_hi(z.w));
                *(GAS u32x4*)(ob + (size_t)(8 * p + row8) * DM + c16 * 8) = w; }
            asm volatile("s_waitcnt lgkmcnt(0)" ::: "memory");
        }
    }
}
}

#ifndef FLASH_NA
#define FLASH_NA 1
#endif
#ifndef FLASH_SW
#define FLASH_SW 1
#endif
#ifndef FLASH_MEM
#define FLASH_MEM 1
#endif
__device__ __forceinline__ void attention_phase(Frame& F, int l, int mask = 7) {
    LAS unsigned char* lds = F.lds; const int tid = F.tid, G = F.G;
    int tpar = 0;
    const int wid = F.wave;
    if (FLASH_NA && (mask & 1)) for (int i = 0;; ++i) {
        const int u = i * G + F.vcu; if (u >= 1152) break;
        const int bh = u >> 3, blk = u & 7, b = bh / 12, h = bh % 12;
        const int ln = lane_id_hw(), r32 = ln & 31, hi = ln >> 5;
        fa::FlashUnit U; U.C = 0.08838834764831845f * LOG2E; U.tblo = fa::OFF_TBL + tpar * 4096; tpar ^= 1;
        const int rb = blk >> 2, cb = blk & 3, lo = rb ? 12 : 0; U.NT = 10;
        int c0 = 16 * cb - 8; c0 = c0 < 0 ? 0 : (c0 > 32 ? 32 : c0);
        const size_t tok0 = (size_t)b * SEQ + rb * 1024 + cb * 16;
        const int qr = 16 * rb + 2 * wid + (r32 >> 4), qc = 16 * cb + (r32 & 15);
        int rs = qr - 4; rs = rs < 0 ? 0 : (rs > 24 ? 24 : rs); int cs = qc - 8; cs = cs < 0 ? 0 : (cs > 48 ? 48 : cs);
        int rsA = 16 * rb + 2 * wid - 4; rsA = rsA < 0 ? 0 : (rsA > 24 ? 24 : rsA); int rsB = 16 * rb + 2 * wid - 3; rsB = rsB < 0 ? 0 : (rsB > 24 ? 24 : rsB);
        U.Q = F.P + tok0 * INW + QA + h * 128; if (GATES_FP8) { const size_t ko = ((size_t)(b * 12 + h) * SEQ + lo * 64 + c0) * 128; U.K = (const bf16_t*)(F.ws + WS_KNA) + ko; U.V = (const bf16_t*)(F.ws + WS_VNA) + ko; }
        else { U.K = F.P + ((size_t)b * SEQ + lo * 64 + c0) * INW + KA + h * 128; U.V = U.K + (VA - KA); } U.Z = F.P + tok0 * INW + ZA + h * 128; U.O = F.X + tok0 * DM + h * 128;
        U.jlo = (rsA - lo) >> 1; U.jhi = ((rsB + 7 - lo) >> 1) + 1; U.rsl = rs - lo;
        U.lane_off = (lo - qr + 7) * 31 + (c0 - qc + 15) + 4 * hi; U.jstride = 62; U.vbase = c0 - cs + 4 * hi; U.vstride = 0; U.vlim = 16u;
        U.m_init = -30000.f; U.l_init = 0.f;
        const float* rp = F.rpb + (size_t)(l * 12 + h) * 465;
        { const int k = wid * 64 + ln; U.tcnt = 465; U.tv = (k < 465) ? ((const GAS float*)rp)[k] : 0.f; }
        if (mask & 8) U.jhi = U.jlo;
        fa::flash_unit<true>(lds, U, wid * 64 + ln);
    }
    if (FLASH_SW && (mask & 2)) for (int i = 0;; ++i) {
        int u = i * G + F.vcu; if (u >= 1152) break;
        int bh, blk;
        if (u < 864) { bh = u / 6; blk = 1 + u % 6; } else { u -= 864; bh = u >> 1; blk = (u & 1) * 7; }
        const int b = bh / 12, h = bh % 12;
        const int ln = lane_id_hw(), r32 = ln & 31, hi = ln >> 5;
        fa::FlashUnit U; U.C = 0.08838834764831845f * LOG2E; U.tblo = fa::OFF_TBL + tpar * 4096; tpar ^= 1; const size_t row0 = (size_t)b * SEQ + blk * 256;
        const int t0 = 256 * blk, kt0 = (blk == 0) ? 0 : t0 - 128; U.NT = (blk == 0 || blk == 7) ? 6 : 8;
        const int tq = t0 + 32 * wid + r32;
        U.Q = F.P + row0 * INW + QB + h * 128; if (GATES_FP8) { const size_t ko = ((size_t)(b * 4 + h / 3) * SEQ + kt0) * 128; U.K = (const bf16_t*)(F.ws + WS_KSW) + ko; U.V = (const bf16_t*)(F.ws + WS_VSW) + ko; }
        else { U.K = F.P + ((size_t)b * SEQ + kt0) * INW + KB + (h / 3) * 128; U.V = U.K + (VB - KB); } U.Z = F.P + row0 * INW + ZB + h * 128; U.O = F.X + row0 * DM + 1536 + h * 128;
        const int a = t0 + 32 * wid - 128 - kt0, bnd = t0 + 32 * wid + 159 - kt0; U.jlo = a <= 0 ? 0 : (a >> 6); { const int jh = (bnd >> 6) + 1; U.jhi = jh < U.NT ? jh : U.NT; }
        U.lane_off = kt0 - tq + 128 + 4 * hi; U.jstride = 64; U.vbase = U.lane_off; U.vstride = 64; U.vlim = 257u;
        U.m_init = F.sink[l * 12 + h] * LOG2E; U.l_init = 1.f; U.rsl = 0;
        { const int k = wid * 64 + ln; U.tcnt = 257; U.tv = (k < 257) ? ((const GAS float*)F.t5)[t5_bucket(k - 128) * 12 + h] : 0.f; }
        if (mask & 8) U.jhi = U.jlo;
        fa::flash_unit<false>(lds, U, wid * 64 + ln);
    }
    __syncthreads();
#if FLASH_MEM
    const bf16_t* KV = F.KVM + (size_t)l * MROWS * KVW;
    if (mask & 4) for (int i = 0;; ++i) {
        const int u = i * G + (G - 1 - F.vcu); if (u >= 384) break;
        const int bh = u >> 3, qb = u & 7, b = bh >> 2, h = bh & 3; const size_t row0 = (size_t)b * SEQ + qb * 256;
        fa::mem_unit(lds, F.P + row0 * INW + QM + h * 256, KV + (size_t)b * MEMT * KVW + h * 256, F.P + row0 * INW + ZM + h * 256, F.X + row0 * DM + 3072 + h * 256, F.wave * 64 + lane_id_hw());
    }
    __syncthreads();
#endif
}

__device__ __forceinline__ const float* x_row(const Frame& F, int m) { return m < TP ? F.xp + (size_t)m * DM : F.xs + (size_t)(m - TP) * DM; }

__device__ __forceinline__ void p0_prologue(Frame& F) {
    LAS float* scr = (LAS float*)(F.lds + F.wave * 16384);
    const int gw = F.vcu * NWAVES + F.wave, NGW = F.G * NWAVES;
    constexpr int I_IN = (DM / 64) * (INW / 32), I_KV = (DM / 64) * (KVW / 32), I_A = (1536 / 64) * (DM / 32), I_M = (1024 / 64) * (DM / 32), I_O = (DM / 64) * (DM / 32);
    constexpr int PER_L = I_IN + I_KV + 2 * I_A + I_M + I_O;
    for (int it = gw; it < DEPTH * PER_L; it += NGW) {
        const int l = it / PER_L; int r = it - l * PER_L;
        if (r < I_IN) { transpose_item(F.w_in + (size_t)l * DM * INW, INW, F.WinT + (size_t)l * INW * DM, DM, 0, nullptr, scr, r, F.lane, GATES_FP8 ? F.W8 + (size_t)l * NGATE * DM : nullptr, GA); continue; } r -= I_IN;
        if (r < I_KV) { transpose_item(F.w_kv + (size_t)l * DM * KVW, KVW, F.WkvT + (size_t)l * KVW * DM, DM, 0, F.mem_norm + l * DM, scr, r, F.lane); continue; } r -= I_KV;
        bf16_t* wc = F.WcatT + (size_t)l * DM * DM;
        if (r < I_A) { transpose_item(F.w_a + (size_t)l * 1536 * DM, DM, wc, DM, 0, nullptr, scr, r, F.lane); continue; } r -= I_A;
        if (r < I_A) { transpose_item(F.w_b + (size_t)l * 1536 * DM, DM, wc, DM, 1536, nullptr, scr, r, F.lane); continue; } r -= I_A;
        if (r < I_M) { transpose_item(F.w_m + (size_t)l * 1024 * DM, DM, wc, DM, 3072, nullptr, scr, r, F.lane); continue; } r -= I_M;
        transpose_item(F.w_out + (size_t)l * DM * DM, DM, F.WoutT + (size_t)l * DM * DM, DM, 0, nullptr, scr, r, F.lane);
    }
    for (int m = gw; m < T; m += NGW) rms_row_to_bf16(x_row(F, m), F.pre_norm, F.H + (size_t)m * DM, F.lane, GATES_FP8 ? F.H8 + (size_t)m * DM : nullptr);
    for (int m = gw; m < MROWS; m += NGW) rms_row_to_bf16(m < 4 * MEMT ? F.memp + (size_t)m * DM : F.mems + (size_t)(m - 4 * MEMT) * DM, nullptr, F.MEMH + (size_t)m * DM, F.lane);
}
__device__ __forceinline__ void post_norm_phase(Frame& F, int l) {
    const int gw = F.vcu * NWAVES + F.wave, NGW = F.G * NWAVES, lane = F.lane;
    const float* pg = F.post_norm + l * DM; const float* npre = (l + 1 < DEPTH) ? F.pre_norm + (l + 1) * DM : nullptr;
    for (int m = gw; m < T; m += NGW) {
        const GAS u32x2* orow = (const GAS u32x2*)(F.X + (size_t)m * DM) + lane;
        GAS u32x2* x1row = (GAS u32x2*)(F.P + (size_t)m * INW + 18432) + lane;
        GAS f32x4* yo = (GAS f32x4*)(F.out + (size_t)m * DM) + lane;
        f32x4 v[16]; u32x2 ov[16]; float s2 = 0.f;
        if (l == 0) { const GAS f32x4* xr = (const GAS f32x4*)x_row(F, m) + lane;
#pragma unroll
            for (int j = 0; j < 16; ++j) { v[j] = xr[64 * j]; ov[j] = orow[64 * j]; } }
        else {
#pragma unroll
            for (int j = 0; j < 16; ++j) { const u32x2 xw = x1row[64 * j]; ov[j] = orow[64 * j]; v[j].x = bf_lo(xw.x); v[j].y = bf_hi(xw.x); v[j].z = bf_lo(xw.y); v[j].w = bf_hi(xw.y); } }
        __builtin_amdgcn_sched_barrier(0);
        const float ss = wave_sum(F.RSQ[(size_t)m * 64 + lane], lane);
        const float r = 1.0f / sqrtf(ss * (1.0f / DM) + RMS_EPS);
#pragma unroll
        for (int j = 0; j < 16; ++j) { const f32x4 x = v[j]; const u32x2 ow = ov[j]; const f32x4 g = ((const GAS f32x4*)pg)[lane + 64 * j];
            f32x4 y; y.x = x.x + bf_lo(ow.x) * r * g.x; y.y = x.y + bf_hi(ow.x) * r * g.y; y.z = x.z + bf_lo(ow.y) * r * g.z; y.w = x.w + bf_hi(ow.y) * r * g.w;
            v[j] = y; s2 += (y.x * y.x + y.y * y.y) + (y.z * y.z + y.w * y.w);
            if (npre) { u32x2 w; w.x = cvt_pk_bf16(y.x, y.y); w.y = cvt_pk_bf16(y.z, y.w); x1row[64 * j] = w; } else yo[64 * j] = y; }
        if (npre) {
            const float r2 = 1.0f / sqrtf(wave_sum(s2, lane) * (1.0f / DM) + RMS_EPS);
            GAS u32x2* h8 = (GAS u32x2*)(F.H + (size_t)m * DM) + lane;
#pragma unroll
            for (int j = 0; j < 16; ++j) { const f32x4 g = ((const GAS f32x4*)npre)[lane + 64 * j];
                const float y0 = v[j].x * r2 * g.x, y1 = v[j].y * r2 * g.y, y2 = v[j].z * r2 * g.z, y3 = v[j].w * r2 * g.w;
                u32x2 w; w.x = cvt_pk_bf16(y0, y1); w.y = cvt_pk_bf16(y2, y3); h8[64 * j] = w;
                if (GATES_FP8) ((GAS unsigned*)(F.H8 + (size_t)m * DM))[lane + 64 * j] = pk4_fp8(y0 * H8_SCALE, y1 * H8_SCALE, y2 * H8_SCALE, y3 * H8_SCALE); }
        }
    }
}

constexpr int N_PHASES = 1 + 5 * DEPTH;
__global__ void __launch_bounds__(NWAVES * 64, 2) fwd(Args args) {
    extern __shared__ __attribute__((aligned(16))) unsigned char lds_raw[];
    LAS unsigned char* lds = (LAS unsigned char*)lds_raw;
    const int wave_s = __builtin_amdgcn_readfirstlane((int)threadIdx.x >> 6);
    for (int u = wave_s * 64 + lane_id_hw(); u < (LDS_BYTES - LDSCTL_OFF) / 4; u += NWAVES * 64) ((LAS unsigned*)(lds + LDSCTL_OFF))[u] = 0u;
    __syncthreads();
    unsigned* const barw = (unsigned*)(args.ws + WS_CTL) + CW_BAR;
    XcdBarrier bar; bar.bar = barw; bar.x = 0; bar.st = nullptr;
    if (MK_ONE_LAUNCH) bar = xcd_barrier_post(barw, (volatile LAS unsigned*)(lds + MISC_OFF) + 8, wave_s == 0 && lane_id_hw() == 0);
    const int lo = args.ph_lo, hi = args.ph_hi;
#define IN(k) (lo <= (k) && (k) < hi)
#define SEAM(k) do { if (IN(k) && IN((k) + 1)) xcd_barrier(bar, wave_s == 0 && lane_id_hw() == 0); } while (0)

    const int probe_phase = args.probe_phase, n_iter = DEPTH + args.probe_reps;
    if (IN(0)) { Frame F; make_frame(F, lds, wave_s); p0_prologue(F); SEAM(0); }
    for (int it = 0; it < n_iter; ++it) {
        const bool probing = it >= DEPTH; const int l = probing ? ((it - DEPTH) & 1) : it;
        const int pb = 1 + 5 * l;
        if (probing && it == DEPTH) xcd_barrier(bar, wave_s == 0 && lane_id_hw() == 0);
#define RUN(k) (probing ? (probe_phase == (k)) : IN(pb + (k) - 1))
#define SEAM2(k) do { if (probing || (IN(pb + (k) - 1) && IN(pb + (k)))) xcd_barrier(bar, wave_s == 0 && lane_id_hw() == 0); } while (0)
        if (RUN(1)) {
            Frame F; make_frame(F, lds, wave_s);
            SchedIn S; S.G = F.G; S.c = (int)blockIdx.x; S.nextra = (l == 0) ? 2 * 96 : 0; S.A = (unsigned)WS_H; S.B = (unsigned)(WS_WIN + (size_t)l * INW * DM * 2);
            S.memA = (unsigned)WS_MEMH; S.memB0 = (unsigned)WS_WKV; S.memB1 = (unsigned)(WS_WKV + (size_t)KVW * DM * 2);
            EpiIn E{F.P, F.KVM, F.KVM + (size_t)MROWS * KVW, (bf16_t*)F.ws};
            pg8::gemm_phase<EpiIn, SchedIn>(lds, (const char*)F.ws, S, E, wave_s);
            SEAM2(1);
        }
        if (RUN(2)) { Frame F; make_frame(F, lds, wave_s); attention_phase(F, l); if (!(FLASH_NA && FLASH_SW && FLASH_MEM)) naive_attention(F, l); if (!GATES_FP8) SEAM2(2); }
        if (GATES_FP8 && RUN(2)) {
            Frame F; make_frame(F, lds, wave_s);
            SchedIn8 S8; S8.G = F.G; S8.c = (int)blockIdx.x; S8.A = (unsigned)WS_H8; S8.B = (unsigned)(WS_W8 + (size_t)l * NGATE * DM);
            EpiIn8 E8{F.P};
            pg8::gemm_phase<EpiIn8, SchedIn8, 4096, true>(lds, (const char*)F.ws, S8, E8, wave_s);
            SEAM2(2);
        }
        if (probing && probe_phase >= 6) { Frame F; make_frame(F, lds, wave_s); attention_phase(F, l, probe_phase == 6 ? 1 : probe_phase == 7 ? 2 : probe_phase == 8 ? 4 : probe_phase == 9 ? 9 : 10); xcd_barrier(bar, wave_s == 0 && lane_id_hw() == 0); }
        if (RUN(3)) {
            Frame F; make_frame(F, lds, wave_s);
            SchedBr S; S.G = F.G; S.c = (int)blockIdx.x; S.A = (unsigned)WS_X; S.B = (unsigned)(WS_WCAT + (size_t)l * DM * DM * 2);
            EpiBr E{F.P, F.H};
            pg8::gemm_phase<EpiBr, SchedBr>(lds, (const char*)F.ws, S, E, wave_s);
            SEAM2(3);
        }
        if (RUN(4)) {
            Frame F; make_frame(F, lds, wave_s);
            SchedOut S; S.G = F.G; S.c = (int)blockIdx.x; S.A = (unsigned)WS_H; S.B = (unsigned)(WS_WOUT + (size_t)l * DM * DM * 2);
            EpiOut E{F.X, F.RSQ};
            pg8::gemm_phase<EpiOut, SchedOut>(lds, (const char*)F.ws, S, E, wave_s);
            SEAM2(4);
        }
        if (RUN(5)) { Frame F; make_frame(F, lds, wave_s); if (probing) F.out = (float*)F.P; post_norm_phase(F, probing ? 0 : l); SEAM2(5); }
#undef RUN
#undef SEAM2
    }
#undef IN
#undef SEAM
}

extern "C" void kernel_launch(void* const* d_in, const int* in_sizes, int n_in, void* d_out, int out_size, void* d_ws, size_t ws_size, hipStream_t stream) {
    static int grid = 0;
    if (grid == 0) {
        if (n_in != 16 || in_sizes[0] != TP * DM || in_sizes[1] != (T - TP) * DM || out_size != T * DM || ws_size < WS_END) {
            fprintf(stderr, "kernel_launch: shape mismatch (n_in %d, in0 %d, in1 %d, out %d, ws %zu need %zu); nothing launched\n", n_in, n_in > 0 ? in_sizes[0] : -1, n_in > 1 ? in_sizes[1] : -1, out_size, ws_size, (size_t)WS_END); grid = -1; return; }
        int dev = 0, cus = 0, per_cu = 0;
        if (hipGetDevice(&dev) != hipSuccess || hipDeviceGetAttribute(&cus, hipDeviceAttributeMultiprocessorCount, dev) != hipSuccess) { grid = -1; return; }
        if (hipFuncSetAttribute((const void*)fwd, hipFuncAttributeMaxDynamicSharedMemorySize, LDS_BYTES) != hipSuccess) { fprintf(stderr, "kernel_launch: hipFuncSetAttribute failed\n"); grid = -1; return; }
        if (hipOccupancyMaxActiveBlocksPerMultiprocessor(&per_cu, (const void*)fwd, NWAVES * 64, LDS_BYTES) != hipSuccess || per_cu < 1)
            fprintf(stderr, "kernel_launch: note: occupancy query reports %d workgroups per CU\n", per_cu);
        (void)hipGetLastError();
        grid = cus;
    }
    if (grid < 0) return;
    if (hipMemsetAsync((char*)d_ws + WS_CTL, 0, CTL_ZERO_BYTES, stream) != hipSuccess) { fprintf(stderr, "kernel_launch: memset failed\n"); return; }
    Args a{};
    for (int i = 0; i < 16; ++i) a.in[i] = (const float*)d_in[i];
    a.out = (float*)d_out; a.ws = (unsigned char*)d_ws; a.probe_phase = PROBE_PHASE; a.probe_reps = PROBE_REPS;
#if MK_ONE_LAUNCH
    a.ph_lo = 0; a.ph_hi = N_PHASES;
    hipLaunchKernelGGL(fwd, dim3(grid), dim3(NWAVES * 64), LDS_BYTES, stream, a);
#else
    for (int p = 0; p < N_PHASES; ++p) { a.ph_lo = p; a.ph_hi = p + 1; hipLaunchKernelGGL(fwd, dim3(grid), dim3(NWAVES * 64), LDS_BYTES, stream, a); }
#endif
    const hipError_t le = hipPeekAtLastError();
    if (le != hipSuccess) fprintf(stderr, "kernel_launch: launch failed: %s\n", hipGetErrorName(le));
}
```

```cpp
#include <hip/hip_runtime.h>
#include <cstdio>
#include <cstdint>

#ifndef FLASH_NA
#define FLASH_NA 1
#endif
#ifndef FLASH_SW
#define FLASH_SW 1
#endif
#ifndef FLASH_MEM
#define FLASH_MEM 1
#endif
#ifndef PROBE_PHASE
#define PROBE_PHASE 0
#endif
#ifndef PROBE_REPS
#define PROBE_REPS 0
#endif
#ifndef GATE_U8
#define GATE_U8 1
#endif
#ifndef GATES_FP8
#define GATES_FP8 1
#endif
#ifndef WGM_IN
#define WGM_IN 4
#endif
#ifndef WGM_SM
#define WGM_SM 4
#endif
#ifndef MK_ONE_LAUNCH
#define MK_ONE_LAUNCH 1
#endif

#define LAS __attribute__((address_space(3)))
#define GAS __attribute__((address_space(1)))
typedef unsigned short bf16_t;
typedef short bf16x8 __attribute__((ext_vector_type(8)));
typedef float f32x4 __attribute__((ext_vector_type(4)));
typedef float f32x2 __attribute__((ext_vector_type(2)));
typedef unsigned u32x4 __attribute__((ext_vector_type(4)));
typedef unsigned u32x2 __attribute__((ext_vector_type(2)));

constexpr int DM = 4096, NSEQ = 12, SEQ = 2048, T = NSEQ * SEQ  , DEPTH = 2, TP = 4 * SEQ  ;
constexpr int INW = 24576;
constexpr int MEMT = 256, MROWS = NSEQ * MEMT;
constexpr int KVW = 2048;
constexpr int QA = 0, KA = 1536, VA = 3072, ZA = 4608, QB = 6144, KB = 7680, VB = 8192, ZB = 8704, QM = 10240, ZM = 11264, GA = 12288;
constexpr float RMS_EPS = 1e-6f;
constexpr float LOG2E = 1.4426950408889634f;

constexpr size_t MiB = 1u << 20;
constexpr size_t WS_CTL = 0, CTL_ZERO_BYTES = 64 * 1024;
constexpr size_t WS_WIN = 1 * MiB;
constexpr size_t WS_WKV = WS_WIN + 2 * 192 * MiB;
constexpr size_t WS_WCAT = WS_WKV + 2 * 16 * MiB;
constexpr size_t WS_WOUT = WS_WCAT + 2 * 32 * MiB;
constexpr size_t WS_H = WS_WOUT + 2 * 32 * MiB;
constexpr size_t WS_X = WS_H + 192 * MiB;
constexpr size_t WS_P = WS_X + 192 * MiB;
constexpr size_t WS_MEMH = WS_P + 1152 * MiB;
constexpr size_t WS_KVM = WS_MEMH + 24 * MiB;
constexpr size_t WS_RSQ = WS_KVM + 2 * 12 * MiB;
constexpr size_t WS_H8 = WS_RSQ + 6 * MiB;
constexpr size_t WS_W8 = WS_H8 + 96 * MiB;
constexpr size_t WS_END = WS_W8 + 2 * 48 * MiB;
constexpr size_t WS_KNA = WS_WIN + 96 * MiB, WS_KSW = WS_KNA + 72 * MiB;
constexpr size_t WS_VNA = WS_WIN + 192 * MiB + 96 * MiB, WS_VSW = WS_VNA + 72 * MiB;
constexpr float H8_SCALE = 8.f, W8_SCALE = 256.f, G8_DESCALE = 1.0f / (8.f * 256.f);
constexpr int NGATE = 3 * DM;
constexpr int CW_BAR = 4096;

constexpr int RING_BYTES = 131072;
constexpr int LDSCTL_OFF = RING_BYTES, MISC_OFF = LDSCTL_OFF + 320;
constexpr int LDS_BYTES = 163840;
constexpr int NWAVES = 8;

__device__ __forceinline__ int lane_id_hw() { int l; asm volatile("v_mbcnt_lo_u32_b32 %0, -1, 0\n\tv_mbcnt_hi_u32_b32 %0, -1, %0" : "=v"(l)); return l; }
typedef float f32x2_t_ __attribute__((ext_vector_type(2))); typedef __bf16 bf16x2_t_ __attribute__((ext_vector_type(2)));
__device__ __forceinline__ unsigned cvt_pk_bf16(float lo, float hi) { const f32x2_t_ v = {lo, hi}; const bf16x2_t_ b = __builtin_convertvector(v, bf16x2_t_); return __builtin_bit_cast(unsigned, b); }
__device__ __forceinline__ unsigned pk4_fp8(float a, float b, float c, float d) { int w = __builtin_amdgcn_cvt_pk_fp8_f32(a, b, 0, false); w = __builtin_amdgcn_cvt_pk_fp8_f32(c, d, w, true); return (unsigned)w; }
__device__ __forceinline__ float bf_lo(unsigned w) { return __uint_as_float(w << 16); }
__device__ __forceinline__ float bf_hi(unsigned w) { return __uint_as_float(w & 0xffff0000u); }
__device__ __forceinline__ float sigmoid_f(float x) { return __builtin_amdgcn_rcpf(1.0f + __builtin_amdgcn_exp2f(-x * LOG2E)); }
__device__ __forceinline__ unsigned gate_q8(float g) { return (unsigned)fmaxf(g * 255.0f + 0.5f, 1.0f); }
__device__ __forceinline__ unsigned gate_pk4(const f32x4& g) { return gate_q8(g[0]) | (gate_q8(g[1]) << 8) | (gate_q8(g[2]) << 16) | (gate_q8(g[3]) << 24); }
__device__ __forceinline__ float ub0(unsigned w) { return (float)(w & 0xffu); }
__device__ __forceinline__ float ub1(unsigned w) { return (float)((w >> 8) & 0xffu); }
__device__ __forceinline__ float ub2(unsigned w) { return (float)((w >> 16) & 0xffu); }
__device__ __forceinline__ float ub3(unsigned w) { return (float)(w >> 24); }
__device__ __forceinline__ void gate_ratio4(f32x4& v, unsigned n, unsigned d) {
    v[0] *= ub0(n) * __builtin_amdgcn_rcpf(ub0(d)); v[1] *= ub1(n) * __builtin_amdgcn_rcpf(ub1(d)); v[2] *= ub2(n) * __builtin_amdgcn_rcpf(ub2(d)); v[3] *= ub3(n) * __builtin_amdgcn_rcpf(ub3(d)); }
__device__ __forceinline__ void gate_mul4(f32x4& v, unsigned g) { const float s = 1.0f / 255.0f; v[0] *= ub0(g) * s; v[1] *= ub1(g) * s; v[2] *= ub2(g) * s; v[3] *= ub3(g) * s; }

namespace pg8 {
constexpr int BM = 256, BK = 64, HALF = 128, HTB = HALF * BK * 2, STAGE_BYTES = 8 * HTB, NXCD = 8, WGM = 8;
constexpr size_t KSTEP = (size_t)BK * 2;
constexpr size_t TSTEP16 = (size_t)256 * 4096 * 2, TSTEP8 = (size_t)256 * 4096;
typedef int i32x4 __attribute__((ext_vector_type(4)));
typedef int i32x8 __attribute__((ext_vector_type(8)));
__device__ __forceinline__ i32x8 cat8(bf16x8 lo, bf16x8 hi) { return __builtin_shufflevector(__builtin_bit_cast(i32x4, lo), __builtin_bit_cast(i32x4, hi), 0, 1, 2, 3, 4, 5, 6, 7); }
__host__ __device__ __forceinline__ int lds_byte(int r, int c) { const int st = (r >> 4) * 2 + (c >> 5), rr = r & 15, cc = c & 31, ob = rr * 64 + cc * 2; return st * 1024 + (ob ^ (((ob >> 9) & 1) << 5)); }
__host__ __device__ __forceinline__ void stage_rc(int b, int& R, int& C) { const int st = b / 1024, sb = b % 1024, swz = sb ^ (((sb >> 9) & 1) << 5); R = (st >> 1) * 16 + swz / 64; C = (st & 1) * 32 + (swz % 64) / 2; }
__host__ __device__ __forceinline__ int perm32(int rho) { const int n = rho >> 4, i = rho & 15; return 8 * (i >> 2) + 4 * n + (i & 3); }

struct GUnit { unsigned ao, bo; int nt, pm, pn, kind; };

template <int WGM_> __device__ __forceinline__ void tile_of(int L, int nM, int nN, int& pm, int& pn) {
    const int nwg = nM * nN; int wgid = L;
    { const int q = nwg / NXCD, r = nwg % NXCD, xcd = wgid % NXCD, off = wgid / NXCD; wgid = (xcd < r ? xcd * (q + 1) : r * (q + 1) + (xcd - r) * q) + off; }
    const int nig = WGM_ * nN, gid = wgid / nig, fm = gid * WGM_, gsz = (nM - fm) < WGM_ ? (nM - fm) : WGM_;
    pm = fm + ((wgid % nig) % gsz); pn = (wgid % nig) / gsz;
}

#ifndef PG8_SP2
#define PG8_SP2 true
#endif
template <class Epi, class Sched, int PITCH = 8192, bool F8 = false, bool SP2 = PG8_SP2>
__device__ __forceinline__ void gemm_phase(LAS unsigned char* lds, const char* wsb, const Sched& S, const Epi& E, int wave_s) {
    const int lane = lane_id_hw(), wid = wave_s, tid = wid * 64 + lane;
    const int wr = wid >> 2, wc = wid & 3, fr = lane & 15, fq = lane >> 4;
    unsigned voffA[2], voffB[2];
#pragma unroll
    for (int i = 0; i < 2; ++i) { int R, C; stage_rc(tid * 16 + i * 8192, R, C); const int Rb = (R & ~31) + perm32(R & 31);
        voffA[i] = (unsigned)(R * PITCH + C * 2); voffB[i] = (unsigned)(Rb * PITCH + C * 2); }
    const unsigned kstep = (unsigned)KSTEP, hstep = (unsigned)HALF * PITCH;
    const unsigned ldsw = (unsigned)wid * 1024u;
    const int aoff = lds_byte(wr * 64 + fr, fq * 8), boff = lds_byte(wc * 32 + fr, fq * 8);
#define PG8_SA(b, h) (((b) * 2 + (h)) * HTB)
#define PG8_SB(b, h) ((4 + (b) * 2 + (h)) * HTB)
#define PG8_STAGE(bufoff, gbase, voff) do { unsigned _g = (gbase); asm volatile("" : "+s"(_g));   _Pragma("unroll") for (int _i = 0; _i < 2; ++_i) \
        __builtin_amdgcn_global_load_lds((const unsigned*)(wsb + (size_t)(unsigned)(_g + (voff)[_i])), (LAS unsigned*)(lds + (bufoff) + ldsw + _i * 8192), 16, 0, 0); } while (0)
#define PG8_LDA(dst, b, h) do { if constexpr (F8) { _Pragma("unroll") for (int m = 0; m < 4; ++m) dst##8[m] = cat8(*(const LAS bf16x8*)(lds + PG8_SA(b, h) + aoff + m * 2048), *(const LAS bf16x8*)(lds + PG8_SA(b, h) + aoff + m * 2048 + 1024)); } \
      else { _Pragma("unroll") for (int m = 0; m < 4; ++m) _Pragma("unroll") for (int k = 0; k < 2; ++k) dst[m][k] = *(const LAS bf16x8*)(lds + PG8_SA(b, h) + aoff + m * 2048 + k * 1024); } } while (0)
#define PG8_LDB(dst, b, h) do { if constexpr (F8) { _Pragma("unroll") for (int n = 0; n < 2; ++n) dst##8[n] = cat8(*(const LAS bf16x8*)(lds + PG8_SB(b, h) + boff + n * 2048), *(const LAS bf16x8*)(lds + PG8_SB(b, h) + boff + n * 2048 + 1024)); } \
      else { _Pragma("unroll") for (int n = 0; n < 2; ++n) _Pragma("unroll") for (int k = 0; k < 2; ++k) dst[n][k] = *(const LAS bf16x8*)(lds + PG8_SB(b, h) + boff + n * 2048 + k * 1024); } } while (0)
#define PG8_MMA(ai, bj, At, Bt) do { __builtin_amdgcn_s_setprio(1); if constexpr (F8) { _Pragma("unroll") for (int m = 0; m < 4; ++m) _Pragma("unroll") for (int n = 0; n < 2; ++n) \
        acc[ai][bj][m][n] = __builtin_amdgcn_mfma_scale_f32_16x16x128_f8f6f4(Bt##8[n], At##8[m], acc[ai][bj][m][n], 0, 0, 0, 0, 0, 0); } \
      else { _Pragma("unroll") for (int m = 0; m < 4; ++m) _Pragma("unroll") for (int n = 0; n < 2; ++n) _Pragma("unroll") for (int k = 0; k < 2; ++k) \
        acc[ai][bj][m][n] = __builtin_amdgcn_mfma_f32_16x16x32_bf16(Bt[n][k], At[m][k], acc[ai][bj][m][n], 0, 0, 0); } __builtin_amdgcn_s_setprio(0); } while (0)
#define PG8_WAIT_V(n) asm volatile("s_waitcnt vmcnt(" #n ")" ::: "memory")
#define PG8_WAIT_L(n) asm volatile("s_waitcnt lgkmcnt(" #n ")" ::: "memory")
#define PG8_BAR __builtin_amdgcn_s_barrier()
#define PG8_SCHED __builtin_amdgcn_sched_barrier(0)
    GUnit cur, nxt; int ui = 0;
    if (!S.next(0, cur)) return;
    f32x4 acc[2][2][4][2];
#pragma unroll
    for (int a = 0; a < 2; ++a)
#pragma unroll
        for (int b = 0; b < 2; ++b)
#pragma unroll
            for (int m = 0; m < 4; ++m)
#pragma unroll
                for (int n = 0; n < 2; ++n) acc[a][b][m][n] = (f32x4){0.f, 0.f, 0.f, 0.f};
    bf16x8 At[4][2], B0[2][2], B1[2][2]; i32x8 At8[4], B08[2], B18[2];
    unsigned cA = cur.ao, cB = cur.bo;
    if constexpr (SP2) {
        PG8_STAGE(PG8_SB(0, 0), cB, voffB); PG8_STAGE(PG8_SB(0, 1), cB + hstep, voffB); PG8_STAGE(PG8_SA(0, 0), cA, voffA); PG8_STAGE(PG8_SA(0, 1), cA + hstep, voffA);
        if (wr == 1) PG8_BAR;
        PG8_WAIT_V(2); PG8_BAR;
        PG8_STAGE(PG8_SB(1, 0), cB + kstep, voffB); PG8_STAGE(PG8_SA(1, 0), cA + kstep, voffA); PG8_STAGE(PG8_SB(1, 1), cB + hstep + kstep, voffB);
        PG8_WAIT_V(6); PG8_BAR;
    } else {
    PG8_STAGE(PG8_SB(0, 0), cB, voffB); PG8_STAGE(PG8_SA(0, 0), cA, voffA); PG8_STAGE(PG8_SB(0, 1), cB + hstep, voffB); PG8_STAGE(PG8_SA(0, 1), cA + hstep, voffA);
    if (wr == 1) PG8_BAR;
    PG8_WAIT_V(4); PG8_BAR;
    PG8_STAGE(PG8_SB(1, 0), cB + kstep, voffB); PG8_STAGE(PG8_SA(1, 0), cA + kstep, voffA); PG8_STAGE(PG8_SB(1, 1), cB + hstep + kstep, voffB);
    PG8_WAIT_V(6); PG8_BAR;
    }
    for (;;) {
        const bool has_next = S.next(ui + 1, nxt);
        const unsigned nA = has_next ? nxt.ao : cA, nB = has_next ? nxt.bo : cB;
        const int nt = cur.nt;
        for (int t = 0; t < nt; t += 2) {
            if constexpr (Epi::HAS_MID) { if (t == Epi::MID0 || t == Epi::MID1) { const int l2 = lane_id_hw(); E.mid(acc, cur, t == Epi::MID0 ? 0 : 1, wr, wc, l2 & 15, l2 >> 4); } }
            const bool last = (t == nt - 2);
            const unsigned a1 = cA + (unsigned)(t + 1) * kstep;
            const unsigned a2 = last ? nA : cA + (unsigned)(t + 2) * kstep, b2 = last ? nB : cB + (unsigned)(t + 2) * kstep;
            const unsigned a3 = a2 + kstep, b3 = b2 + kstep;
            if constexpr (SP2) {
            PG8_LDB(B0, 0, 0); PG8_LDB(B1, 0, 1); PG8_SCHED; PG8_LDA(At, 0, 0); PG8_STAGE(PG8_SA(1, 1), a1 + hstep, voffA);
            PG8_WAIT_V(8); PG8_WAIT_L(0); PG8_BAR; PG8_MMA(0, 0, At, B0); PG8_MMA(0, 1, At, B1); PG8_BAR; PG8_SCHED;
            PG8_LDA(At, 0, 1); PG8_STAGE(PG8_SB(0, 0), b2, voffB); PG8_STAGE(PG8_SB(0, 1), b2 + hstep, voffB); PG8_STAGE(PG8_SA(0, 0), a2, voffA);
            PG8_WAIT_V(8); PG8_WAIT_L(0); PG8_BAR; PG8_MMA(1, 0, At, B0); PG8_MMA(1, 1, At, B1); PG8_BAR; PG8_SCHED;
            PG8_LDB(B0, 1, 0); PG8_LDB(B1, 1, 1); PG8_SCHED; PG8_LDA(At, 1, 0); PG8_STAGE(PG8_SA(0, 1), a2 + hstep, voffA);
            PG8_WAIT_V(8); PG8_WAIT_L(0); PG8_BAR; PG8_MMA(0, 0, At, B0); PG8_MMA(0, 1, At, B1); PG8_BAR; PG8_SCHED;
            PG8_LDA(At, 1, 1); PG8_STAGE(PG8_SB(1, 0), b3, voffB); PG8_STAGE(PG8_SB(1, 1), b3 + hstep, voffB); PG8_STAGE(PG8_SA(1, 0), a3, voffA);
            PG8_WAIT_V(8); PG8_WAIT_L(0); PG8_BAR; PG8_MMA(1, 0, At, B0); PG8_MMA(1, 1, At, B1); PG8_BAR; PG8_SCHED;
            } else {
            PG8_LDB(B0, 0, 0); PG8_SCHED; PG8_LDA(At, 0, 0); PG8_STAGE(PG8_SA(1, 1), a1 + hstep, voffA);
            PG8_WAIT_L(8); PG8_BAR; PG8_WAIT_L(0); PG8_MMA(0, 0, At, B0); PG8_BAR; PG8_SCHED;
            PG8_LDB(B1, 0, 1); PG8_STAGE(PG8_SB(0, 0), b2, voffB);
            PG8_BAR; PG8_WAIT_L(0); PG8_MMA(0, 1, At, B1); PG8_BAR;
            PG8_LDA(At, 0, 1); PG8_STAGE(PG8_SA(0, 0), a2, voffA);
            PG8_BAR; PG8_WAIT_L(0); PG8_MMA(1, 0, At, B0); PG8_BAR; PG8_SCHED;
            PG8_STAGE(PG8_SB(0, 1), b2 + hstep, voffB);
            PG8_WAIT_V(6); PG8_BAR; PG8_MMA(1, 1, At, B1); PG8_BAR;
            PG8_LDB(B0, 1, 0); PG8_SCHED; PG8_LDA(At, 1, 0); PG8_STAGE(PG8_SA(0, 1), a2 + hstep, voffA);
            PG8_WAIT_L(8); PG8_BAR; PG8_WAIT_L(0); PG8_MMA(0, 0, At, B0); PG8_BAR; PG8_SCHED;
            PG8_LDB(B1, 1, 1); PG8_STAGE(PG8_SB(1, 0), b3, voffB);
            PG8_BAR; PG8_WAIT_L(0); PG8_MMA(0, 1, At, B1); PG8_BAR;
            PG8_LDA(At, 1, 1); PG8_STAGE(PG8_SA(1, 0), a3, voffA);
            PG8_BAR; PG8_WAIT_L(0); PG8_MMA(1, 0, At, B0); PG8_BAR; PG8_SCHED;
            PG8_STAGE(PG8_SB(1, 1), b3 + hstep, voffB);
            PG8_WAIT_V(6); PG8_BAR; PG8_MMA(1, 1, At, B1); PG8_BAR;
            }
        }
        { const int l2 = lane_id_hw(); E(acc, cur, wr, wc, l2 & 15, l2 >> 4); }
        if (!has_next) break;
#pragma unroll
        for (int a = 0; a < 2; ++a)
#pragma unroll
            for (int b = 0; b < 2; ++b)
#pragma unroll
                for (int m = 0; m < 4; ++m)
#pragma unroll
                    for (int n = 0; n < 2; ++n) acc[a][b][m][n] = (f32x4){0.f, 0.f, 0.f, 0.f};
        cur = nxt; cA = nA; cB = nB; ++ui;
    }
    PG8_WAIT_V(0);
    if (wr == 0) PG8_BAR;
    PG8_BAR;
#undef PG8_SA
#undef PG8_SB
#undef PG8_STAGE
#undef PG8_LDA
#undef PG8_LDB
#undef PG8_MMA
#undef PG8_WAIT_V
#undef PG8_WAIT_L
#undef PG8_BAR
#undef PG8_SCHED
}
}

struct SchedIn {
    int G, c, nextra; unsigned A, B, memA, memB0, memB1;
    __device__ __forceinline__ bool next(int i, pg8::GUnit& u) const {
        int L = i * G + c;
        constexpr int NN = GATES_FP8 ? 48 : 96;
        if (L < 96 * NN) { int pm, pn; pg8::tile_of<WGM_IN>(L, 96, NN, pm, pn); u.ao = A + (unsigned)pm * (unsigned)pg8::TSTEP16; u.bo = B + (unsigned)pn * (unsigned)pg8::TSTEP16; u.nt = 64; u.pm = pm; u.pn = pn; u.kind = 0; return true; }
        L -= 96 * NN; if (L >= nextra) return false;
        const int le = L / 96, r = L % 96, pm = r % 12, pn = r / 12;
        u.ao = memA + (unsigned)pm * (unsigned)pg8::TSTEP16; u.bo = (le ? memB1 : memB0) + (unsigned)pn * (unsigned)pg8::TSTEP16; u.nt = 64; u.pm = pm; u.pn = pn; u.kind = 1 + le; return true;
    }
};
struct EpiIn {   static constexpr bool HAS_MID = false; static constexpr int MID0 = -1, MID1 = -1;
    bf16_t* P; bf16_t* KVM0; bf16_t* KVM1; bf16_t* wsb16;
    __device__ __forceinline__ void operator()(const f32x4 (&acc)[2][2][4][2], const pg8::GUnit& u, int wr, int wc, int fr, int fq) const {
        bf16_t* base; int ldc, mode = 0, bjs = 128; int rowb = u.pm * 256 + wr * 64 + fr, colb = u.pn * 256 + wc * 32 + 8 * fq;
        if (u.kind == 0) { base = P; ldc = INW; const int pn = u.pn; if (pn >= GA / 256) mode = 1; else if ((pn >= ZA / 256 && pn < QB / 256) || (pn >= ZB / 256 && pn < QM / 256) || (pn >= ZM / 256)) mode = 2;
            if (GATES_FP8) {
                int nh = 0, hp = 0; size_t off = 0;
                if (pn >= KA / 256 && pn < VA / 256) { nh = 12; hp = pn - KA / 256; off = WS_KNA; } else if (pn >= VA / 256 && pn < ZA / 256) { nh = 12; hp = pn - VA / 256; off = WS_VNA; }
                else if (pn >= KB / 256 && pn < VB / 256) { nh = 4; hp = pn - KB / 256; off = WS_KSW; } else if (pn >= VB / 256 && pn < ZB / 256) { nh = 4; hp = pn - VB / 256; off = WS_VSW; }
                if (nh) { const int b = u.pm >> 3; base = wsb16 + off / 2; ldc = 128; bjs = SEQ * 128; rowb = (b * nh + 2 * hp) * SEQ + (u.pm & 7) * 256 + wr * 64 + fr; colb = wc * 32 + 8 * fq; } } }
        else { base = (u.kind == 1) ? KVM0 : KVM1; ldc = KVW; }
#pragma unroll
        for (int ai = 0; ai < 2; ++ai)
#pragma unroll
            for (int m = 0; m < 4; ++m) { GAS bf16_t* rowp = (GAS bf16_t*)base + (size_t)(rowb + ai * 128 + m * 16) * ldc + colb;
#pragma unroll
                for (int bj = 0; bj < 2; ++bj) { f32x4 v0 = acc[ai][bj][m][0], v1 = acc[ai][bj][m][1];
                    if (mode == 1) {
#pragma unroll
                        for (int j = 0; j < 4; ++j) { v0[j] = sigmoid_f(v0[j]); v1[j] = sigmoid_f(v1[j]); } }
                    else if (mode == 2) {
#pragma unroll
                        for (int j = 0; j < 4; ++j) { v0[j] = v0[j] * sigmoid_f(v0[j]); v1[j] = v1[j] * sigmoid_f(v1[j]); } }
                    u32x4 w; w.x = cvt_pk_bf16(v0[0], v0[1]); w.y = cvt_pk_bf16(v0[2], v0[3]); w.z = cvt_pk_bf16(v1[0], v1[1]); w.w = cvt_pk_bf16(v1[2], v1[3]);
                    *(GAS u32x4*)(rowp + (size_t)bj * bjs) = w; } }
    }
};
struct SchedIn8 {
    int G, c; unsigned A, B;
    __device__ __forceinline__ bool next(int i, pg8::GUnit& u) const {
        const int L = i * G + c; if (L >= 96 * 48) return false;
        int pm, pn; pg8::tile_of<WGM_IN>(L, 96, 48, pm, pn);
        u.ao = A + (unsigned)pm * (unsigned)pg8::TSTEP8; u.bo = B + (unsigned)pn * (unsigned)pg8::TSTEP8; u.nt = 32; u.pm = pm; u.pn = pn; u.kind = 0; return true;
    }
};
struct EpiIn8 {   static constexpr bool HAS_MID = false; static constexpr int MID0 = -1, MID1 = -1;
    bf16_t* P;
    __device__ __forceinline__ void operator()(const f32x4 (&acc)[2][2][4][2], const pg8::GUnit& u, int wr, int wc, int fr, int fq) const {
#if GATE_U8
        GAS unsigned char* gb = (GAS unsigned char*)P + (size_t)(u.pm * 256 + (wr * 4 + wc) * 32 + fq) * (INW * 2) + (GA * 2 + u.pn * 256 + fr * 16);
#pragma unroll
        for (int ai = 0; ai < 2; ++ai)
#pragma unroll
            for (int m = 0; m < 4; ++m) { u32x4 w; unsigned wq[4];
#pragma unroll
                for (int bj = 0; bj < 2; ++bj)
#pragma unroll
                    for (int n = 0; n < 2; ++n) { f32x4 v = acc[ai][bj][m][n];
#pragma unroll
                        for (int j = 0; j < 4; ++j) v[j] = __builtin_amdgcn_rcpf(1.0f + __builtin_amdgcn_exp2f(v[j] * (-LOG2E * G8_DESCALE)));
                        wq[bj * 2 + n] = gate_pk4(v); }
                w.x = wq[0]; w.y = wq[1]; w.z = wq[2]; w.w = wq[3];
                *(GAS u32x4*)(gb + (size_t)((ai * 4 + m) * 4) * (INW * 2)) = w; }
#else
        const int row0 = u.pm * 256 + wr * 64 + fr, col0 = GA + u.pn * 256 + wc * 32 + 8 * fq;
#pragma unroll
        for (int ai = 0; ai < 2; ++ai)
#pragma unroll
            for (int m = 0; m < 4; ++m) { GAS bf16_t* rowp = (GAS bf16_t*)P + (size_t)(row0 + ai * 128 + m * 16) * INW + col0;
#pragma unroll
                for (int bj = 0; bj < 2; ++bj) { f32x4 v0 = acc[ai][bj][m][0], v1 = acc[ai][bj][m][1];
#pragma unroll
                    for (int j = 0; j < 4; ++j) { v0[j] = __builtin_amdgcn_rcpf(1.0f + __builtin_amdgcn_exp2f(v0[j] * (-LOG2E * G8_DESCALE))); v1[j] = __builtin_amdgcn_rcpf(1.0f + __builtin_amdgcn_exp2f(v1[j] * (-LOG2E * G8_DESCALE))); }
                    u32x4 w; w.x = cvt_pk_bf16(v0[0], v0[1]); w.y = cvt_pk_bf16(v0[2], v0[3]); w.z = cvt_pk_bf16(v1[0], v1[1]); w.w = cvt_pk_bf16(v1[2], v1[3]);
                    *(GAS u32x4*)(rowp + bj * 128) = w; } }
#endif
    }
};
struct SchedBr {
    int G, c; unsigned A, B;
    __device__ __forceinline__ bool next(int i, pg8::GUnit& u) const {
        const int L = i * G + c; if (L >= 96 * 16) return false;
        int pm, pn; pg8::tile_of<WGM_SM>(L, 96, 16, pm, pn);
        u.ao = A + (unsigned)pm * (unsigned)pg8::TSTEP16; u.bo = B + (unsigned)pn * (unsigned)pg8::TSTEP16; u.nt = 64; u.pm = pm; u.pn = pn; u.kind = 0; return true;
    }
};
struct EpiBr {
    static constexpr bool HAS_MID = true; static constexpr int MID0 = 24, MID1 = 48;
    const bf16_t* P; bf16_t* Mg;
    __device__ __forceinline__ void mid(f32x4 (&acc)[2][2][4][2], const pg8::GUnit& u, int b, int wr, int wc, int fr, int fq) const {
#if GATE_U8
        const GAS unsigned char* gp = (const GAS unsigned char*)P + (size_t)(u.pm * 256 + (wr * 4 + wc) * 32 + fq) * (INW * 2) + (GA * 2 + (b * 16 + u.pn) * 256 + fr * 16);
        u32x4 gn[8], gd[8];
#pragma unroll
        for (int k = 0; k < 8; ++k) { const GAS unsigned char* q = gp + (size_t)(k * 4) * (INW * 2); gn[k] = *(const GAS u32x4*)q; gd[k] = *(const GAS u32x4*)(q + DM); }
#pragma unroll
        for (int k = 0; k < 8; ++k) { const int ai = k >> 2, m = k & 3;
            gate_ratio4(acc[ai][0][m][0], gn[k].x, gd[k].x); gate_ratio4(acc[ai][0][m][1], gn[k].y, gd[k].y); gate_ratio4(acc[ai][1][m][0], gn[k].z, gd[k].z); gate_ratio4(acc[ai][1][m][1], gn[k].w, gd[k].w); }
#else
        const int row0 = u.pm * 256 + wr * 64 + fr, col0 = u.pn * 256 + wc * 32 + 8 * fq;
        const GAS bf16_t* gp = (const GAS bf16_t*)P + (size_t)row0 * INW + GA + b * DM + col0;
#pragma unroll
        for (int ai = 0; ai < 2; ++ai) {
            u32x4 gn[4][2], gd[4][2];
#pragma unroll
            for (int m = 0; m < 4; ++m)
#pragma unroll
                for (int bj = 0; bj < 2; ++bj) { const GAS bf16_t* q = gp + (size_t)(ai * 128 + m * 16) * INW + bj * 128; gn[m][bj] = *(const GAS u32x4*)q; gd[m][bj] = *(const GAS u32x4*)(q + DM); }
#pragma unroll
            for (int m = 0; m < 4; ++m)
#pragma unroll
                for (int bj = 0; bj < 2; ++bj) { const u32x4 n4 = gn[m][bj], d4 = gd[m][bj];
                    f32x4& v0 = acc[ai][bj][m][0]; f32x4& v1 = acc[ai][bj][m][1];
                    v0[0] *= bf_lo(n4.x) * __builtin_amdgcn_rcpf(fmaxf(bf_lo(d4.x), 1e-30f)); v0[1] *= bf_hi(n4.x) * __builtin_amdgcn_rcpf(fmaxf(bf_hi(d4.x), 1e-30f));
                    v0[2] *= bf_lo(n4.y) * __builtin_amdgcn_rcpf(fmaxf(bf_lo(d4.y), 1e-30f)); v0[3] *= bf_hi(n4.y) * __builtin_amdgcn_rcpf(fmaxf(bf_hi(d4.y), 1e-30f));
                    v1[0] *= bf_lo(n4.z) * __builtin_amdgcn_rcpf(fmaxf(bf_lo(d4.z), 1e-30f)); v1[1] *= bf_hi(n4.z) * __builtin_amdgcn_rcpf(fmaxf(bf_hi(d4.z), 1e-30f));
                    v1[2] *= bf_lo(n4.w) * __builtin_amdgcn_rcpf(fmaxf(bf_lo(d4.w), 1e-30f)); v1[3] *= bf_hi(n4.w) * __builtin_amdgcn_rcpf(fmaxf(bf_hi(d4.w), 1e-30f)); }
        }
#endif
    }
    __device__ __forceinline__ void operator()(const f32x4 (&acc)[2][2][4][2], const pg8::GUnit& u, int wr, int wc, int fr, int fq) const {
        const int row0 = u.pm * 256 + wr * 64 + fr, col0 = u.pn * 256 + wc * 32 + 8 * fq;
        GAS bf16_t* mp0 = (GAS bf16_t*)Mg + (size_t)row0 * DM + col0;
#if GATE_U8
        const GAS unsigned char* gp = (const GAS unsigned char*)P + (size_t)(u.pm * 256 + (wr * 4 + wc) * 32 + fq) * (INW * 2) + (GA * 2 + (2 * 16 + u.pn) * 256 + fr * 16);
        u32x4 g[8];
#pragma unroll
        for (int k = 0; k < 8; ++k) g[k] = *(const GAS u32x4*)(gp + (size_t)(k * 4) * (INW * 2));
#pragma unroll
        for (int k = 0; k < 8; ++k) { const int ai = k >> 2, m = k & 3;
#pragma unroll
            for (int bj = 0; bj < 2; ++bj) { f32x4 v0 = acc[ai][bj][m][0], v1 = acc[ai][bj][m][1];
                gate_mul4(v0, bj ? g[k].z : g[k].x); gate_mul4(v1, bj ? g[k].w : g[k].y);
                u32x4 w; w.x = cvt_pk_bf16(v0[0], v0[1]); w.y = cvt_pk_bf16(v0[2], v0[3]); w.z = cvt_pk_bf16(v1[0], v1[1]); w.w = cvt_pk_bf16(v1[2], v1[3]);
                *(GAS u32x4*)(mp0 + (size_t)(ai * 128 + m * 16) * DM + bj * 128) = w; } }
#else
        const GAS bf16_t* gp = (const GAS bf16_t*)P + (size_t)row0 * INW + GA + 2 * DM + col0;
#pragma unroll
        for (int ai = 0; ai < 2; ++ai) {
            u32x4 g[4][2];
#pragma unroll
            for (int m = 0; m < 4; ++m)
#pragma unroll
                for (int bj = 0; bj < 2; ++bj) g[m][bj] = *(const GAS u32x4*)(gp + (size_t)(ai * 128 + m * 16) * INW + bj * 128);
#pragma unroll
            for (int m = 0; m < 4; ++m)
#pragma unroll
                for (int bj = 0; bj < 2; ++bj) { const u32x4 gg = g[m][bj];
                    f32x4 v0 = acc[ai][bj][m][0], v1 = acc[ai][bj][m][1];
                    v0[0] *= bf_lo(gg.x); v0[1] *= bf_hi(gg.x); v0[2] *= bf_lo(gg.y); v0[3] *= bf_hi(gg.y); v1[0] *= bf_lo(gg.z); v1[1] *= bf_hi(gg.z); v1[2] *= bf_lo(gg.w); v1[3] *= bf_hi(gg.w);
                    u32x4 w; w.x = cvt_pk_bf16(v0[0], v0[1]); w.y = cvt_pk_bf16(v0[2], v0[3]); w.z = cvt_pk_bf16(v1[0], v1[1]); w.w = cvt_pk_bf16(v1[2], v1[3]);
                    *(GAS u32x4*)(mp0 + (size_t)(ai * 128 + m * 16) * DM + bj * 128) = w; }
        }
#endif
    }
};
struct SchedOut {
    int G, c; unsigned A, B;
    __device__ __forceinline__ bool next(int i, pg8::GUnit& u) const {
        const int L = i * G + c; if (L >= 96 * 16) return false;
        int pm, pn; pg8::tile_of<WGM_SM>(L, 96, 16, pm, pn);
        u.ao = A + (unsigned)pm * (unsigned)pg8::TSTEP16; u.bo = B + (unsigned)pn * (unsigned)pg8::TSTEP16; u.nt = 64; u.pm = pm; u.pn = pn; u.kind = 0; return true;
    }
};
struct EpiOut {  static constexpr bool HAS_MID = false; static constexpr int MID0 = -1, MID1 = -1;
    bf16_t* O; float* RSQ;
    __device__ __forceinline__ void operator()(const f32x4 (&acc)[2][2][4][2], const pg8::GUnit& u, int wr, int wc, int fr, int fq) const {
        const int row0 = u.pm * 256 + wr * 64 + fr, col0 = u.pn * 256 + wc * 32 + 8 * fq;
#pragma unroll
        for (int ai = 0; ai < 2; ++ai)
#pragma unroll
            for (int m = 0; m < 4; ++m) { const size_t row = (size_t)(row0 + ai * 128 + m * 16); float s = 0.f;
#pragma unroll
                for (int bj = 0; bj < 2; ++bj) { const f32x4 v0 = acc[ai][bj][m][0], v1 = acc[ai][bj][m][1];
                    s += (v0[0] * v0[0] + v0[1] * v0[1]) + (v0[2] * v0[2] + v0[3] * v0[3]) + (v1[0] * v1[0] + v1[1] * v1[1]) + (v1[2] * v1[2] + v1[3] * v1[3]);
                    u32x4 w; w.x = cvt_pk_bf16(v0[0], v0[1]); w.y = cvt_pk_bf16(v0[2], v0[3]); w.z = cvt_pk_bf16(v1[0], v1[1]); w.w = cvt_pk_bf16(v1[2], v1[3]);
                    *(GAS u32x4*)((GAS bf16_t*)O + row * DM + col0 + bj * 128) = w; }
                { const int ln = fr + 16 * fq; s += __int_as_float(__builtin_amdgcn_ds_bpermute((ln ^ 16) << 2, __float_as_int(s))); s += __int_as_float(__builtin_amdgcn_ds_bpermute((ln ^ 32) << 2, __float_as_int(s))); }
                if (fq == 0) ((GAS float*)RSQ)[row * 64 + u.pn * 4 + wc] = s; }
    }
};

static_assert(!GATE_U8 || GATES_FP8, "GATE_U8 lives in the fp8 gate GEMM epilogue");
#define XB_TMO      128
#define XB_XCNT(j)  (256  + 64 * (j))
#define XB_XSUB(j)  (1280 + 64 * (j))
#define XB_XGEN(j)  (2304 + 64 * (j))
#define XB_TOP      3328
#define XB_TOPGEN   3392
#define XCD_BAR_WORDS 3456
#define XB_SPIN_CAP (1u << 18)
__device__ __forceinline__ unsigned xb_ld(unsigned* p)              { return __hip_atomic_load(p, __ATOMIC_RELAXED, __HIP_MEMORY_SCOPE_AGENT); }
__device__ __forceinline__ unsigned xb_add(unsigned* p, unsigned v) { return __hip_atomic_fetch_add(p, v, __ATOMIC_RELAXED, __HIP_MEMORY_SCOPE_AGENT); }
__device__ __forceinline__ unsigned xb_xcc_id() { return (unsigned)__builtin_amdgcn_s_getreg((3 << 11) | 20) & 0xFu; }
#define XB_SPIN(cond, bar) do { unsigned _sp = 0; while (cond) { __builtin_amdgcn_s_sleep(1); \
    if ((++_sp & 255u) == 0u) { if (xb_ld(&(bar)[XB_TMO])) break; if (_sp > XB_SPIN_CAP) { atomicAdd(&(bar)[XB_TMO], 1u); break; } } } } while (0)
struct XcdBarrier { unsigned* bar; unsigned x; volatile LAS unsigned* st; };
__device__ __forceinline__ XcdBarrier xcd_barrier_post(unsigned* bar, volatile LAS unsigned* st, bool leader) {
    XcdBarrier b; b.bar = bar; b.x = xb_xcc_id(); b.st = st;
    if (leader) (void)xb_add(&bar[XB_XCNT(b.x)], 1u);
    return b;
}
__device__ __forceinline__ void xcd_barrier_complete(unsigned* bar, unsigned x, unsigned& nloc, unsigned& nx) {
    const unsigned G = gridDim.x * gridDim.y * gridDim.z;
    unsigned sum, cnt, mine, sp = 0u;
    for (;;) {
        sum = 0u; cnt = 0u; mine = 0u;
#pragma unroll
        for (unsigned j = 0; j < 16; ++j) { const unsigned c = xb_ld(&bar[XB_XCNT(j)]); sum += c; cnt += (c > 0u) ? 1u : 0u; mine = (j == x) ? c : mine; }
        if (sum == G) break;
        __builtin_amdgcn_s_sleep(1);
        if ((++sp & 255u) == 0u) { if (xb_ld(&bar[XB_TMO])) break; if (sp > XB_SPIN_CAP) { atomicAdd(&bar[XB_TMO], 1u); break; } }
    }
    nloc = mine > 0u ? mine : 1u; nx = cnt > 0u ? cnt : 1u;
}
__device__ __forceinline__ void xcd_barrier(const XcdBarrier& b, bool leader) {
    asm volatile("s_waitcnt vmcnt(0)" ::: "memory");
    __syncthreads();
    if (leader) {
        unsigned* bar = b.bar;
        __builtin_amdgcn_s_waitcnt(0);
        unsigned nloc = b.st[0], nx = b.st[1];
        if (nloc == 0u) { xcd_barrier_complete(bar, b.x, nloc, nx); b.st[0] = nloc; b.st[1] = nx; }
        const unsigned old = xb_add(&bar[XB_XSUB(b.x)], 1u);
        const unsigned gen = old / nloc;
        if (old + 1u == (gen + 1u) * nloc) {
            __builtin_amdgcn_fence(__ATOMIC_RELEASE, "agent");
            asm volatile("s_waitcnt vmcnt(0)" ::: "memory");
            const unsigned og = xb_add(&bar[XB_TOP], 1u);
            const unsigned tg = og / nx;
            if (og + 1u == (tg + 1u) * nx) xb_add(&bar[XB_TOPGEN], 1u);
            else XB_SPIN(xb_ld(&bar[XB_TOPGEN]) == tg, bar);
            __builtin_amdgcn_fence(__ATOMIC_ACQUIRE, "agent");
            xb_add(&bar[XB_XGEN(b.x)], 1u);
            asm volatile("s_waitcnt vmcnt(0)" ::: "memory");
        } else {
            XB_SPIN(xb_ld(&bar[XB_XGEN(b.x)]) == gen, bar);
            __builtin_amdgcn_fence(__ATOMIC_ACQUIRE, "agent");
            asm volatile("s_waitcnt vmcnt(0)" ::: "memory");
        }
    }
    __syncthreads();
}

__device__ __forceinline__ float shfl_xor_l(float v, int mask, int lane) { return __int_as_float(__builtin_amdgcn_ds_bpermute((lane ^ mask) << 2, __float_as_int(v))); }
__device__ __forceinline__ float wave_sum(float v, int lane) {
#pragma unroll
    for (int o = 1; o < 64; o <<= 1) v += shfl_xor_l(v, o, lane);
    return v;
}
__device__ __forceinline__ unsigned f2bf(float f) { unsigned u = __builtin_bit_cast(unsigned, f); return (u + 0x7fffu + ((u >> 16) & 1u)) >> 16; }
__device__ __forceinline__ unsigned pk2(float lo, float hi) { return f2bf(lo) | (f2bf(hi) << 16); }

__device__ __forceinline__ void transpose_item(const float* W, int N, bf16_t* WT, int ldwt, int koff, const float* gain, LAS float* scr, int item, int lane, unsigned char* W8 = nullptr, int n8 = 0) {
    const int nblk = N / 32, kb = item / nblk, nb = item % nblk, k0 = 64 * kb, n0 = 32 * nb;
    const GAS float* wp = (const GAS float*)W + (size_t)(k0 + (lane >> 5)) * N + n0 + (lane & 31); float v[32];
#pragma unroll
    for (int i = 0; i < 32; ++i) v[i] = wp[(size_t)(2 * i) * N];
    if (gain) {
#pragma unroll
        for (int i = 0; i < 32; ++i) v[i] *= ((const GAS float*)gain)[k0 + 2 * i + (lane >> 5)]; }
#pragma unroll
    for (int i = 0; i < 32; ++i) scr[(2 * i + (lane >> 5)) * 33 + (lane & 31)] = v[i];
    asm volatile("s_waitcnt lgkmcnt(0)" ::: "memory");
    const int c = lane & 7;
    if (W8 && n0 >= n8) {
#pragma unroll
        for (int j = 0; j < 4; ++j) { const int n = (lane >> 3) + 8 * j; const LAS float* s = scr + (8 * c) * 33 + n;
            u32x2 o; o.x = pk4_fp8(s[0 * 33] * W8_SCALE, s[1 * 33] * W8_SCALE, s[2 * 33] * W8_SCALE, s[3 * 33] * W8_SCALE); o.y = pk4_fp8(s[4 * 33] * W8_SCALE, s[5 * 33] * W8_SCALE, s[6 * 33] * W8_SCALE, s[7 * 33] * W8_SCALE);
            *(GAS u32x2*)(W8 + (size_t)(n0 - n8 + n) * DM + k0 + 8 * c) = o; }
    } else {
#pragma unroll
    for (int j = 0; j < 4; ++j) { const int n = (lane >> 3) + 8 * j; const LAS float* s = scr + (8 * c) * 33 + n;
        u32x4 o; o.x = pk2(s[0 * 33], s[1 * 33]); o.y = pk2(s[2 * 33], s[3 * 33]); o.z = pk2(s[4 * 33], s[5 * 33]); o.w = pk2(s[6 * 33], s[7 * 33]);
        *(GAS u32x4*)(WT + (size_t)(n0 + n) * ldwt + koff + k0 + 8 * c) = o; }
    }
    asm volatile("s_waitcnt lgkmcnt(0)" ::: "memory");
}
__device__ __forceinline__ void rms_row_to_bf16(const float* xrow, const float* gain, bf16_t* orow, int lane, unsigned char* o8row = nullptr) {
    const GAS f32x4* xr = (const GAS f32x4*)xrow + lane;
    f32x4 v[16]; float s = 0.f;
#pragma unroll
    for (int j = 0; j < 16; ++j) v[j] = xr[64 * j];
    f32x4 gv[16];
#pragma unroll
    for (int j = 0; j < 16; ++j) gv[j] = gain ? ((const GAS f32x4*)gain)[lane + 64 * j] : (f32x4){1.f, 1.f, 1.f, 1.f};
#pragma unroll
    for (int j = 0; j < 16; ++j) s += (v[j].x * v[j].x + v[j].y * v[j].y) + (v[j].z * v[j].z + v[j].w * v[j].w);
    const float r = 1.0f / sqrtf(wave_sum(s, lane) * (1.0f / DM) + RMS_EPS);
    GAS u32x2* o8 = (GAS u32x2*)orow + lane;
#pragma unroll
    for (int j = 0; j < 16; ++j) { const f32x4 g = gv[j];
        const float y0 = v[j].x * r * g.x, y1 = v[j].y * r * g.y, y2 = v[j].z * r * g.z, y3 = v[j].w * r * g.w;
        u32x2 w; w.x = cvt_pk_bf16(y0, y1); w.y = cvt_pk_bf16(y2, y3); o8[64 * j] = w;
        if (o8row) ((GAS unsigned*)o8row)[lane + 64 * j] = pk4_fp8(y0 * H8_SCALE, y1 * H8_SCALE, y2 * H8_SCALE, y3 * H8_SCALE); }
}

__device__ __forceinline__ int t5_bucket(int rel) {
    const int n = rel < 0 ? -rel : rel;
    const int b = n < 8 ? n : 8 + (n >= 12) + (n >= 16) + (n >= 23) + (n >= 32) + (n >= 46) + (n >= 64) + (n >= 91);
    return b + (rel > 0 ? 16 : 0);
}

struct Args { const float* in[16]; float* out; unsigned char* ws; int ph_lo, ph_hi, probe_phase, probe_reps; };
struct Frame {
    LAS unsigned char* lds;
    int tid, lane, wave, vcu, G;
    const float *xp, *xs, *memp, *mems, *pre_norm, *post_norm, *mem_norm, *w_in, *w_kv, *w_a, *w_b, *w_m, *w_out, *rpb, *sink, *t5;
    float* out;
    bf16_t *WinT, *WkvT, *WcatT, *WoutT, *H, *X, *P, *MEMH, *KVM; float* RSQ; unsigned char *H8, *W8, *ws;
};
__device__ __forceinline__ void make_frame(Frame& F, LAS unsigned char* lds, int wave_s) {
    const Args* ka = (const Args*)__builtin_amdgcn_kernarg_segment_ptr(); asm volatile("" : "+s"(ka));
    const int lane = lane_id_hw();
    F.lds = lds; F.lane = lane; F.wave = wave_s; F.tid = wave_s * 64 + lane;
    F.G = gridDim.x; { const int bx = blockIdx.x; F.vcu = (F.G % 8 == 0) ? (bx % 8) * (F.G / 8) + bx / 8 : bx; }
    F.xp = ka->in[0]; F.xs = ka->in[1]; F.memp = ka->in[2]; F.mems = ka->in[3]; F.pre_norm = ka->in[4]; F.post_norm = ka->in[5]; F.mem_norm = ka->in[6];
    F.w_in = ka->in[7]; F.w_kv = ka->in[8]; F.w_a = ka->in[9]; F.w_b = ka->in[10]; F.w_m = ka->in[11]; F.w_out = ka->in[12]; F.rpb = ka->in[13]; F.sink = ka->in[14]; F.t5 = ka->in[15];
    F.out = ka->out; unsigned char* ws = ka->ws; F.ws = ws;
    F.WinT = (bf16_t*)(ws + WS_WIN); F.WkvT = (bf16_t*)(ws + WS_WKV); F.WcatT = (bf16_t*)(ws + WS_WCAT); F.WoutT = (bf16_t*)(ws + WS_WOUT);
    F.H = (bf16_t*)(ws + WS_H); F.X = (bf16_t*)(ws + WS_X); F.P = (bf16_t*)(ws + WS_P); F.MEMH = (bf16_t*)(ws + WS_MEMH); F.KVM = (bf16_t*)(ws + WS_KVM); F.RSQ = (float*)(ws + WS_RSQ); F.H8 = ws + WS_H8; F.W8 = ws + WS_W8;
}

__device__ __forceinline__ void naive_attention(Frame& F, int l) {
    const int gw = F.vcu * NWAVES + F.wave, NGW = F.G * NWAVES, lane = F.lane;
    const bf16_t* P = F.P; bf16_t* X = F.X;
    if (!FLASH_NA) for (int it = gw; it < NSEQ * 12 * SEQ; it += NGW) {
        const int p = it % SEQ, h = (it / SEQ) % 12, b = it / (SEQ * 12);
        const int r = p >> 6, c = p & 63; int rs = r - 4; rs = rs < 0 ? 0 : (rs > 24 ? 24 : rs); int cs = c - 8; cs = cs < 0 ? 0 : (cs > 48 ? 48 : cs);
        const size_t row = (size_t)b * SEQ + p;
        const unsigned qw = *(const unsigned*)(P + row * INW + QA + h * 128 + 2 * lane); const float q0 = bf_lo(qw), q1 = bf_hi(qw);
        const float* rp = F.rpb + (size_t)(l * 12 + h) * 15 * 31;
        float m = -1e30f, ls = 0.f, o0 = 0.f, o1 = 0.f;
        for (int kr = rs; kr < rs + 8; ++kr)
#pragma unroll 4
          for (int kc = cs; kc < cs + 16; ++kc) {
            const size_t krow = (size_t)b * SEQ + kr * 64 + kc;
            const unsigned kw = *(const unsigned*)(P + krow * INW + KA + h * 128 + 2 * lane), vw = *(const unsigned*)(P + krow * INW + VA + h * 128 + 2 * lane);
            const float s = wave_sum(q0 * bf_lo(kw) + q1 * bf_hi(kw), lane) * 0.08838834764831845f + rp[(kr - r + 7) * 31 + (kc - c + 15)];
            const float mn = fmaxf(m, s), a = __expf(m - mn), pe = __expf(s - mn);
            ls = ls * a + pe; o0 = o0 * a + pe * bf_lo(vw); o1 = o1 * a + pe * bf_hi(vw); m = mn;
        }
        const unsigned zw = *(const unsigned*)(P + row * INW + ZA + h * 128 + 2 * lane); const float inv = 1.0f / ls;
        *(unsigned*)(X + row * DM + h * 128 + 2 * lane) = cvt_pk_bf16(o0 * inv * bf_lo(zw), o1 * inv * bf_hi(zw));
    }
    if (!FLASH_SW) for (int it = gw; it < NSEQ * 12 * SEQ; it += NGW) {
        const int p = it % SEQ, h = (it / SEQ) % 12, b = it / (SEQ * 12), kvh = h / 3;
        const size_t row = (size_t)b * SEQ + p;
        const unsigned qw = *(const unsigned*)(P + row * INW + QB + h * 128 + 2 * lane); const float q0 = bf_lo(qw), q1 = bf_hi(qw);
        float m = F.sink[l * 12 + h], ls = 1.f, o0 = 0.f, o1 = 0.f;
        const int j0 = p - 128 < 0 ? 0 : p - 128, j1 = p + 128 > SEQ - 1 ? SEQ - 1 : p + 128;
#pragma unroll 4
        for (int j = j0; j <= j1; ++j) {
            const size_t krow = (size_t)b * SEQ + j;
            const unsigned kw = *(const unsigned*)(P + krow * INW + KB + kvh * 128 + 2 * lane), vw = *(const unsigned*)(P + krow * INW + VB + kvh * 128 + 2 * lane);
            const float s = wave_sum(q0 * bf_lo(kw) + q1 * bf_hi(kw), lane) * 0.08838834764831845f + F.t5[t5_bucket(j - p) * 12 + h];
            const float mn = fmaxf(m, s), a = __expf(m - mn), pe = __expf(s - mn);
            ls = ls * a + pe; o0 = o0 * a + pe * bf_lo(vw); o1 = o1 * a + pe * bf_hi(vw); m = mn;
        }
        const unsigned zw = *(const unsigned*)(P + row * INW + ZB + h * 128 + 2 * lane); const float inv = 1.0f / ls;
        *(unsigned*)(X + row * DM + 1536 + h * 128 + 2 * lane) = cvt_pk_bf16(o0 * inv * bf_lo(zw), o1 * inv * bf_hi(zw));
    }
    const bf16_t* KV = F.KVM + (size_t)l * MROWS * KVW;
    if (!FLASH_MEM) for (int it = gw; it < NSEQ * 4 * SEQ; it += NGW) {
        const int p = it % SEQ, h = (it / SEQ) % 4, b = it / (SEQ * 4);
        const size_t row = (size_t)b * SEQ + p;
        const u32x2 qw = *(const u32x2*)(P + row * INW + QM + h * 256 + 4 * lane); const float q0 = bf_lo(qw.x), q1 = bf_hi(qw.x), q2 = bf_lo(qw.y), q3 = bf_hi(qw.y);
        float m = -1e30f, ls = 0.f, o0 = 0.f, o1 = 0.f, o2 = 0.f, o3 = 0.f;
#pragma unroll 4
        for (int j = 0; j < MEMT; ++j) {
            const size_t krow = (size_t)b * MEMT + j;
            const u32x2 kw = *(const u32x2*)(KV + krow * KVW + h * 256 + 4 * lane), vw = *(const u32x2*)(KV + krow * KVW + 1024 + h * 256 + 4 * lane);
            const float s = wave_sum((q0 * bf_lo(kw.x) + q1 * bf_hi(kw.x)) + (q2 * bf_lo(kw.y) + q3 * bf_hi(kw.y)), lane) * 0.0625f;
            const float mn = fmaxf(m, s), a = __expf(m - mn), pe = __expf(s - mn);
            ls = ls * a + pe; o0 = o0 * a + pe * bf_lo(vw.x); o1 = o1 * a + pe * bf_hi(vw.x); o2 = o2 * a + pe * bf_lo(vw.y); o3 = o3 * a + pe * bf_hi(vw.y); m = mn;
        }
        const u32x2 zw = *(const u32x2*)(P + row * INW + ZM + h * 256 + 4 * lane); const float inv = 1.0f / ls;
        u32x2 w; w.x = cvt_pk_bf16(o0 * inv * bf_lo(zw.x), o1 * inv * bf_hi(zw.x)); w.y = cvt_pk_bf16(o2 * inv * bf_lo(zw.y), o3 * inv * bf_hi(zw.y));
        *(u32x2*)(X + row * DM + 3072 + h * 256 + 4 * lane) = w;
    }
}


namespace fa {
typedef float f32x16 __attribute__((ext_vector_type(16)));
typedef short s16x4 __attribute__((ext_vector_type(4)));
constexpr int SHM_V = 16384, SHM_K = 16384;
constexpr int OFF_V = 0, OFF_K = 32768, OFF_OST = 65536  , OFF_WS = RING_BYTES + 2048, OFF_TBL = RING_BYTES + 4096, TBL_PAD = 256;
constexpr int OFF_WS_MEM = RING_BYTES + 1024, OFF_OST_MEM = RING_BYTES + 16384;
constexpr float THR2 = 11.5f;
constexpr float NEG = -1e30f;
#define FA_KSWZ(row, colB) ((row) * 256 + ((colB) ^ (((row) & 7) << 4)))
#define FA_SBAR() __builtin_amdgcn_sched_barrier(0)
__device__ __forceinline__ int crow(int r, int hi) { return (r & 3) + 8 * (r >> 2) + 4 * hi; }
__device__ __forceinline__ int v_st(int k, int c) { const int kk = (k & ~0xC) | ((k & 4) << 1) | ((k & 8) >> 1); return ((kk >> 3) * 4 + (c >> 5)) * 512 + ((kk & 7) * 32 + (c & 31)) * 2; }
__device__ __forceinline__ int v_rd_base(int lane) { return ((lane & 3) << 3) | (((lane >> 2) & 3) << 6) | (((lane >> 4) & 1) << 5) | (((lane >> 5) & 1) << 8); }
constexpr int v_rd_off(int d0, int ks, int half) { return d0 * 512 + ks * 4096 + half * 2048; }
template <int OFF> __device__ __forceinline__ s16x4 tr_read(int vb) { s16x4 r; asm volatile("ds_read_b64_tr_b16 %0, %1 offset:%2" : "=&v"(r) : "v"(vb), "i"(OFF) : "memory"); return r; }
template <int D0> __device__ __forceinline__ void pv_one(f32x16& od, int vb, bf16x8 pa0, bf16x8 pa1, bf16x8 pa2, bf16x8 pa3) {
    const s16x4 l0 = tr_read<v_rd_off(D0, 0, 0)>(vb), h0 = tr_read<v_rd_off(D0, 0, 1)>(vb), l1 = tr_read<v_rd_off(D0, 1, 0)>(vb), h1 = tr_read<v_rd_off(D0, 1, 1)>(vb);
    const s16x4 l2 = tr_read<v_rd_off(D0, 2, 0)>(vb), h2 = tr_read<v_rd_off(D0, 2, 1)>(vb), l3 = tr_read<v_rd_off(D0, 3, 0)>(vb), h3 = tr_read<v_rd_off(D0, 3, 1)>(vb);
    asm volatile("s_waitcnt lgkmcnt(0)" ::: "memory"); FA_SBAR();
#define FA_PK(L, H) (bf16x8){L[0], L[1], L[2], L[3], H[0], H[1], H[2], H[3]}
    od = __builtin_amdgcn_mfma_f32_32x32x16_bf16(pa0, FA_PK(l0, h0), od, 0, 0, 0);
    od = __builtin_amdgcn_mfma_f32_32x32x16_bf16(pa1, FA_PK(l1, h1), od, 0, 0, 0);
    od = __builtin_amdgcn_mfma_f32_32x32x16_bf16(pa2, FA_PK(l2, h2), od, 0, 0, 0);
    od = __builtin_amdgcn_mfma_f32_32x32x16_bf16(pa3, FA_PK(l3, h3), od, 0, 0, 0);
#undef FA_PK
}
__device__ __forceinline__ void pv_d0(f32x16* o, int vb, bf16x8 pa0, bf16x8 pa1, bf16x8 pa2, bf16x8 pa3) {
    pv_one<0>(o[0], vb, pa0, pa1, pa2, pa3); pv_one<1>(o[1], vb, pa0, pa1, pa2, pa3); pv_one<2>(o[2], vb, pa0, pa1, pa2, pa3); pv_one<3>(o[3], vb, pa0, pa1, pa2, pa3);
}
template <int P1T> __device__ __forceinline__ void qkt(f32x16& p0, f32x16& p1, const LAS unsigned char* Ks, const bf16x8* qr, int r32, int hi, const LAS float* tb) {
#pragma unroll
    for (int r = 0; r < 16; ++r) { const int k0 = (r & 3) + 8 * (r >> 2); p0[r] = tb[k0]; p1[r] = tb[P1T + k0]; }
#ifndef FA_KBATCH
#define FA_KBATCH 2
#endif
#pragma unroll
    for (int g = 0; g < 8 / FA_KBATCH; ++g) { bf16x8 kf0[FA_KBATCH], kf1[FA_KBATCH];
#pragma unroll
        for (int d = 0; d < FA_KBATCH; ++d) { const int cb = ((g * FA_KBATCH + d) * 16 + hi * 8) * 2; kf0[d] = *(const LAS bf16x8*)(Ks + FA_KSWZ(r32, cb)); kf1[d] = *(const LAS bf16x8*)(Ks + FA_KSWZ(32 + r32, cb)); }
        FA_SBAR();
#pragma unroll
        for (int d = 0; d < FA_KBATCH; ++d) { p0 = __builtin_amdgcn_mfma_f32_32x32x16_bf16(kf0[d], qr[g * FA_KBATCH + d], p0, 0, 0, 0); p1 = __builtin_amdgcn_mfma_f32_32x32x16_bf16(kf1[d], qr[g * FA_KBATCH + d], p1, 0, 0, 0); }
        FA_SBAR(); }
}
template <int P1V> __device__ __forceinline__ void apply_bias(f32x16& p0, f32x16& p1, int vb, unsigned vl0, unsigned vl1, float C) {
#pragma unroll
    for (int r = 0; r < 16; ++r) { const int k0 = (r & 3) + 8 * (r >> 2);
        const float x0 = p0[r] * C, x1 = p1[r] * C;
        p0[r] = ((unsigned)(vb + k0) < vl0) ? x0 : NEG; p1[r] = ((unsigned)(vb + P1V + k0) < vl1) ? x1 : NEG; }
}
__device__ __forceinline__ void partialSM(f32x16& p0, f32x16& p1, float& m_reg, float& alpha) {
    float pmax = p0[0];
#pragma unroll
    for (int r = 1; r < 16; ++r) pmax = fmaxf(pmax, p0[r]);
#pragma unroll
    for (int r = 0; r < 16; ++r) pmax = fmaxf(pmax, p1[r]);
    { auto rr = __builtin_amdgcn_permlane32_swap(__float_as_uint(pmax), __float_as_uint(pmax), false, false); pmax = fmaxf(__uint_as_float(rr[0]), __uint_as_float(rr[1])); }
    if (__builtin_expect(__all(pmax - m_reg <= THR2), 1)) { alpha = 1.f; }
    else { const float mn = fmaxf(m_reg, pmax); alpha = __builtin_amdgcn_exp2f(m_reg - mn); m_reg = mn; }
#pragma unroll
    for (int r = 0; r < 16; ++r) { p0[r] = __builtin_amdgcn_exp2f(p0[r] - m_reg); p1[r] = p1[r] - m_reg; }
}
#define FA_PK4(P, BASE, OUT) do { const unsigned a0 = cvt_pk_bf16(P[BASE + 0], P[BASE + 1]), a1 = cvt_pk_bf16(P[BASE + 2], P[BASE + 3]);   \
    const unsigned b0 = cvt_pk_bf16(P[BASE + 4], P[BASE + 5]), b1 = cvt_pk_bf16(P[BASE + 6], P[BASE + 7]);                              \
    auto r0 = __builtin_amdgcn_permlane32_swap(a0, b0, false, false); auto r1 = __builtin_amdgcn_permlane32_swap(a1, b1, false, false); \
    u32x4 w = {r0[0], r1[0], r0[1], r1[1]}; OUT = __builtin_bit_cast(bf16x8, w); } while (0)
__device__ __forceinline__ void finishSM(f32x16& p0, f32x16& p1, float alpha, float& l_reg, bf16x8& pa0, bf16x8& pa1, bf16x8& pa2, bf16x8& pa3) {
#pragma unroll
    for (int r = 0; r < 16; ++r) p1[r] = __builtin_amdgcn_exp2f(p1[r]);
    float ps = 0.f;
#pragma unroll
    for (int r = 0; r < 16; ++r) ps += p0[r];
#pragma unroll
    for (int r = 0; r < 16; ++r) ps += p1[r];
    { auto rr = __builtin_amdgcn_permlane32_swap(__float_as_uint(ps), __float_as_uint(ps), false, false); ps = __uint_as_float(rr[0]) + __uint_as_float(rr[1]); }
    l_reg = l_reg * alpha + ps;
    FA_PK4(p0, 0, pa0); FA_PK4(p0, 8, pa1); FA_PK4(p1, 0, pa2); FA_PK4(p1, 8, pa3);
}

struct FlashUnit {
    const bf16_t *Q, *K, *V, *Z; bf16_t* O;
    int NT, jlo, jhi;
    int tblo;
    float tv; int tcnt;
    int rsl;
    int lane_off, jstride, vbase, vstride; unsigned vlim;
    float m_init, l_init, C;
};
template <bool NA2>
__device__ __forceinline__ void flash_unit(LAS unsigned char* lds, const FlashUnit& U, int tid) {
    const int wid = __builtin_amdgcn_readfirstlane(tid >> 6), lane = tid & 63, r32 = lane & 31, hi = lane >> 5;
    constexpr int EHI = NA2 ? 64 : 16, KROW1 = NA2 ? 64 : 32, KTILE = NA2 ? 128 : 64, P1T = NA2 ? 31 : 32, P1V = NA2 ? 0 : 32;
    constexpr int KP = GATES_FP8 ? 128 : INW;
    const int ebase = NA2 ? wid * 128 : wid * 32;
    LAS unsigned char* V_lds = lds + OFF_V; LAS unsigned char* K_lds = lds + OFF_K;
    LAS float* wsx = (LAS float*)(lds + OFF_WS) + wid * 64; LAS float* li_l = wsx; LAS float* al_l = wsx + 32;
    const LAS float* tbl = (const LAS float*)(lds + U.tblo) + TBL_PAD + U.lane_off;
    float m_reg = U.m_init, l_reg = U.l_init; f32x16 o[4] = {}; bf16x8 qr[8];
    { const GAS char* Qw = (const GAS char*)U.Q; const unsigned qo = (unsigned)((ebase + (r32 & 15) + (r32 >> 4) * EHI) * INW + hi * 8) * 2u;
#pragma unroll
      for (int d0 = 0; d0 < 8; ++d0) qr[d0] = *(const GAS bf16x8*)(Qw + qo + d0 * 32); }
    const int sr = tid >> 4, sc = (tid & 15) * 8, vst0 = v_st(sr, sc), vst1 = v_st(32 + sr, sc), kst0 = FA_KSWZ(sr, sc * 2), kst1 = FA_KSWZ(32 + sr, sc * 2);
    const int vb0 = (int)(unsigned)(size_t)V_lds + v_rd_base(lane);
    const unsigned go0 = (unsigned)(sr * KP + sc) * 2u, go1 = (unsigned)((KROW1 + sr) * KP + sc) * 2u;
    constexpr size_t TILE_B = (size_t)KTILE * KP * 2;
    bf16x8 sv0[2], sv1[2], sk0[2], sk1[2];
#define FA_SLOAD(i, j) do { const GAS char* kt = (const GAS char*)U.K + (size_t)(j) * TILE_B; const GAS char* vt = (const GAS char*)U.V + (size_t)(j) * TILE_B; \
    sv0[i] = *(const GAS bf16x8*)(vt + go0); sv1[i] = *(const GAS bf16x8*)(vt + go1); sk0[i] = *(const GAS bf16x8*)(kt + go0); sk1[i] = *(const GAS bf16x8*)(kt + go1); } while (0)
#define FA_SWRITE(b, i) do { *(LAS bf16x8*)(V_lds + (b) * SHM_V + vst0) = sv0[i]; *(LAS bf16x8*)(V_lds + (b) * SHM_V + vst1) = sv1[i]; \
    *(LAS bf16x8*)(K_lds + (b) * SHM_K + kst0) = sk0[i]; *(LAS bf16x8*)(K_lds + (b) * SHM_K + kst1) = sk1[i]; } while (0)
    const int NT = U.NT;
    FA_SLOAD(0, 0); if (1 < NT) FA_SLOAD(1, 1);
    __builtin_amdgcn_sched_barrier(0);
    if (tid < U.tcnt) ((LAS float*)(lds + U.tblo))[TBL_PAD + tid] = U.tv * 11.313708498984761f;
#define FA_TILE(j, BUF) do { \
    FA_SWRITE(BUF, BUF); __syncthreads(); \
    if ((j) + 2 < NT) FA_SLOAD(BUF, (j) + 2); \
    if ((j) >= U.jlo && (j) < U.jhi) { f32x16 p0, p1; float alpha; bf16x8 pa0, pa1, pa2, pa3; \
        qkt<P1T>(p0, p1, K_lds + (BUF) * SHM_K, qr, r32, hi, tbl + (j) * U.jstride); \
        unsigned vl0 = U.vlim, vl1 = U.vlim; if constexpr (NA2) { vl0 = ((unsigned)(2 * (j) - U.rsl) < 8u) ? 16u : 0u; vl1 = ((unsigned)(2 * (j) + 1 - U.rsl) < 8u) ? 16u : 0u; } \
        apply_bias<P1V>(p0, p1, U.vbase + (j) * U.vstride, vl0, vl1, U.C); \
        partialSM(p0, p1, m_reg, alpha); finishSM(p0, p1, alpha, l_reg, pa0, pa1, pa2, pa3); \
        if (__any(alpha < 1.f)) { if (hi == 0) al_l[r32] = alpha; asm volatile("s_waitcnt lgkmcnt(0)" ::: "memory"); \
            _Pragma("unroll") for (int d = 0; d < 4; ++d) _Pragma("unroll") for (int r = 0; r < 16; ++r) o[d][r] *= al_l[crow(r, hi)]; } \
        pv_d0(o, vb0 + (BUF) * SHM_V, pa0, pa1, pa2, pa3); } } while (0)
    int j = 0;
    for (; j + 1 < NT; j += 2) { FA_TILE(j, 0); FA_TILE(j + 1, 1); }
    if (j < NT) FA_TILE(j, 0);
    { const GAS bf16_t* zb = (const GAS bf16_t*)U.Z + (size_t)ebase * INW; GAS bf16_t* ob = (GAS bf16_t*)U.O + (size_t)ebase * DM;
      int ln2 = lane; asm volatile("" : "+v"(ln2));
      u32x4 zv[8];
#pragma unroll
      for (int k = 0; k < 8; ++k) { const int ch = ln2 + 64 * k, row = ch >> 4, c16 = ch & 15, grow = (row & 15) + (row >> 4) * EHI; zv[k] = *(const GAS u32x4*)(zb + (size_t)grow * INW + c16 * 8); }
      if (hi == 0) li_l[r32] = l_reg; asm volatile("s_waitcnt lgkmcnt(0)" ::: "memory");
      LAS unsigned char* stg = lds + OFF_OST + wid * 8192;
#pragma unroll
      for (int r = 0; r < 16; ++r) { const int lr = crow(r, hi); const float rl = __builtin_amdgcn_rcpf(li_l[lr]);
#pragma unroll
          for (int d0 = 0; d0 < 4; ++d0) *(LAS bf16_t*)(stg + lr * 256 + (d0 * 32 + r32) * 2) = (bf16_t)f2bf(o[d0][r] * rl); }
      asm volatile("s_waitcnt lgkmcnt(0)" ::: "memory"); __builtin_amdgcn_sched_barrier(0);
#pragma unroll
      for (int k = 0; k < 8; ++k) { const int ch = ln2 + 64 * k, row = ch >> 4, c16 = ch & 15, grow = (row & 15) + (row >> 4) * EHI; const u32x4 ov = *(const LAS u32x4*)(stg + row * 256 + c16 * 16); const u32x4 z = zv[k];
          u32x4 w; w.x = cvt_pk_bf16(bf_lo(ov.x) * bf_lo(z.x), bf_hi(ov.x) * bf_hi(z.x)); w.y = cvt_pk_bf16(bf_lo(ov.y) * bf_lo(z.y), bf_hi(ov.y) * bf_hi(z.y));
          w.z = cvt_pk_bf16(bf_lo(ov.z) * bf_lo(z.z), bf_hi(ov.z) * bf_hi(z.z)); w.w = cvt_pk_bf16(bf_lo(ov.w) * bf_lo(z.w), bf_hi(ov.w) * bf_hi(z.w));
          *(GAS u32x4*)(ob + (size_t)grow * DM + c16 * 8) = w; } }
#undef FA_SLOAD
#undef FA_SWRITE
#undef FA_TILE
}

__device__ __forceinline__ void mem_unit(LAS unsigned char* lds, const bf16_t* Qb, const bf16_t* KVg, const bf16_t* Zb, bf16_t* Ob, int tid) {
    const int wid = __builtin_amdgcn_readfirstlane(tid >> 6), lane = tid & 63, r32 = lane & 31, hi = lane >> 5;
    bf16x8 kv[16];
#pragma unroll
    for (int i = 0; i < 16; ++i) { const int ch = i * 512 + tid, key = ch >> 5, c16 = ch & 31; kv[i] = *(const GAS bf16x8*)((const GAS bf16_t*)KVg + (size_t)key * KVW + c16 * 8); }
    __syncthreads();
#pragma unroll
    for (int i = 0; i < 16; ++i) { const int ch = i * 512 + tid, key = ch >> 5, c16 = ch & 31; *(LAS bf16x8*)(lds + key * 512 + ((c16 * 16) ^ ((key & 7) << 4))) = kv[i]; }
    __syncthreads();
    f32x16 p[8];
#pragma unroll
    for (int kb = 0; kb < 8; ++kb) p[kb] = (f32x16){};
    const GAS bf16_t* Qw = (const GAS bf16_t*)Qb + (size_t)(wid * 32 + r32) * INW + hi * 8;
#pragma unroll
    for (int d0 = 0; d0 < 16; ++d0) { const bf16x8 qf = *(const GAS bf16x8*)(Qw + d0 * 16); const int cb = (d0 * 32 + hi * 16) ^ ((r32 & 7) << 4);
#pragma unroll
        for (int kb = 0; kb < 8; ++kb) { const bf16x8 kf = *(const LAS bf16x8*)(lds + (kb * 32 + r32) * 512 + cb); p[kb] = __builtin_amdgcn_mfma_f32_32x32x16_bf16(kf, qf, p[kb], 0, 0, 0); } }
#pragma unroll
    for (int i = 0; i < 16; ++i) { const int ch = i * 512 + tid, key = ch >> 5, c16 = ch & 31; kv[i] = *(const GAS bf16x8*)((const GAS bf16_t*)KVg + (size_t)key * KVW + 1024 + c16 * 8); }
    constexpr float C2 = 0.0625f * LOG2E;
    float mx = p[0][0];
#pragma unroll
    for (int kb = 0; kb < 8; ++kb)
#pragma unroll
        for (int r = 0; r < 16; ++r) mx = fmaxf(mx, p[kb][r]);
    { auto rr = __builtin_amdgcn_permlane32_swap(__float_as_uint(mx), __float_as_uint(mx), false, false); mx = fmaxf(__uint_as_float(rr[0]), __uint_as_float(rr[1])); }
    const float mc = -mx * C2; float ls = 0.f;
#pragma unroll
    for (int kb = 0; kb < 8; ++kb)
#pragma unroll
        for (int r = 0; r < 16; ++r) { const float e = __builtin_amdgcn_exp2f(fmaf(p[kb][r], C2, mc)); p[kb][r] = e; ls += e; }
    { auto rr = __builtin_amdgcn_permlane32_swap(__float_as_uint(ls), __float_as_uint(ls), false, false); ls = __uint_as_float(rr[0]) + __uint_as_float(rr[1]); }
    bf16x8 pa[4][4];
#pragma unroll
    for (int g = 0; g < 4; ++g) { FA_PK4(p[2 * g], 0, pa[g][0]); FA_PK4(p[2 * g], 8, pa[g][1]); FA_PK4(p[2 * g + 1], 0, pa[g][2]); FA_PK4(p[2 * g + 1], 8, pa[g][3]); }
    __syncthreads();
#pragma unroll
    for (int i = 0; i < 16; ++i) { const int ch = i * 512 + tid, key = ch >> 5, c16 = ch & 31, d = c16 * 8;
        *(LAS bf16x8*)(lds + ((key >> 6) * 2 + (d >> 7)) * 16384 + v_st(key & 63, d & 127)) = kv[i]; }
    __syncthreads();
    const int vb0 = (int)(unsigned)(size_t)lds + v_rd_base(lane);
    LAS float* li_l = (LAS float*)(lds + OFF_WS_MEM) + wid * 32;
    if (hi == 0) li_l[r32] = ls; asm volatile("s_waitcnt lgkmcnt(0)" ::: "memory");
    LAS unsigned char* stg = lds + OFF_OST_MEM + wid * 2048;
#pragma unroll
    for (int dh = 0; dh < 2; ++dh) {
        int ln2 = lane; asm volatile("" : "+v"(ln2));
        const GAS bf16_t* zb = (const GAS bf16_t*)Zb + (size_t)(wid * 32) * INW + dh * 128; GAS bf16_t* ob = (GAS bf16_t*)Ob + (size_t)(wid * 32) * DM + dh * 128;
        u32x4 zv[8];
#pragma unroll
        for (int k = 0; k < 8; ++k) { const int ch = ln2 + 64 * k, row = ch >> 4, c16 = ch & 15; zv[k] = *(const GAS u32x4*)(zb + (size_t)row * INW + c16 * 8); }
        f32x16 o[4] = {};
#pragma unroll
        for (int g = 0; g < 4; ++g) pv_d0(o, vb0 + (g * 2 + dh) * 16384, pa[g][0], pa[g][1], pa[g][2], pa[g][3]);
#pragma unroll
        for (int p = 0; p < 4; ++p) {
#pragma unroll
            for (int q = 0; q < 4; ++q) { const int r = 4 * p + q, lr8 = q + 4 * hi; const float rl = __builtin_amdgcn_rcpf(li_l[8 * p + lr8]);
#pragma unroll
                for (int d0 = 0; d0 < 4; ++d0) *(LAS bf16_t*)(stg + lr8 * 256 + (d0 * 32 + r32) * 2) = (bf16_t)f2bf(o[d0][r] * rl); }
            asm volatile("s_waitcnt lgkmcnt(0)" ::: "memory");
#pragma unroll
            for (int k = 0; k < 2; ++k) { const int ch = ln2 + 64 * k, row8 = ch >> 4, c16 = ch & 15; const u32x4 ov = *(const LAS u32x4*)(stg + row8 * 256 + c16 * 16); const u32x4 z = zv[2 * p + k];
                u32x4 w; w.x = cvt_pk_bf16(bf_lo(ov.x) * bf_lo(z.x), bf_hi(ov.x) * bf_hi(z.x)); w.y = cvt_pk_bf16(bf_lo(ov.y) * bf_lo(z.y), bf_hi(ov.y) * bf_hi(z.y));
                w.z = cvt_pk_bf16(bf_lo(ov.z) * bf_lo(z.z), bf_hi(ov.z) * bf_hi(z.z)); w.w = cvt_pk_bf16(bf_lo(ov.w) * bf_lo(z.w), bf_hi(ov.w) * bf_hi(z.w));
                *(GAS u32x4*)(ob + (size_t)(8 * p + row8) * DM + c16 * 8) = w; }
            asm volatile("s_waitcnt lgkmcnt(0)" ::: "memory");
        }
    }
}
}

#ifndef FLASH_NA
#define FLASH_NA 1
#endif
#ifndef FLASH_SW
#define FLASH_SW 1
#endif
#ifndef FLASH_MEM
#define FLASH_MEM 1
#endif
__device__ __forceinline__ void attention_phase(Frame& F, int l, int mask = 7) {
    LAS unsigned char* lds = F.lds; const int tid = F.tid, G = F.G;
    int tpar = 0;
    const int wid = F.wave;
    if (FLASH_NA && (mask & 1)) for (int i = 0;; ++i) {
        const int u = i * G + F.vcu; if (u >= 1152) break;
        const int bh = u >> 3, blk = u & 7, b = bh / 12, h = bh % 12;
        const int ln = lane_id_hw(), r32 = ln & 31, hi = ln >> 5;
        fa::FlashUnit U; U.C = 0.08838834764831845f * LOG2E; U.tblo = fa::OFF_TBL + tpar * 4096; tpar ^= 1;
        const int rb = blk >> 2, cb = blk & 3, lo = rb ? 12 : 0; U.NT = 10;
        int c0 = 16 * cb - 8; c0 = c0 < 0 ? 0 : (c0 > 32 ? 32 : c0);
        const size_t tok0 = (size_t)b * SEQ + rb * 1024 + cb * 16;
        const int qr = 16 * rb + 2 * wid + (r32 >> 4), qc = 16 * cb + (r32 & 15);
        int rs = qr - 4; rs = rs < 0 ? 0 : (rs > 24 ? 24 : rs); int cs = qc - 8; cs = cs < 0 ? 0 : (cs > 48 ? 48 : cs);
        int rsA = 16 * rb + 2 * wid - 4; rsA = rsA < 0 ? 0 : (rsA > 24 ? 24 : rsA); int rsB = 16 * rb + 2 * wid - 3; rsB = rsB < 0 ? 0 : (rsB > 24 ? 24 : rsB);
        U.Q = F.P + tok0 * INW + QA + h * 128; if (GATES_FP8) { const size_t ko = ((size_t)(b * 12 + h) * SEQ + lo * 64 + c0) * 128; U.K = (const bf16_t*)(F.ws + WS_KNA) + ko; U.V = (const bf16_t*)(F.ws + WS_VNA) + ko; }
        else { U.K = F.P + ((size_t)b * SEQ + lo * 64 + c0) * INW + KA + h * 128; U.V = U.K + (VA - KA); } U.Z = F.P + tok0 * INW + ZA + h * 128; U.O = F.X + tok0 * DM + h * 128;
        U.jlo = (rsA - lo) >> 1; U.jhi = ((rsB + 7 - lo) >> 1) + 1; U.rsl = rs - lo;
        U.lane_off = (lo - qr + 7) * 31 + (c0 - qc + 15) + 4 * hi; U.jstride = 62; U.vbase = c0 - cs + 4 * hi; U.vstride = 0; U.vlim = 16u;
        U.m_init = -30000.f; U.l_init = 0.f;
        const float* rp = F.rpb + (size_t)(l * 12 + h) * 465;
        { const int k = wid * 64 + ln; U.tcnt = 465; U.tv = (k < 465) ? ((const GAS float*)rp)[k] : 0.f; }
        if (mask & 8) U.jhi = U.jlo;
        fa::flash_unit<true>(lds, U, wid * 64 + ln);
    }
    if (FLASH_SW && (mask & 2)) for (int i = 0;; ++i) {
        int u = i * G + F.vcu; if (u >= 1152) break;
        int bh, blk;
        if (u < 864) { bh = u / 6; blk = 1 + u % 6; } else { u -= 864; bh = u >> 1; blk = (u & 1) * 7; }
        const int b = bh / 12, h = bh % 12;
        const int ln = lane_id_hw(), r32 = ln & 31, hi = ln >> 5;
        fa::FlashUnit U; U.C = 0.08838834764831845f * LOG2E; U.tblo = fa::OFF_TBL + tpar * 4096; tpar ^= 1; const size_t row0 = (size_t)b * SEQ + blk * 256;
        const int t0 = 256 * blk, kt0 = (blk == 0) ? 0 : t0 - 128; U.NT = (blk == 0 || blk == 7) ? 6 : 8;
        const int tq = t0 + 32 * wid + r32;
        U.Q = F.P + row0 * INW + QB + h * 128; if (GATES_FP8) { const size_t ko = ((size_t)(b * 4 + h / 3) * SEQ + kt0) * 128; U.K = (const bf16_t*)(F.ws + WS_KSW) + ko; U.V = (const bf16_t*)(F.ws + WS_VSW) + ko; }
        else { U.K = F.P + ((size_t)b * SEQ + kt0) * INW + KB + (h / 3) * 128; U.V = U.K + (VB - KB); } U.Z = F.P + row0 * INW + ZB + h * 128; U.O = F.X + row0 * DM + 1536 + h * 128;
        const int a = t0 + 32 * wid - 128 - kt0, bnd = t0 + 32 * wid + 159 - kt0; U.jlo = a <= 0 ? 0 : (a >> 6); { const int jh = (bnd >> 6) + 1; U.jhi = jh < U.NT ? jh : U.NT; }
        U.lane_off = kt0 - tq + 128 + 4 * hi; U.jstride = 64; U.vbase = U.lane_off; U.vstride = 64; U.vlim = 257u;
        U.m_init = F.sink[l * 12 + h] * LOG2E; U.l_init = 1.f; U.rsl = 0;
        { const int k = wid * 64 + ln; U.tcnt = 257; U.tv = (k < 257) ? ((const GAS float*)F.t5)[t5_bucket(k - 128) * 12 + h] : 0.f; }
        if (mask & 8) U.jhi = U.jlo;
        fa::flash_unit<false>(lds, U, wid * 64 + ln);
    }
    __syncthreads();
#if FLASH_MEM
    const bf16_t* KV = F.KVM + (size_t)l * MROWS * KVW;
    if (mask & 4) for (int i = 0;; ++i) {
        const int u = i * G + (G - 1 - F.vcu); if (u >= 384) break;
        const int bh = u >> 3, qb = u & 7, b = bh >> 2, h = bh & 3; const size_t row0 = (size_t)b * SEQ + qb * 256;
        fa::mem_unit(lds, F.P + row0 * INW + QM + h * 256, KV + (size_t)b * MEMT * KVW + h * 256, F.P + row0 * INW + ZM + h * 256, F.X + row0 * DM + 3072 + h * 256, F.wave * 64 + lane_id_hw());
    }
    __syncthreads();
#endif
}

__device__ __forceinline__ const float* x_row(const Frame& F, int m) { return m < TP ? F.xp + (size_t)m * DM : F.xs + (size_t)(m - TP) * DM; }

__device__ __forceinline__ void p0_prologue(Frame& F) {
    LAS float* scr = (LAS float*)(F.lds + F.wave * 16384);
    const int gw = F.vcu * NWAVES + F.wave, NGW = F.G * NWAVES;
    constexpr int I_IN = (DM / 64) * (INW / 32), I_KV = (DM / 64) * (KVW / 32), I_A = (1536 / 64) * (DM / 32), I_M = (1024 / 64) * (DM / 32), I_O = (DM / 64) * (DM / 32);
    constexpr int PER_L = I_IN + I_KV + 2 * I_A + I_M + I_O;
    for (int it = gw; it < DEPTH * PER_L; it += NGW) {
        const int l = it / PER_L; int r = it - l * PER_L;
        if (r < I_IN) { transpose_item(F.w_in + (size_t)l * DM * INW, INW, F.WinT + (size_t)l * INW * DM, DM, 0, nullptr, scr, r, F.lane, GATES_FP8 ? F.W8 + (size_t)l * NGATE * DM : nullptr, GA); continue; } r -= I_IN;
        if (r < I_KV) { transpose_item(F.w_kv + (size_t)l * DM * KVW, KVW, F.WkvT + (size_t)l * KVW * DM, DM, 0, F.mem_norm + l * DM, scr, r, F.lane); continue; } r -= I_KV;
        bf16_t* wc = F.WcatT + (size_t)l * DM * DM;
        if (r < I_A) { transpose_item(F.w_a + (size_t)l * 1536 * DM, DM, wc, DM, 0, nullptr, scr, r, F.lane); continue; } r -= I_A;
        if (r < I_A) { transpose_item(F.w_b + (size_t)l * 1536 * DM, DM, wc, DM, 1536, nullptr, scr, r, F.lane); continue; } r -= I_A;
        if (r < I_M) { transpose_item(F.w_m + (size_t)l * 1024 * DM, DM, wc, DM, 3072, nullptr, scr, r, F.lane); continue; } r -= I_M;
        transpose_item(F.w_out + (size_t)l * DM * DM, DM, F.WoutT + (size_t)l * DM * DM, DM, 0, nullptr, scr, r, F.lane);
    }
    for (int m = gw; m < T; m += NGW) rms_row_to_bf16(x_row(F, m), F.pre_norm, F.H + (size_t)m * DM, F.lane, GATES_FP8 ? F.H8 + (size_t)m * DM : nullptr);
    for (int m = gw; m < MROWS; m += NGW) rms_row_to_bf16(m < 4 * MEMT ? F.memp + (size_t)m * DM : F.mems + (size_t)(m - 4 * MEMT) * DM, nullptr, F.MEMH + (size_t)m * DM, F.lane);
}
__device__ __forceinline__ void post_norm_phase(Frame& F, int l) {
    const int gw = F.vcu * NWAVES + F.wave, NGW = F.G * NWAVES, lane = F.lane;
    const float* pg = F.post_norm + l * DM; const float* npre = (l + 1 < DEPTH) ? F.pre_norm + (l + 1) * DM : nullptr;
    for (int m = gw; m < T; m += NGW) {
        const GAS u32x2* orow = (const GAS u32x2*)(F.X + (size_t)m * DM) + lane;
        GAS u32x2* x1row = (GAS u32x2*)(F.P + (size_t)m * INW + 18432) + lane;
        GAS f32x4* yo = (GAS f32x4*)(F.out + (size_t)m * DM) + lane;
        f32x4 v[16]; u32x2 ov[16]; float s2 = 0.f;
        if (l == 0) { const GAS f32x4* xr = (const GAS f32x4*)x_row(F, m) + lane;
#pragma unroll
            for (int j = 0; j < 16; ++j) { v[j] = xr[64 * j]; ov[j] = orow[64 * j]; } }
        else {
#pragma unroll
            for (int j = 0; j < 16; ++j) { const u32x2 xw = x1row[64 * j]; ov[j] = orow[64 * j]; v[j].x = bf_lo(xw.x); v[j].y = bf_hi(xw.x); v[j].z = bf_lo(xw.y); v[j].w = bf_hi(xw.y); } }
        f32x4 gv[16];
#pragma unroll
        for (int j = 0; j < 16; ++j) gv[j] = ((const GAS f32x4*)pg)[lane + 64 * j];
        __builtin_amdgcn_sched_barrier(0);
        const float ss = wave_sum(F.RSQ[(size_t)m * 64 + lane], lane);
        const float r = 1.0f / sqrtf(ss * (1.0f / DM) + RMS_EPS);
#pragma unroll
        for (int j = 0; j < 16; ++j) { const f32x4 x = v[j]; const u32x2 ow = ov[j]; const f32x4 g = gv[j];
            f32x4 y; y.x = x.x + bf_lo(ow.x) * r * g.x; y.y = x.y + bf_hi(ow.x) * r * g.y; y.z = x.z + bf_lo(ow.y) * r * g.z; y.w = x.w + bf_hi(ow.y) * r * g.w;
            v[j] = y; s2 += (y.x * y.x + y.y * y.y) + (y.z * y.z + y.w * y.w);
            if (npre) { u32x2 w; w.x = cvt_pk_bf16(y.x, y.y); w.y = cvt_pk_bf16(y.z, y.w); x1row[64 * j] = w; } else yo[64 * j] = y; }
        if (npre) {
#pragma unroll
            for (int j = 0; j < 16; ++j) gv[j] = ((const GAS f32x4*)npre)[lane + 64 * j];
            __builtin_amdgcn_sched_barrier(0);
            const float r2 = 1.0f / sqrtf(wave_sum(s2, lane) * (1.0f / DM) + RMS_EPS);
            GAS u32x2* h8 = (GAS u32x2*)(F.H + (size_t)m * DM) + lane;
#pragma unroll
            for (int j = 0; j < 16; ++j) { const f32x4 g = gv[j];
                const float y0 = v[j].x * r2 * g.x, y1 = v[j].y * r2 * g.y, y2 = v[j].z * r2 * g.z, y3 = v[j].w * r2 * g.w;
                u32x2 w; w.x = cvt_pk_bf16(y0, y1); w.y = cvt_pk_bf16(y2, y3); h8[64 * j] = w;
                if (GATES_FP8) ((GAS unsigned*)(F.H8 + (size_t)m * DM))[lane + 64 * j] = pk4_fp8(y0 * H8_SCALE, y1 * H8_SCALE, y2 * H8_SCALE, y3 * H8_SCALE); }
        }
    }
}

constexpr int N_PHASES = 1 + 5 * DEPTH;
__global__ void __launch_bounds__(NWAVES * 64, 2) fwd(Args args) {
    extern __shared__ __attribute__((aligned(16))) unsigned char lds_raw[];
    LAS unsigned char* lds = (LAS unsigned char*)lds_raw;
    const int wave_s = __builtin_amdgcn_readfirstlane((int)threadIdx.x >> 6);
    for (int u = wave_s * 64 + lane_id_hw(); u < (LDS_BYTES - LDSCTL_OFF) / 4; u += NWAVES * 64) ((LAS unsigned*)(lds + LDSCTL_OFF))[u] = 0u;
    __syncthreads();
    unsigned* const barw = (unsigned*)(args.ws + WS_CTL) + CW_BAR;
    XcdBarrier bar; bar.bar = barw; bar.x = 0; bar.st = nullptr;
    if (MK_ONE_LAUNCH) bar = xcd_barrier_post(barw, (volatile LAS unsigned*)(lds + MISC_OFF) + 8, wave_s == 0 && lane_id_hw() == 0);
    const int lo = args.ph_lo, hi = args.ph_hi;
#define IN(k) (lo <= (k) && (k) < hi)
#define SEAM(k) do { if (IN(k) && IN((k) + 1)) xcd_barrier(bar, wave_s == 0 && lane_id_hw() == 0); } while (0)

    const int probe_phase = args.probe_phase, n_iter = DEPTH + args.probe_reps;
    if (IN(0)) { Frame F; make_frame(F, lds, wave_s); p0_prologue(F); SEAM(0); }
    for (int it = 0; it < n_iter; ++it) {
        const bool probing = it >= DEPTH; const int l = probing ? ((it - DEPTH) & 1) : it;
        const int pb = 1 + 5 * l;
        if (probing && it == DEPTH) xcd_barrier(bar, wave_s == 0 && lane_id_hw() == 0);
#define RUN(k) (probing ? (probe_phase == (k)) : IN(pb + (k) - 1))
#define SEAM2(k) do { if (probing || (IN(pb + (k) - 1) && IN(pb + (k)))) xcd_barrier(bar, wave_s == 0 && lane_id_hw() == 0); } while (0)
        if (RUN(1)) {
            Frame F; make_frame(F, lds, wave_s);
            SchedIn S; S.G = F.G; S.c = (int)blockIdx.x; S.nextra = (l == 0) ? 2 * 96 : 0; S.A = (unsigned)WS_H; S.B = (unsigned)(WS_WIN + (size_t)l * INW * DM * 2);
            S.memA = (unsigned)WS_MEMH; S.memB0 = (unsigned)WS_WKV; S.memB1 = (unsigned)(WS_WKV + (size_t)KVW * DM * 2);
            EpiIn E{F.P, F.KVM, F.KVM + (size_t)MROWS * KVW, (bf16_t*)F.ws};
            pg8::gemm_phase<EpiIn, SchedIn>(lds, (const char*)F.ws, S, E, wave_s);
            SEAM2(1);
        }
        if (RUN(2)) { Frame F; make_frame(F, lds, wave_s); attention_phase(F, l); if (!(FLASH_NA && FLASH_SW && FLASH_MEM)) naive_attention(F, l); if (!GATES_FP8) SEAM2(2); }
        if (GATES_FP8 && RUN(2)) {
            Frame F; make_frame(F, lds, wave_s);
            SchedIn8 S8; S8.G = F.G; S8.c = (int)blockIdx.x; S8.A = (unsigned)WS_H8; S8.B = (unsigned)(WS_W8 + (size_t)l * NGATE * DM);
            EpiIn8 E8{F.P};
            pg8::gemm_phase<EpiIn8, SchedIn8, 4096, true>(lds, (const char*)F.ws, S8, E8, wave_s);
            SEAM2(2);
        }
        if (probing && probe_phase >= 6) { Frame F; make_frame(F, lds, wave_s); attention_phase(F, l, probe_phase == 6 ? 1 : probe_phase == 7 ? 2 : probe_phase == 8 ? 4 : probe_phase == 9 ? 9 : 10); xcd_barrier(bar, wave_s == 0 && lane_id_hw() == 0); }
        if (RUN(3)) {
            Frame F; make_frame(F, lds, wave_s);
            SchedBr S; S.G = F.G; S.c = (int)blockIdx.x; S.A = (unsigned)WS_X; S.B = (unsigned)(WS_WCAT + (size_t)l * DM * DM * 2);
            EpiBr E{F.P, F.H};
            pg8::gemm_phase<EpiBr, SchedBr>(lds, (const char*)F.ws, S, E, wave_s);
            SEAM2(3);
        }
        if (RUN(4)) {
            Frame F; make_frame(F, lds, wave_s);
            SchedOut S; S.G = F.G; S.c = (int)blockIdx.x; S.A = (unsigned)WS_H; S.B = (unsigned)(WS_WOUT + (size_t)l * DM * DM * 2);
            EpiOut E{F.X, F.RSQ};
            pg8::gemm_phase<EpiOut, SchedOut>(lds, (const char*)F.ws, S, E, wave_s);
            SEAM2(4);
        }
        if (RUN(5)) { Frame F; make_frame(F, lds, wave_s); if (probing) F.out = (float*)F.P; post_norm_phase(F, probing ? 0 : l); SEAM2(5); }
#undef RUN
#undef SEAM2
    }
#undef IN
#undef SEAM
}

extern "C" void kernel_launch(void* const* d_in, const int* in_sizes, int n_in, void* d_out, int out_size, void* d_ws, size_t ws_size, hipStream_t stream) {
    static int grid = 0;
    if (grid == 0) {
        if (n_in != 16 || in_sizes[0] != TP * DM || in_sizes[1] != (T - TP) * DM || out_size != T * DM || ws_size < WS_END) {
            fprintf(stderr, "kernel_launch: shape mismatch (n_in %d, in0 %d, in1 %d, out %d, ws %zu need %zu); nothing launched\n", n_in, n_in > 0 ? in_sizes[0] : -1, n_in > 1 ? in_sizes[1] : -1, out_size, ws_size, (size_t)WS_END); grid = -1; return; }
        int dev = 0, cus = 0, per_cu = 0;
        if (hipGetDevice(&dev) != hipSuccess || hipDeviceGetAttribute(&cus, hipDeviceAttributeMultiprocessorCount, dev) != hipSuccess) { grid = -1; return; }
        if (hipFuncSetAttribute((const void*)fwd, hipFuncAttributeMaxDynamicSharedMemorySize, LDS_BYTES) != hipSuccess) { fprintf(stderr, "kernel_launch: hipFuncSetAttribute failed\n"); grid = -1; return; }
        if (hipOccupancyMaxActiveBlocksPerMultiprocessor(&per_cu, (const void*)fwd, NWAVES * 64, LDS_BYTES) != hipSuccess || per_cu < 1)
            fprintf(stderr, "kernel_launch: note: occupancy query reports %d workgroups per CU\n", per_cu);
        (void)hipGetLastError();
        grid = cus;
    }
    if (grid < 0) return;
    if (hipMemsetAsync((char*)d_ws + WS_CTL, 0, CTL_ZERO_BYTES, stream) != hipSuccess) { fprintf(stderr, "kernel_launch: memset failed\n"); return; }
    Args a{};
    for (int i = 0; i < 16; ++i) a.in[i] = (const float*)d_in[i];
    a.out = (float*)d_out; a.ws = (unsigned char*)d_ws; a.probe_phase = PROBE_PHASE; a.probe_reps = PROBE_REPS;
#if MK_ONE_LAUNCH
    a.ph_lo = 0; a.ph_hi = N_PHASES;
    hipLaunchKernelGGL(fwd, dim3(grid), dim3(NWAVES * 64), LDS_BYTES, stream, a);
#else
    for (int p = 0; p < N_PHASES; ++p) { a.ph_lo = p; a.ph_hi = p + 1; hipLaunchKernelGGL(fwd, dim3(grid), dim3(NWAVES * 64), LDS_BYTES, stream, a); }
#endif
    const hipError_t le = hipPeekAtLastError();
    if (le != hipSuccess) fprintf(stderr, "kernel_launch: launch failed: %s\n", hipGetErrorName(le));
}
```

```cpp
#include <hip/hip_runtime.h>
#include <cstdio>
#include <cstdint>

#ifndef FLASH_NA
#define FLASH_NA 1
#endif
#ifndef FLASH_SW
#define FLASH_SW 1
#endif
#ifndef FLASH_MEM
#define FLASH_MEM 1
#endif
#ifndef PROBE_PHASE
#define PROBE_PHASE 0
#endif
#ifndef PROBE_REPS
#define PROBE_REPS 0
#endif
#ifndef GATE_U8
#define GATE_U8 1
#endif
#ifndef GATES_FP8
#define GATES_FP8 1
#endif
#ifndef WGM_IN
#define WGM_IN 4
#endif
#ifndef WGM_SM
#define WGM_SM 4
#endif
#ifndef MK_ONE_LAUNCH
#define MK_ONE_LAUNCH 1
#endif

#define LAS __attribute__((address_space(3)))
#define GAS __attribute__((address_space(1)))
typedef unsigned short bf16_t;
typedef short bf16x8 __attribute__((ext_vector_type(8)));
typedef float f32x4 __attribute__((ext_vector_type(4)));
typedef float f32x2 __attribute__((ext_vector_type(2)));
typedef unsigned u32x4 __attribute__((ext_vector_type(4)));
typedef unsigned u32x2 __attribute__((ext_vector_type(2)));

constexpr int DM = 4096, NSEQ = 12, SEQ = 2048, T = NSEQ * SEQ  , DEPTH = 2, TP = 4 * SEQ  ;
constexpr int INW = 24576;
constexpr int MEMT = 256, MROWS = NSEQ * MEMT;
constexpr int KVW = 2048;
constexpr int QA = 0, KA = 1536, VA = 3072, ZA = 4608, QB = 6144, KB = 7680, VB = 8192, ZB = 8704, QM = 10240, ZM = 11264, GA = 12288;
constexpr float RMS_EPS = 1e-6f;
constexpr float LOG2E = 1.4426950408889634f;

constexpr size_t MiB = 1u << 20;
constexpr size_t WS_CTL = 0, CTL_ZERO_BYTES = 64 * 1024;
constexpr size_t WS_WIN = 1 * MiB;
constexpr size_t WS_WKV = WS_WIN + 2 * 192 * MiB;
constexpr size_t WS_WCAT = WS_WKV + 2 * 16 * MiB;
constexpr size_t WS_WOUT = WS_WCAT + 2 * 32 * MiB;
constexpr size_t WS_H = WS_WOUT + 2 * 32 * MiB;
constexpr size_t WS_X = WS_H + 192 * MiB;
constexpr size_t WS_P = WS_X + 192 * MiB;
constexpr size_t WS_MEMH = WS_P + 1152 * MiB;
constexpr size_t WS_KVM = WS_MEMH + 24 * MiB;
constexpr size_t WS_RSQ = WS_KVM + 2 * 12 * MiB;
constexpr size_t WS_H8 = WS_RSQ + 6 * MiB;
constexpr size_t WS_W8 = WS_H8 + 96 * MiB;
constexpr size_t WS_END = WS_W8 + 2 * 48 * MiB;
constexpr size_t WS_KNA = WS_WIN + 96 * MiB, WS_KSW = WS_KNA + 72 * MiB;
constexpr size_t WS_VNA = WS_WIN + 192 * MiB + 96 * MiB, WS_VSW = WS_VNA + 72 * MiB;
constexpr float H8_SCALE = 8.f, W8_SCALE = 256.f, G8_DESCALE = 1.0f / (8.f * 256.f);
constexpr int NGATE = 3 * DM;
constexpr int CW_BAR = 4096;

constexpr int RING_BYTES = 131072;
constexpr int LDSCTL_OFF = RING_BYTES, MISC_OFF = LDSCTL_OFF + 320;
constexpr int LDS_BYTES = 163840;
constexpr int NWAVES = 8;

__device__ __forceinline__ int lane_id_hw() { int l; asm volatile("v_mbcnt_lo_u32_b32 %0, -1, 0\n\tv_mbcnt_hi_u32_b32 %0, -1, %0" : "=v"(l)); return l; }
typedef float f32x2_t_ __attribute__((ext_vector_type(2))); typedef __bf16 bf16x2_t_ __attribute__((ext_vector_type(2)));
__device__ __forceinline__ unsigned cvt_pk_bf16(float lo, float hi) { const f32x2_t_ v = {lo, hi}; const bf16x2_t_ b = __builtin_convertvector(v, bf16x2_t_); return __builtin_bit_cast(unsigned, b); }
__device__ __forceinline__ unsigned pk4_fp8(float a, float b, float c, float d) { int w = __builtin_amdgcn_cvt_pk_fp8_f32(a, b, 0, false); w = __builtin_amdgcn_cvt_pk_fp8_f32(c, d, w, true); return (unsigned)w; }
__device__ __forceinline__ float bf_lo(unsigned w) { return __uint_as_float(w << 16); }
__device__ __forceinline__ float bf_hi(unsigned w) { return __uint_as_float(w & 0xffff0000u); }
__device__ __forceinline__ float sigmoid_f(float x) { return __builtin_amdgcn_rcpf(1.0f + __builtin_amdgcn_exp2f(-x * LOG2E)); }
__device__ __forceinline__ unsigned gate_q8(float g) { return (unsigned)fmaxf(g * 255.0f + 0.5f, 1.0f); }
__device__ __forceinline__ unsigned gate_pk4(const f32x4& g) { return gate_q8(g[0]) | (gate_q8(g[1]) << 8) | (gate_q8(g[2]) << 16) | (gate_q8(g[3]) << 24); }
__device__ __forceinline__ float ub0(unsigned w) { return (float)(w & 0xffu); }
__device__ __forceinline__ float ub1(unsigned w) { return (float)((w >> 8) & 0xffu); }
__device__ __forceinline__ float ub2(unsigned w) { return (float)((w >> 16) & 0xffu); }
__device__ __forceinline__ float ub3(unsigned w) { return (float)(w >> 24); }
__device__ __forceinline__ void gate_ratio4(f32x4& v, unsigned n, unsigned d) {
    v[0] *= ub0(n) * __builtin_amdgcn_rcpf(ub0(d)); v[1] *= ub1(n) * __builtin_amdgcn_rcpf(ub1(d)); v[2] *= ub2(n) * __builtin_amdgcn_rcpf(ub2(d)); v[3] *= ub3(n) * __builtin_amdgcn_rcpf(ub3(d)); }
__device__ __forceinline__ void gate_mul4(f32x4& v, unsigned g) { const float s = 1.0f / 255.0f; v[0] *= ub0(g) * s; v[1] *= ub1(g) * s; v[2] *= ub2(g) * s; v[3] *= ub3(g) * s; }

namespace pg8 {
constexpr int BM = 256, BK = 64, HALF = 128, HTB = HALF * BK * 2, STAGE_BYTES = 8 * HTB, NXCD = 8, WGM = 8;
constexpr size_t KSTEP = (size_t)BK * 2;
constexpr size_t TSTEP16 = (size_t)256 * 4096 * 2, TSTEP8 = (size_t)256 * 4096;
typedef int i32x4 __attribute__((ext_vector_type(4)));
typedef int i32x8 __attribute__((ext_vector_type(8)));
__device__ __forceinline__ i32x8 cat8(bf16x8 lo, bf16x8 hi) { return __builtin_shufflevector(__builtin_bit_cast(i32x4, lo), __builtin_bit_cast(i32x4, hi), 0, 1, 2, 3, 4, 5, 6, 7); }
__host__ __device__ __forceinline__ int lds_byte(int r, int c) { const int st = (r >> 4) * 2 + (c >> 5), rr = r & 15, cc = c & 31, ob = rr * 64 + cc * 2; return st * 1024 + (ob ^ (((ob >> 9) & 1) << 5)); }
__host__ __device__ __forceinline__ void stage_rc(int b, int& R, int& C) { const int st = b / 1024, sb = b % 1024, swz = sb ^ (((sb >> 9) & 1) << 5); R = (st >> 1) * 16 + swz / 64; C = (st & 1) * 32 + (swz % 64) / 2; }
__host__ __device__ __forceinline__ int perm32(int rho) { const int n = rho >> 4, i = rho & 15; return 8 * (i >> 2) + 4 * n + (i & 3); }

struct GUnit { unsigned ao, bo; int nt, pm, pn, kind; };

template <int WGM_> __device__ __forceinline__ void tile_of(int L, int nM, int nN, int& pm, int& pn) {
    const int nwg = nM * nN; int wgid = L;
    { const int q = nwg / NXCD, r = nwg % NXCD, xcd = wgid % NXCD, off = wgid / NXCD; wgid = (xcd < r ? xcd * (q + 1) : r * (q + 1) + (xcd - r) * q) + off; }
    const int nig = WGM_ * nN, gid = wgid / nig, fm = gid * WGM_, gsz = (nM - fm) < WGM_ ? (nM - fm) : WGM_;
    pm = fm + ((wgid % nig) % gsz); pn = (wgid % nig) / gsz;
}

#ifndef PG8_SP2
#define PG8_SP2 true
#endif
template <class Epi, class Sched, int PITCH = 8192, bool F8 = false, bool SP2 = PG8_SP2>
__device__ __forceinline__ void gemm_phase(LAS unsigned char* lds, const char* wsb, const Sched& S, const Epi& E, int wave_s) {
    const int lane = lane_id_hw(), wid = wave_s, tid = wid * 64 + lane;
    const int wr = wid >> 2, wc = wid & 3, fr = lane & 15, fq = lane >> 4;
    unsigned voffA[2], voffB[2];
#pragma unroll
    for (int i = 0; i < 2; ++i) { int R, C; stage_rc(tid * 16 + i * 8192, R, C); const int Rb = (R & ~31) + perm32(R & 31);
        voffA[i] = (unsigned)(R * PITCH + C * 2); voffB[i] = (unsigned)(Rb * PITCH + C * 2); }
    const unsigned kstep = (unsigned)KSTEP, hstep = (unsigned)HALF * PITCH;
    const unsigned ldsw = (unsigned)wid * 1024u;
    const int aoff = lds_byte(wr * 64 + fr, fq * 8), boff = lds_byte(wc * 32 + fr, fq * 8);
#define PG8_SA(b, h) (((b) * 2 + (h)) * HTB)
#define PG8_SB(b, h) ((4 + (b) * 2 + (h)) * HTB)
#define PG8_STAGE(bufoff, gbase, voff) do { unsigned _g = (gbase); asm volatile("" : "+s"(_g));   _Pragma("unroll") for (int _i = 0; _i < 2; ++_i) \
        __builtin_amdgcn_global_load_lds((const unsigned*)(wsb + (size_t)(unsigned)(_g + (voff)[_i])), (LAS unsigned*)(lds + (bufoff) + ldsw + _i * 8192), 16, 0, 0); } while (0)
#define PG8_LDA(dst, b, h) do { if constexpr (F8) { _Pragma("unroll") for (int m = 0; m < 4; ++m) dst##8[m] = cat8(*(const LAS bf16x8*)(lds + PG8_SA(b, h) + aoff + m * 2048), *(const LAS bf16x8*)(lds + PG8_SA(b, h) + aoff + m * 2048 + 1024)); } \
      else { _Pragma("unroll") for (int m = 0; m < 4; ++m) _Pragma("unroll") for (int k = 0; k < 2; ++k) dst[m][k] = *(const LAS bf16x8*)(lds + PG8_SA(b, h) + aoff + m * 2048 + k * 1024); } } while (0)
#define PG8_LDB(dst, b, h) do { if constexpr (F8) { _Pragma("unroll") for (int n = 0; n < 2; ++n) dst##8[n] = cat8(*(const LAS bf16x8*)(lds + PG8_SB(b, h) + boff + n * 2048), *(const LAS bf16x8*)(lds + PG8_SB(b, h) + boff + n * 2048 + 1024)); } \
      else { _Pragma("unroll") for (int n = 0; n < 2; ++n) _Pragma("unroll") for (int k = 0; k < 2; ++k) dst[n][k] = *(const LAS bf16x8*)(lds + PG8_SB(b, h) + boff + n * 2048 + k * 1024); } } while (0)
#define PG8_MMA(ai, bj, At, Bt) do { __builtin_amdgcn_s_setprio(1); if constexpr (F8) { _Pragma("unroll") for (int m = 0; m < 4; ++m) _Pragma("unroll") for (int n = 0; n < 2; ++n) \
        acc[ai][bj][m][n] = __builtin_amdgcn_mfma_scale_f32_16x16x128_f8f6f4(Bt##8[n], At##8[m], acc[ai][bj][m][n], 0, 0, 0, 0, 0, 0); } \
      else { _Pragma("unroll") for (int m = 0; m < 4; ++m) _Pragma("unroll") for (int n = 0; n < 2; ++n) _Pragma("unroll") for (int k = 0; k < 2; ++k) \
        acc[ai][bj][m][n] = __builtin_amdgcn_mfma_f32_16x16x32_bf16(Bt[n][k], At[m][k], acc[ai][bj][m][n], 0, 0, 0); } __builtin_amdgcn_s_setprio(0); } while (0)
#define PG8_WAIT_V(n) asm volatile("s_waitcnt vmcnt(" #n ")" ::: "memory")
#define PG8_WAIT_L(n) asm volatile("s_waitcnt lgkmcnt(" #n ")" ::: "memory")
#define PG8_BAR __builtin_amdgcn_s_barrier()
#define PG8_SCHED __builtin_amdgcn_sched_barrier(0)
    GUnit cur, nxt; int ui = 0;
    if (!S.next(0, cur)) return;
    f32x4 acc[2][2][4][2];
#pragma unroll
    for (int a = 0; a < 2; ++a)
#pragma unroll
        for (int b = 0; b < 2; ++b)
#pragma unroll
            for (int m = 0; m < 4; ++m)
#pragma unroll
                for (int n = 0; n < 2; ++n) acc[a][b][m][n] = (f32x4){0.f, 0.f, 0.f, 0.f};
    bf16x8 At[4][2], B0[2][2], B1[2][2]; i32x8 At8[4], B08[2], B18[2];
    unsigned cA = cur.ao, cB = cur.bo;
    if constexpr (SP2) {
        PG8_STAGE(PG8_SB(0, 0), cB, voffB); PG8_STAGE(PG8_SB(0, 1), cB + hstep, voffB); PG8_STAGE(PG8_SA(0, 0), cA, voffA); PG8_STAGE(PG8_SA(0, 1), cA + hstep, voffA);
        if (wr == 1) PG8_BAR;
        PG8_WAIT_V(2); PG8_BAR;
        PG8_STAGE(PG8_SB(1, 0), cB + kstep, voffB); PG8_STAGE(PG8_SA(1, 0), cA + kstep, voffA); PG8_STAGE(PG8_SB(1, 1), cB + hstep + kstep, voffB);
        PG8_WAIT_V(6); PG8_BAR;
    } else {
    PG8_STAGE(PG8_SB(0, 0), cB, voffB); PG8_STAGE(PG8_SA(0, 0), cA, voffA); PG8_STAGE(PG8_SB(0, 1), cB + hstep, voffB); PG8_STAGE(PG8_SA(0, 1), cA + hstep, voffA);
    if (wr == 1) PG8_BAR;
    PG8_WAIT_V(4); PG8_BAR;
    PG8_STAGE(PG8_SB(1, 0), cB + kstep, voffB); PG8_STAGE(PG8_SA(1, 0), cA + kstep, voffA); PG8_STAGE(PG8_SB(1, 1), cB + hstep + kstep, voffB);
    PG8_WAIT_V(6); PG8_BAR;
    }
    for (;;) {
        const bool has_next = S.next(ui + 1, nxt);
        const unsigned nA = has_next ? nxt.ao : cA, nB = has_next ? nxt.bo : cB;
        const int nt = cur.nt;
        for (int t = 0; t < nt; t += 2) {
            if constexpr (Epi::HAS_MID) { if (t == Epi::MID0 || t == Epi::MID1) { const int l2 = lane_id_hw(); E.mid(acc, cur, t == Epi::MID0 ? 0 : 1, wr, wc, l2 & 15, l2 >> 4); } }
            const bool last = (t == nt - 2);
            const unsigned a1 = cA + (unsigned)(t + 1) * kstep;
            const unsigned a2 = last ? nA : cA + (unsigned)(t + 2) * kstep, b2 = last ? nB : cB + (unsigned)(t + 2) * kstep;
            const unsigned a3 = a2 + kstep, b3 = b2 + kstep;
            if constexpr (SP2) {
            PG8_LDB(B0, 0, 0); PG8_LDB(B1, 0, 1); PG8_SCHED; PG8_LDA(At, 0, 0); PG8_STAGE(PG8_SA(1, 1), a1 + hstep, voffA);
            PG8_WAIT_V(8); PG8_WAIT_L(0); PG8_BAR; PG8_MMA(0, 0, At, B0); PG8_MMA(0, 1, At, B1); PG8_BAR; PG8_SCHED;
            PG8_LDA(At, 0, 1); PG8_STAGE(PG8_SB(0, 0), b2, voffB); PG8_STAGE(PG8_SB(0, 1), b2 + hstep, voffB); PG8_STAGE(PG8_SA(0, 0), a2, voffA);
            PG8_WAIT_V(8); PG8_WAIT_L(0); PG8_BAR; PG8_MMA(1, 0, At, B0); PG8_MMA(1, 1, At, B1); PG8_BAR; PG8_SCHED;
            PG8_LDB(B0, 1, 0); PG8_LDB(B1, 1, 1); PG8_SCHED; PG8_LDA(At, 1, 0); PG8_STAGE(PG8_SA(0, 1), a2 + hstep, voffA);
            PG8_WAIT_V(8); PG8_WAIT_L(0); PG8_BAR; PG8_MMA(0, 0, At, B0); PG8_MMA(0, 1, At, B1); PG8_BAR; PG8_SCHED;
            PG8_LDA(At, 1, 1); PG8_STAGE(PG8_SB(1, 0), b3, voffB); PG8_STAGE(PG8_SB(1, 1), b3 + hstep, voffB); PG8_STAGE(PG8_SA(1, 0), a3, voffA);
            PG8_WAIT_V(8); PG8_WAIT_L(0); PG8_BAR; PG8_MMA(1, 0, At, B0); PG8_MMA(1, 1, At, B1); PG8_BAR; PG8_SCHED;
            } else {
            PG8_LDB(B0, 0, 0); PG8_SCHED; PG8_LDA(At, 0, 0); PG8_STAGE(PG8_SA(1, 1), a1 + hstep, voffA);
            PG8_WAIT_L(8); PG8_BAR; PG8_WAIT_L(0); PG8_MMA(0, 0, At, B0); PG8_BAR; PG8_SCHED;
            PG8_LDB(B1, 0, 1); PG8_STAGE(PG8_SB(0, 0), b2, voffB);
            PG8_BAR; PG8_WAIT_L(0); PG8_MMA(0, 1, At, B1); PG8_BAR;
            PG8_LDA(At, 0, 1); PG8_STAGE(PG8_SA(0, 0), a2, voffA);
            PG8_BAR; PG8_WAIT_L(0); PG8_MMA(1, 0, At, B0); PG8_BAR; PG8_SCHED;
            PG8_STAGE(PG8_SB(0, 1), b2 + hstep, voffB);
            PG8_WAIT_V(6); PG8_BAR; PG8_MMA(1, 1, At, B1); PG8_BAR;
            PG8_LDB(B0, 1, 0); PG8_SCHED; PG8_LDA(At, 1, 0); PG8_STAGE(PG8_SA(0, 1), a2 + hstep, voffA);
            PG8_WAIT_L(8); PG8_BAR; PG8_WAIT_L(0); PG8_MMA(0, 0, At, B0); PG8_BAR; PG8_SCHED;
            PG8_LDB(B1, 1, 1); PG8_STAGE(PG8_SB(1, 0), b3, voffB);
            PG8_BAR; PG8_WAIT_L(0); PG8_MMA(0, 1, At, B1); PG8_BAR;
            PG8_LDA(At, 1, 1); PG8_STAGE(PG8_SA(1, 0), a3, voffA);
            PG8_BAR; PG8_WAIT_L(0); PG8_MMA(1, 0, At, B0); PG8_BAR; PG8_SCHED;
            PG8_STAGE(PG8_SB(1, 1), b3 + hstep, voffB);
            PG8_WAIT_V(6); PG8_BAR; PG8_MMA(1, 1, At, B1); PG8_BAR;
            }
        }
        { const int l2 = lane_id_hw(); E(acc, cur, wr, wc, l2 & 15, l2 >> 4); }
        if (!has_next) break;
#pragma unroll
        for (int a = 0; a < 2; ++a)
#pragma unroll
            for (int b = 0; b < 2; ++b)
#pragma unroll
                for (int m = 0; m < 4; ++m)
#pragma unroll
                    for (int n = 0; n < 2; ++n) acc[a][b][m][n] = (f32x4){0.f, 0.f, 0.f, 0.f};
        cur = nxt; cA = nA; cB = nB; ++ui;
    }
    PG8_WAIT_V(0);
    if (wr == 0) PG8_BAR;
    PG8_BAR;
#undef PG8_SA
#undef PG8_SB
#undef PG8_STAGE
#undef PG8_LDA
#undef PG8_LDB
#undef PG8_MMA
#undef PG8_WAIT_V
#undef PG8_WAIT_L
#undef PG8_BAR
#undef PG8_SCHED
}
}

struct SchedIn {
    int G, c, nextra; unsigned A, B, memA, memB0, memB1;
    __device__ __forceinline__ bool next(int i, pg8::GUnit& u) const {
        int L = i * G + c;
        constexpr int NN = GATES_FP8 ? 48 : 96;
        if (L < 96 * NN) { int pm, pn; pg8::tile_of<WGM_IN>(L, 96, NN, pm, pn); u.ao = A + (unsigned)pm * (unsigned)pg8::TSTEP16; u.bo = B + (unsigned)pn * (unsigned)pg8::TSTEP16; u.nt = 64; u.pm = pm; u.pn = pn; u.kind = 0; return true; }
        L -= 96 * NN; if (L >= nextra) return false;
        const int le = L / 96, r = L % 96, pm = r % 12, pn = r / 12;
        u.ao = memA + (unsigned)pm * (unsigned)pg8::TSTEP16; u.bo = (le ? memB1 : memB0) + (unsigned)pn * (unsigned)pg8::TSTEP16; u.nt = 64; u.pm = pm; u.pn = pn; u.kind = 1 + le; return true;
    }
};
struct EpiIn {   static constexpr bool HAS_MID = false; static constexpr int MID0 = -1, MID1 = -1;
    bf16_t* P; bf16_t* KVM0; bf16_t* KVM1; bf16_t* wsb16;
    __device__ __forceinline__ void operator()(const f32x4 (&acc)[2][2][4][2], const pg8::GUnit& u, int wr, int wc, int fr, int fq) const {
        bf16_t* base; int ldc, mode = 0, bjs = 128; int rowb = u.pm * 256 + wr * 64 + fr, colb = u.pn * 256 + wc * 32 + 8 * fq;
        if (u.kind == 0) { base = P; ldc = INW; const int pn = u.pn; if (pn >= GA / 256) mode = 1; else if ((pn >= ZA / 256 && pn < QB / 256) || (pn >= ZB / 256 && pn < QM / 256) || (pn >= ZM / 256)) mode = 2;
            if (GATES_FP8) {
                int nh = 0, hp = 0; size_t off = 0;
                if (pn >= KA / 256 && pn < VA / 256) { nh = 12; hp = pn - KA / 256; off = WS_KNA; } else if (pn >= VA / 256 && pn < ZA / 256) { nh = 12; hp = pn - VA / 256; off = WS_VNA; }
                else if (pn >= KB / 256 && pn < VB / 256) { nh = 4; hp = pn - KB / 256; off = WS_KSW; } else if (pn >= VB / 256 && pn < ZB / 256) { nh = 4; hp = pn - VB / 256; off = WS_VSW; }
                if (nh) { const int b = u.pm >> 3; base = wsb16 + off / 2; ldc = 128; bjs = SEQ * 128; rowb = (b * nh + 2 * hp) * SEQ + (u.pm & 7) * 256 + wr * 64 + fr; colb = wc * 32 + 8 * fq; } } }
        else { base = (u.kind == 1) ? KVM0 : KVM1; ldc = KVW; }
#pragma unroll
        for (int ai = 0; ai < 2; ++ai)
#pragma unroll
            for (int m = 0; m < 4; ++m) { GAS bf16_t* rowp = (GAS bf16_t*)base + (size_t)(rowb + ai * 128 + m * 16) * ldc + colb;
#pragma unroll
                for (int bj = 0; bj < 2; ++bj) { f32x4 v0 = acc[ai][bj][m][0], v1 = acc[ai][bj][m][1];
                    if (mode == 1) {
#pragma unroll
                        for (int j = 0; j < 4; ++j) { v0[j] = sigmoid_f(v0[j]); v1[j] = sigmoid_f(v1[j]); } }
                    else if (mode == 2) {
#pragma unroll
                        for (int j = 0; j < 4; ++j) { v0[j] = v0[j] * sigmoid_f(v0[j]); v1[j] = v1[j] * sigmoid_f(v1[j]); } }
                    u32x4 w; w.x = cvt_pk_bf16(v0[0], v0[1]); w.y = cvt_pk_bf16(v0[2], v0[3]); w.z = cvt_pk_bf16(v1[0], v1[1]); w.w = cvt_pk_bf16(v1[2], v1[3]);
                    *(GAS u32x4*)(rowp + (size_t)bj * bjs) = w; } }
    }
};
struct SchedIn8 {
    int G, c; unsigned A, B;
    __device__ __forceinline__ bool next(int i, pg8::GUnit& u) const {
        const int L = i * G + c; if (L >= 96 * 48) return false;
        int pm, pn; pg8::tile_of<WGM_IN>(L, 96, 48, pm, pn);
        u.ao = A + (unsigned)pm * (unsigned)pg8::TSTEP8; u.bo = B + (unsigned)pn * (unsigned)pg8::TSTEP8; u.nt = 32; u.pm = pm; u.pn = pn; u.kind = 0; return true;
    }
};
struct EpiIn8 {   static constexpr bool HAS_MID = false; static constexpr int MID0 = -1, MID1 = -1;
    bf16_t* P;
    __device__ __forceinline__ void operator()(const f32x4 (&acc)[2][2][4][2], const pg8::GUnit& u, int wr, int wc, int fr, int fq) const {
#if GATE_U8
        GAS unsigned char* gb = (GAS unsigned char*)P + (size_t)(u.pm * 256 + (wr * 4 + wc) * 32 + fq) * (INW * 2) + (GA * 2 + u.pn * 256 + fr * 16);
#pragma unroll
        for (int ai = 0; ai < 2; ++ai)
#pragma unroll
            for (int m = 0; m < 4; ++m) { u32x4 w; unsigned wq[4];
#pragma unroll
                for (int bj = 0; bj < 2; ++bj)
#pragma unroll
                    for (int n = 0; n < 2; ++n) { f32x4 v = acc[ai][bj][m][n];
#pragma unroll
                        for (int j = 0; j < 4; ++j) v[j] = __builtin_amdgcn_rcpf(1.0f + __builtin_amdgcn_exp2f(v[j] * (-LOG2E * G8_DESCALE)));
                        wq[bj * 2 + n] = gate_pk4(v); }
                w.x = wq[0]; w.y = wq[1]; w.z = wq[2]; w.w = wq[3];
                *(GAS u32x4*)(gb + (size_t)((ai * 4 + m) * 4) * (INW * 2)) = w; }
#else
        const int row0 = u.pm * 256 + wr * 64 + fr, col0 = GA + u.pn * 256 + wc * 32 + 8 * fq;
#pragma unroll
        for (int ai = 0; ai < 2; ++ai)
#pragma unroll
            for (int m = 0; m < 4; ++m) { GAS bf16_t* rowp = (GAS bf16_t*)P + (size_t)(row0 + ai * 128 + m * 16) * INW + col0;
#pragma unroll
                for (int bj = 0; bj < 2; ++bj) { f32x4 v0 = acc[ai][bj][m][0], v1 = acc[ai][bj][m][1];
#pragma unroll
                    for (int j = 0; j < 4; ++j) { v0[j] = __builtin_amdgcn_rcpf(1.0f + __builtin_amdgcn_exp2f(v0[j] * (-LOG2E * G8_DESCALE))); v1[j] = __builtin_amdgcn_rcpf(1.0f + __builtin_amdgcn_exp2f(v1[j] * (-LOG2E * G8_DESCALE))); }
                    u32x4 w; w.x = cvt_pk_bf16(v0[0], v0[1]); w.y = cvt_pk_bf16(v0[2], v0[3]); w.z = cvt_pk_bf16(v1[0], v1[1]); w.w = cvt_pk_bf16(v1[2], v1[3]);
                    *(GAS u32x4*)(rowp + bj * 128) = w; } }
#endif
    }
};
struct SchedBr {
    int G, c; unsigned A, B;
    __device__ __forceinline__ bool next(int i, pg8::GUnit& u) const {
        const int L = i * G + c; if (L >= 96 * 16) return false;
        int pm, pn; pg8::tile_of<WGM_SM>(L, 96, 16, pm, pn);
        u.ao = A + (unsigned)pm * (unsigned)pg8::TSTEP16; u.bo = B + (unsigned)pn * (unsigned)pg8::TSTEP16; u.nt = 64; u.pm = pm; u.pn = pn; u.kind = 0; return true;
    }
};
struct EpiBr {
    static constexpr bool HAS_MID = true; static constexpr int MID0 = 24, MID1 = 48;
    const bf16_t* P; bf16_t* Mg;
    __device__ __forceinline__ void mid(f32x4 (&acc)[2][2][4][2], const pg8::GUnit& u, int b, int wr, int wc, int fr, int fq) const {
#if GATE_U8
        const GAS unsigned char* gp = (const GAS unsigned char*)P + (size_t)(u.pm * 256 + (wr * 4 + wc) * 32 + fq) * (INW * 2) + (GA * 2 + (b * 16 + u.pn) * 256 + fr * 16);
        u32x4 gn[8], gd[8];
#pragma unroll
        for (int k = 0; k < 8; ++k) { const GAS unsigned char* q = gp + (size_t)(k * 4) * (INW * 2); gn[k] = *(const GAS u32x4*)q; gd[k] = *(const GAS u32x4*)(q + DM); }
#pragma unroll
        for (int k = 0; k < 8; ++k) { const int ai = k >> 2, m = k & 3;
            gate_ratio4(acc[ai][0][m][0], gn[k].x, gd[k].x); gate_ratio4(acc[ai][0][m][1], gn[k].y, gd[k].y); gate_ratio4(acc[ai][1][m][0], gn[k].z, gd[k].z); gate_ratio4(acc[ai][1][m][1], gn[k].w, gd[k].w); }
#else
        const int row0 = u.pm * 256 + wr * 64 + fr, col0 = u.pn * 256 + wc * 32 + 8 * fq;
        const GAS bf16_t* gp = (const GAS bf16_t*)P + (size_t)row0 * INW + GA + b * DM + col0;
#pragma unroll
        for (int ai = 0; ai < 2; ++ai) {
            u32x4 gn[4][2], gd[4][2];
#pragma unroll
            for (int m = 0; m < 4; ++m)
#pragma unroll
                for (int bj = 0; bj < 2; ++bj) { const GAS bf16_t* q = gp + (size_t)(ai * 128 + m * 16) * INW + bj * 128; gn[m][bj] = *(const GAS u32x4*)q; gd[m][bj] = *(const GAS u32x4*)(q + DM); }
#pragma unroll
            for (int m = 0; m < 4; ++m)
#pragma unroll
                for (int bj = 0; bj < 2; ++bj) { const u32x4 n4 = gn[m][bj], d4 = gd[m][bj];
                    f32x4& v0 = acc[ai][bj][m][0]; f32x4& v1 = acc[ai][bj][m][1];
                    v0[0] *= bf_lo(n4.x) * __builtin_amdgcn_rcpf(fmaxf(bf_lo(d4.x), 1e-30f)); v0[1] *= bf_hi(n4.x) * __builtin_amdgcn_rcpf(fmaxf(bf_hi(d4.x), 1e-30f));
                    v0[2] *= bf_lo(n4.y) * __builtin_amdgcn_rcpf(fmaxf(bf_lo(d4.y), 1e-30f)); v0[3] *= bf_hi(n4.y) * __builtin_amdgcn_rcpf(fmaxf(bf_hi(d4.y), 1e-30f));
                    v1[0] *= bf_lo(n4.z) * __builtin_amdgcn_rcpf(fmaxf(bf_lo(d4.z), 1e-30f)); v1[1] *= bf_hi(n4.z) * __builtin_amdgcn_rcpf(fmaxf(bf_hi(d4.z), 1e-30f));
                    v1[2] *= bf_lo(n4.w) * __builtin_amdgcn_rcpf(fmaxf(bf_lo(d4.w), 1e-30f)); v1[3] *= bf_hi(n4.w) * __builtin_amdgcn_rcpf(fmaxf(bf_hi(d4.w), 1e-30f)); }
        }
#endif
    }
    __device__ __forceinline__ void operator()(const f32x4 (&acc)[2][2][4][2], const pg8::GUnit& u, int wr, int wc, int fr, int fq) const {
        const int row0 = u.pm * 256 + wr * 64 + fr, col0 = u.pn * 256 + wc * 32 + 8 * fq;
        GAS bf16_t* mp0 = (GAS bf16_t*)Mg + (size_t)row0 * DM + col0;
#if GATE_U8
        const GAS unsigned char* gp = (const GAS unsigned char*)P + (size_t)(u.pm * 256 + (wr * 4 + wc) * 32 + fq) * (INW * 2) + (GA * 2 + (2 * 16 + u.pn) * 256 + fr * 16);
        u32x4 g[8];
#pragma unroll
        for (int k = 0; k < 8; ++k) g[k] = *(const GAS u32x4*)(gp + (size_t)(k * 4) * (INW * 2));
#pragma unroll
        for (int k = 0; k < 8; ++k) { const int ai = k >> 2, m = k & 3;
#pragma unroll
            for (int bj = 0; bj < 2; ++bj) { f32x4 v0 = acc[ai][bj][m][0], v1 = acc[ai][bj][m][1];
                gate_mul4(v0, bj ? g[k].z : g[k].x); gate_mul4(v1, bj ? g[k].w : g[k].y);
                u32x4 w; w.x = cvt_pk_bf16(v0[0], v0[1]); w.y = cvt_pk_bf16(v0[2], v0[3]); w.z = cvt_pk_bf16(v1[0], v1[1]); w.w = cvt_pk_bf16(v1[2], v1[3]);
                *(GAS u32x4*)(mp0 + (size_t)(ai * 128 + m * 16) * DM + bj * 128) = w; } }
#else
        const GAS bf16_t* gp = (const GAS bf16_t*)P + (size_t)row0 * INW + GA + 2 * DM + col0;
#pragma unroll
        for (int ai = 0; ai < 2; ++ai) {
            u32x4 g[4][2];
#pragma unroll
            for (int m = 0; m < 4; ++m)
#pragma unroll
                for (int bj = 0; bj < 2; ++bj) g[m][bj] = *(const GAS u32x4*)(gp + (size_t)(ai * 128 + m * 16) * INW + bj * 128);
#pragma unroll
            for (int m = 0; m < 4; ++m)
#pragma unroll
                for (int bj = 0; bj < 2; ++bj) { const u32x4 gg = g[m][bj];
                    f32x4 v0 = acc[ai][bj][m][0], v1 = acc[ai][bj][m][1];
                    v0[0] *= bf_lo(gg.x); v0[1] *= bf_hi(gg.x); v0[2] *= bf_lo(gg.y); v0[3] *= bf_hi(gg.y); v1[0] *= bf_lo(gg.z); v1[1] *= bf_hi(gg.z); v1[2] *= bf_lo(gg.w); v1[3] *= bf_hi(gg.w);
                    u32x4 w; w.x = cvt_pk_bf16(v0[0], v0[1]); w.y = cvt_pk_bf16(v0[2], v0[3]); w.z = cvt_pk_bf16(v1[0], v1[1]); w.w = cvt_pk_bf16(v1[2], v1[3]);
                    *(GAS u32x4*)(mp0 + (size_t)(ai * 128 + m * 16) * DM + bj * 128) = w; }
        }
#endif
    }
};
struct SchedOut {
    int G, c; unsigned A, B;
    __device__ __forceinline__ bool next(int i, pg8::GUnit& u) const {
        const int L = i * G + c; if (L >= 96 * 16) return false;
        int pm, pn; pg8::tile_of<WGM_SM>(L, 96, 16, pm, pn);
        u.ao = A + (unsigned)pm * (unsigned)pg8::TSTEP16; u.bo = B + (unsigned)pn * (unsigned)pg8::TSTEP16; u.nt = 64; u.pm = pm; u.pn = pn; u.kind = 0; return true;
    }
};
struct EpiOut {  static constexpr bool HAS_MID = false; static constexpr int MID0 = -1, MID1 = -1;
    bf16_t* O; float* RSQ;
    __device__ __forceinline__ void operator()(const f32x4 (&acc)[2][2][4][2], const pg8::GUnit& u, int wr, int wc, int fr, int fq) const {
        const int row0 = u.pm * 256 + wr * 64 + fr, col0 = u.pn * 256 + wc * 32 + 8 * fq;
#pragma unroll
        for (int ai = 0; ai < 2; ++ai)
#pragma unroll
            for (int m = 0; m < 4; ++m) { const size_t row = (size_t)(row0 + ai * 128 + m * 16); float s = 0.f;
#pragma unroll
                for (int bj = 0; bj < 2; ++bj) { const f32x4 v0 = acc[ai][bj][m][0], v1 = acc[ai][bj][m][1];
                    s += (v0[0] * v0[0] + v0[1] * v0[1]) + (v0[2] * v0[2] + v0[3] * v0[3]) + (v1[0] * v1[0] + v1[1] * v1[1]) + (v1[2] * v1[2] + v1[3] * v1[3]);
                    u32x4 w; w.x = cvt_pk_bf16(v0[0], v0[1]); w.y = cvt_pk_bf16(v0[2], v0[3]); w.z = cvt_pk_bf16(v1[0], v1[1]); w.w = cvt_pk_bf16(v1[2], v1[3]);
                    *(GAS u32x4*)((GAS bf16_t*)O + row * DM + col0 + bj * 128) = w; }
                { const int ln = fr + 16 * fq; s += __int_as_float(__builtin_amdgcn_ds_bpermute((ln ^ 16) << 2, __float_as_int(s))); s += __int_as_float(__builtin_amdgcn_ds_bpermute((ln ^ 32) << 2, __float_as_int(s))); }
                if (fq == 0) ((GAS float*)RSQ)[row * 64 + u.pn * 4 + wc] = s; }
    }
};

static_assert(!GATE_U8 || GATES_FP8, "GATE_U8 lives in the fp8 gate GEMM epilogue");
#define XB_TMO      128
#define XB_XCNT(j)  (256  + 64 * (j))
#define XB_XSUB(j)  (1280 + 64 * (j))
#define XB_XGEN(j)  (2304 + 64 * (j))
#define XB_TOP      3328
#define XB_TOPGEN   3392
#define XCD_BAR_WORDS 3456
#define XB_SPIN_CAP (1u << 18)
__device__ __forceinline__ unsigned xb_ld(unsigned* p)              { return __hip_atomic_load(p, __ATOMIC_RELAXED, __HIP_MEMORY_SCOPE_AGENT); }
__device__ __forceinline__ unsigned xb_add(unsigned* p, unsigned v) { return __hip_atomic_fetch_add(p, v, __ATOMIC_RELAXED, __HIP_MEMORY_SCOPE_AGENT); }
__device__ __forceinline__ unsigned xb_xcc_id() { return (unsigned)__builtin_amdgcn_s_getreg((3 << 11) | 20) & 0xFu; }
#define XB_SPIN(cond, bar) do { unsigned _sp = 0; while (cond) { __builtin_amdgcn_s_sleep(1); \
    if ((++_sp & 255u) == 0u) { if (xb_ld(&(bar)[XB_TMO])) break; if (_sp > XB_SPIN_CAP) { atomicAdd(&(bar)[XB_TMO], 1u); break; } } } } while (0)
struct XcdBarrier { unsigned* bar; unsigned x; volatile LAS unsigned* st; };
__device__ __forceinline__ XcdBarrier xcd_barrier_post(unsigned* bar, volatile LAS unsigned* st, bool leader) {
    XcdBarrier b; b.bar = bar; b.x = xb_xcc_id(); b.st = st;
    if (leader) (void)xb_add(&bar[XB_XCNT(b.x)], 1u);
    return b;
}
__device__ __forceinline__ void xcd_barrier_complete(unsigned* bar, unsigned x, unsigned& nloc, unsigned& nx) {
    const unsigned G = gridDim.x * gridDim.y * gridDim.z;
    unsigned sum, cnt, mine, sp = 0u;
    for (;;) {
        sum = 0u; cnt = 0u; mine = 0u;
#pragma unroll
        for (unsigned j = 0; j < 16; ++j) { const unsigned c = xb_ld(&bar[XB_XCNT(j)]); sum += c; cnt += (c > 0u) ? 1u : 0u; mine = (j == x) ? c : mine; }
        if (sum == G) break;
        __builtin_amdgcn_s_sleep(1);
        if ((++sp & 255u) == 0u) { if (xb_ld(&bar[XB_TMO])) break; if (sp > XB_SPIN_CAP) { atomicAdd(&bar[XB_TMO], 1u); break; } }
    }
    nloc = mine > 0u ? mine : 1u; nx = cnt > 0u ? cnt : 1u;
}
__device__ __forceinline__ void xcd_barrier(const XcdBarrier& b, bool leader) {
    asm volatile("s_waitcnt vmcnt(0)" ::: "memory");
    __syncthreads();
    if (leader) {
        unsigned* bar = b.bar;
        __builtin_amdgcn_s_waitcnt(0);
        unsigned nloc = b.st[0], nx = b.st[1];
        if (nloc == 0u) { xcd_barrier_complete(bar, b.x, nloc, nx); b.st[0] = nloc; b.st[1] = nx; }
        const unsigned old = xb_add(&bar[XB_XSUB(b.x)], 1u);
        const unsigned gen = old / nloc;
        if (old + 1u == (gen + 1u) * nloc) {
            __builtin_amdgcn_fence(__ATOMIC_RELEASE, "agent");
            asm volatile("s_waitcnt vmcnt(0)" ::: "memory");
            const unsigned og = xb_add(&bar[XB_TOP], 1u);
            const unsigned tg = og / nx;
            if (og + 1u == (tg + 1u) * nx) xb_add(&bar[XB_TOPGEN], 1u);
            else XB_SPIN(xb_ld(&bar[XB_TOPGEN]) == tg, bar);
            __builtin_amdgcn_fence(__ATOMIC_ACQUIRE, "agent");
            xb_add(&bar[XB_XGEN(b.x)], 1u);
            asm volatile("s_waitcnt vmcnt(0)" ::: "memory");
        } else {
            XB_SPIN(xb_ld(&bar[XB_XGEN(b.x)]) == gen, bar);
            __builtin_amdgcn_fence(__ATOMIC_ACQUIRE, "agent");
            asm volatile("s_waitcnt vmcnt(0)" ::: "memory");
        }
    }
    __syncthreads();
}

__device__ __forceinline__ float shfl_xor_l(float v, int mask, int lane) { return __int_as_float(__builtin_amdgcn_ds_bpermute((lane ^ mask) << 2, __float_as_int(v))); }
__device__ __forceinline__ float wave_sum(float v, int lane) {
#pragma unroll
    for (int o = 1; o < 64; o <<= 1) v += shfl_xor_l(v, o, lane);
    return v;
}
__device__ __forceinline__ unsigned f2bf(float f) { unsigned u = __builtin_bit_cast(unsigned, f); return (u + 0x7fffu + ((u >> 16) & 1u)) >> 16; }
__device__ __forceinline__ unsigned pk2(float lo, float hi) { return f2bf(lo) | (f2bf(hi) << 16); }

struct TItem { const float* W; int N; bf16_t* WT; int ldwt, koff; const float* gain; unsigned char* W8; int n8, item; };
__device__ __forceinline__ void titem_load(const TItem& t, float (&v)[32], int lane) {
    const int nblk = t.N / 32, kb = t.item / nblk, nb = t.item % nblk, k0 = 64 * kb, n0 = 32 * nb;
    const GAS float* wp = (const GAS float*)t.W + (size_t)(k0 + (lane >> 5)) * t.N + n0 + (lane & 31);
#pragma unroll
    for (int i = 0; i < 32; ++i) v[i] = wp[(size_t)(2 * i) * t.N];
}
__device__ __forceinline__ void titem_finish(const TItem& t, float (&v)[32], LAS float* scr, int lane) {
    const int N = t.N, item = t.item; const float* gain = t.gain; bf16_t* WT = t.WT; const int ldwt = t.ldwt, koff = t.koff; unsigned char* W8 = t.W8; const int n8 = t.n8;
    const int nblk = N / 32, kb = item / nblk, nb = item % nblk, k0 = 64 * kb, n0 = 32 * nb;
    if (gain) {
#pragma unroll
        for (int i = 0; i < 32; ++i) v[i] *= ((const GAS float*)gain)[k0 + 2 * i + (lane >> 5)]; }
#pragma unroll
    for (int i = 0; i < 32; ++i) scr[(2 * i + (lane >> 5)) * 33 + (lane & 31)] = v[i];
    asm volatile("s_waitcnt lgkmcnt(0)" ::: "memory");
    const int c = lane & 7;
    if (W8 && n0 >= n8) {
#pragma unroll
        for (int j = 0; j < 4; ++j) { const int n = (lane >> 3) + 8 * j; const LAS float* s = scr + (8 * c) * 33 + n;
            u32x2 o; o.x = pk4_fp8(s[0 * 33] * W8_SCALE, s[1 * 33] * W8_SCALE, s[2 * 33] * W8_SCALE, s[3 * 33] * W8_SCALE); o.y = pk4_fp8(s[4 * 33] * W8_SCALE, s[5 * 33] * W8_SCALE, s[6 * 33] * W8_SCALE, s[7 * 33] * W8_SCALE);
            *(GAS u32x2*)(W8 + (size_t)(n0 - n8 + n) * DM + k0 + 8 * c) = o; }
    } else {
#pragma unroll
    for (int j = 0; j < 4; ++j) { const int n = (lane >> 3) + 8 * j; const LAS float* s = scr + (8 * c) * 33 + n;
        u32x4 o; o.x = pk2(s[0 * 33], s[1 * 33]); o.y = pk2(s[2 * 33], s[3 * 33]); o.z = pk2(s[4 * 33], s[5 * 33]); o.w = pk2(s[6 * 33], s[7 * 33]);
        *(GAS u32x4*)(WT + (size_t)(n0 + n) * ldwt + koff + k0 + 8 * c) = o; }
    }
    asm volatile("s_waitcnt lgkmcnt(0)" ::: "memory");
}
__device__ __forceinline__ void rms_row_to_bf16(const float* xrow, const float* gain, bf16_t* orow, int lane, unsigned char* o8row = nullptr) {
    const GAS f32x4* xr = (const GAS f32x4*)xrow + lane;
    f32x4 v[16]; float s = 0.f;
#pragma unroll
    for (int j = 0; j < 16; ++j) v[j] = xr[64 * j];
    f32x4 gv[16];
#pragma unroll
    for (int j = 0; j < 16; ++j) gv[j] = gain ? ((const GAS f32x4*)gain)[lane + 64 * j] : (f32x4){1.f, 1.f, 1.f, 1.f};
#pragma unroll
    for (int j = 0; j < 16; ++j) s += (v[j].x * v[j].x + v[j].y * v[j].y) + (v[j].z * v[j].z + v[j].w * v[j].w);
    const float r = 1.0f / sqrtf(wave_sum(s, lane) * (1.0f / DM) + RMS_EPS);
    GAS u32x2* o8 = (GAS u32x2*)orow + lane;
#pragma unroll
    for (int j = 0; j < 16; ++j) { const f32x4 g = gv[j];
        const float y0 = v[j].x * r * g.x, y1 = v[j].y * r * g.y, y2 = v[j].z * r * g.z, y3 = v[j].w * r * g.w;
        u32x2 w; w.x = cvt_pk_bf16(y0, y1); w.y = cvt_pk_bf16(y2, y3); o8[64 * j] = w;
        if (o8row) ((GAS unsigned*)o8row)[lane + 64 * j] = pk4_fp8(y0 * H8_SCALE, y1 * H8_SCALE, y2 * H8_SCALE, y3 * H8_SCALE); }
}

__device__ __forceinline__ int t5_bucket(int rel) {
    const int n = rel < 0 ? -rel : rel;
    const int b = n < 8 ? n : 8 + (n >= 12) + (n >= 16) + (n >= 23) + (n >= 32) + (n >= 46) + (n >= 64) + (n >= 91);
    return b + (rel > 0 ? 16 : 0);
}

struct Args { const float* in[16]; float* out; unsigned char* ws; int ph_lo, ph_hi, probe_phase, probe_reps; };
struct Frame {
    LAS unsigned char* lds;
    int tid, lane, wave, vcu, G;
    const float *xp, *xs, *memp, *mems, *pre_norm, *post_norm, *mem_norm, *w_in, *w_kv, *w_a, *w_b, *w_m, *w_out, *rpb, *sink, *t5;
    float* out;
    bf16_t *WinT, *WkvT, *WcatT, *WoutT, *H, *X, *P, *MEMH, *KVM; float* RSQ; unsigned char *H8, *W8, *ws;
};
__device__ __forceinline__ void make_frame(Frame& F, LAS unsigned char* lds, int wave_s) {
    const Args* ka = (const Args*)__builtin_amdgcn_kernarg_segment_ptr(); asm volatile("" : "+s"(ka));
    const int lane = lane_id_hw();
    F.lds = lds; F.lane = lane; F.wave = wave_s; F.tid = wave_s * 64 + lane;
    F.G = gridDim.x; { const int bx = blockIdx.x; F.vcu = (F.G % 8 == 0) ? (bx % 8) * (F.G / 8) + bx / 8 : bx; }
    F.xp = ka->in[0]; F.xs = ka->in[1]; F.memp = ka->in[2]; F.mems = ka->in[3]; F.pre_norm = ka->in[4]; F.post_norm = ka->in[5]; F.mem_norm = ka->in[6];
    F.w_in = ka->in[7]; F.w_kv = ka->in[8]; F.w_a = ka->in[9]; F.w_b = ka->in[10]; F.w_m = ka->in[11]; F.w_out = ka->in[12]; F.rpb = ka->in[13]; F.sink = ka->in[14]; F.t5 = ka->in[15];
    F.out = ka->out; unsigned char* ws = ka->ws; F.ws = ws;
    F.WinT = (bf16_t*)(ws + WS_WIN); F.WkvT = (bf16_t*)(ws + WS_WKV); F.WcatT = (bf16_t*)(ws + WS_WCAT); F.WoutT = (bf16_t*)(ws + WS_WOUT);
    F.H = (bf16_t*)(ws + WS_H); F.X = (bf16_t*)(ws + WS_X); F.P = (bf16_t*)(ws + WS_P); F.MEMH = (bf16_t*)(ws + WS_MEMH); F.KVM = (bf16_t*)(ws + WS_KVM); F.RSQ = (float*)(ws + WS_RSQ); F.H8 = ws + WS_H8; F.W8 = ws + WS_W8;
}

__device__ __forceinline__ void naive_attention(Frame& F, int l) {
    const int gw = F.vcu * NWAVES + F.wave, NGW = F.G * NWAVES, lane = F.lane;
    const bf16_t* P = F.P; bf16_t* X = F.X;
    if (!FLASH_NA) for (int it = gw; it < NSEQ * 12 * SEQ; it += NGW) {
        const int p = it % SEQ, h = (it / SEQ) % 12, b = it / (SEQ * 12);
        const int r = p >> 6, c = p & 63; int rs = r - 4; rs = rs < 0 ? 0 : (rs > 24 ? 24 : rs); int cs = c - 8; cs = cs < 0 ? 0 : (cs > 48 ? 48 : cs);
        const size_t row = (size_t)b * SEQ + p;
        const unsigned qw = *(const unsigned*)(P + row * INW + QA + h * 128 + 2 * lane); const float q0 = bf_lo(qw), q1 = bf_hi(qw);
        const float* rp = F.rpb + (size_t)(l * 12 + h) * 15 * 31;
        float m = -1e30f, ls = 0.f, o0 = 0.f, o1 = 0.f;
        for (int kr = rs; kr < rs + 8; ++kr)
#pragma unroll 4
          for (int kc = cs; kc < cs + 16; ++kc) {
            const size_t krow = (size_t)b * SEQ + kr * 64 + kc;
            const unsigned kw = *(const unsigned*)(P + krow * INW + KA + h * 128 + 2 * lane), vw = *(const unsigned*)(P + krow * INW + VA + h * 128 + 2 * lane);
            const float s = wave_sum(q0 * bf_lo(kw) + q1 * bf_hi(kw), lane) * 0.08838834764831845f + rp[(kr - r + 7) * 31 + (kc - c + 15)];
            const float mn = fmaxf(m, s), a = __expf(m - mn), pe = __expf(s - mn);
            ls = ls * a + pe; o0 = o0 * a + pe * bf_lo(vw); o1 = o1 * a + pe * bf_hi(vw); m = mn;
        }
        const unsigned zw = *(const unsigned*)(P + row * INW + ZA + h * 128 + 2 * lane); const float inv = 1.0f / ls;
        *(unsigned*)(X + row * DM + h * 128 + 2 * lane) = cvt_pk_bf16(o0 * inv * bf_lo(zw), o1 * inv * bf_hi(zw));
    }
    if (!FLASH_SW) for (int it = gw; it < NSEQ * 12 * SEQ; it += NGW) {
        const int p = it % SEQ, h = (it / SEQ) % 12, b = it / (SEQ * 12), kvh = h / 3;
        const size_t row = (size_t)b * SEQ + p;
        const unsigned qw = *(const unsigned*)(P + row * INW + QB + h * 128 + 2 * lane); const float q0 = bf_lo(qw), q1 = bf_hi(qw);
        float m = F.sink[l * 12 + h], ls = 1.f, o0 = 0.f, o1 = 0.f;
        const int j0 = p - 128 < 0 ? 0 : p - 128, j1 = p + 128 > SEQ - 1 ? SEQ - 1 : p + 128;
#pragma unroll 4
        for (int j = j0; j <= j1; ++j) {
            const size_t krow = (size_t)b * SEQ + j;
            const unsigned kw = *(const unsigned*)(P + krow * INW + KB + kvh * 128 + 2 * lane), vw = *(const unsigned*)(P + krow * INW + VB + kvh * 128 + 2 * lane);
            const float s = wave_sum(q0 * bf_lo(kw) + q1 * bf_hi(kw), lane) * 0.08838834764831845f + F.t5[t5_bucket(j - p) * 12 + h];
            const float mn = fmaxf(m, s), a = __expf(m - mn), pe = __expf(s - mn);
            ls = ls * a + pe; o0 = o0 * a + pe * bf_lo(vw); o1 = o1 * a + pe * bf_hi(vw); m = mn;
        }
        const unsigned zw = *(const unsigned*)(P + row * INW + ZB + h * 128 + 2 * lane); const float inv = 1.0f / ls;
        *(unsigned*)(X + row * DM + 1536 + h * 128 + 2 * lane) = cvt_pk_bf16(o0 * inv * bf_lo(zw), o1 * inv * bf_hi(zw));
    }
    const bf16_t* KV = F.KVM + (size_t)l * MROWS * KVW;
    if (!FLASH_MEM) for (int it = gw; it < NSEQ * 4 * SEQ; it += NGW) {
        const int p = it % SEQ, h = (it / SEQ) % 4, b = it / (SEQ * 4);
        const size_t row = (size_t)b * SEQ + p;
        const u32x2 qw = *(const u32x2*)(P + row * INW + QM + h * 256 + 4 * lane); const float q0 = bf_lo(qw.x), q1 = bf_hi(qw.x), q2 = bf_lo(qw.y), q3 = bf_hi(qw.y);
        float m = -1e30f, ls = 0.f, o0 = 0.f, o1 = 0.f, o2 = 0.f, o3 = 0.f;
#pragma unroll 4
        for (int j = 0; j < MEMT; ++j) {
            const size_t krow = (size_t)b * MEMT + j;
            const u32x2 kw = *(const u32x2*)(KV + krow * KVW + h * 256 + 4 * lane), vw = *(const u32x2*)(KV + krow * KVW + 1024 + h * 256 + 4 * lane);
            const float s = wave_sum((q0 * bf_lo(kw.x) + q1 * bf_hi(kw.x)) + (q2 * bf_lo(kw.y) + q3 * bf_hi(kw.y)), lane) * 0.0625f;
            const float mn = fmaxf(m, s), a = __expf(m - mn), pe = __expf(s - mn);
            ls = ls * a + pe; o0 = o0 * a + pe * bf_lo(vw.x); o1 = o1 * a + pe * bf_hi(vw.x); o2 = o2 * a + pe * bf_lo(vw.y); o3 = o3 * a + pe * bf_hi(vw.y); m = mn;
        }
        const u32x2 zw = *(const u32x2*)(P + row * INW + ZM + h * 256 + 4 * lane); const float inv = 1.0f / ls;
        u32x2 w; w.x = cvt_pk_bf16(o0 * inv * bf_lo(zw.x), o1 * inv * bf_hi(zw.x)); w.y = cvt_pk_bf16(o2 * inv * bf_lo(zw.y), o3 * inv * bf_hi(zw.y));
        *(u32x2*)(X + row * DM + 3072 + h * 256 + 4 * lane) = w;
    }
}


namespace fa {
typedef float f32x16 __attribute__((ext_vector_type(16)));
typedef short s16x4 __attribute__((ext_vector_type(4)));
constexpr int SHM_V = 16384, SHM_K = 16384;
constexpr int OFF_V = 0, OFF_K = 32768, OFF_OST = 65536  , OFF_WS = RING_BYTES + 2048, OFF_TBL = RING_BYTES + 4096, TBL_PAD = 256;
constexpr int OFF_WS_MEM = RING_BYTES + 1024, OFF_OST_MEM = RING_BYTES + 16384;
constexpr float THR2 = 11.5f;
constexpr float NEG = -1e30f;
#define FA_KSWZ(row, colB) ((row) * 256 + ((colB) ^ (((row) & 7) << 4)))
#define FA_SBAR() __builtin_amdgcn_sched_barrier(0)
__device__ __forceinline__ int crow(int r, int hi) { return (r & 3) + 8 * (r >> 2) + 4 * hi; }
__device__ __forceinline__ int v_st(int k, int c) { const int kk = (k & ~0xC) | ((k & 4) << 1) | ((k & 8) >> 1); return ((kk >> 3) * 4 + (c >> 5)) * 512 + ((kk & 7) * 32 + (c & 31)) * 2; }
__device__ __forceinline__ int v_rd_base(int lane) { return ((lane & 3) << 3) | (((lane >> 2) & 3) << 6) | (((lane >> 4) & 1) << 5) | (((lane >> 5) & 1) << 8); }
constexpr int v_rd_off(int d0, int ks, int half) { return d0 * 512 + ks * 4096 + half * 2048; }
template <int OFF> __device__ __forceinline__ s16x4 tr_read(int vb) { s16x4 r; asm volatile("ds_read_b64_tr_b16 %0, %1 offset:%2" : "=&v"(r) : "v"(vb), "i"(OFF) : "memory"); return r; }
template <int D0> __device__ __forceinline__ void pv_one(f32x16& od, int vb, bf16x8 pa0, bf16x8 pa1, bf16x8 pa2, bf16x8 pa3) {
    const s16x4 l0 = tr_read<v_rd_off(D0, 0, 0)>(vb), h0 = tr_read<v_rd_off(D0, 0, 1)>(vb), l1 = tr_read<v_rd_off(D0, 1, 0)>(vb), h1 = tr_read<v_rd_off(D0, 1, 1)>(vb);
    const s16x4 l2 = tr_read<v_rd_off(D0, 2, 0)>(vb), h2 = tr_read<v_rd_off(D0, 2, 1)>(vb), l3 = tr_read<v_rd_off(D0, 3, 0)>(vb), h3 = tr_read<v_rd_off(D0, 3, 1)>(vb);
    asm volatile("s_waitcnt lgkmcnt(0)" ::: "memory"); FA_SBAR();
#define FA_PK(L, H) (bf16x8){L[0], L[1], L[2], L[3], H[0], H[1], H[2], H[3]}
    od = __builtin_amdgcn_mfma_f32_32x32x16_bf16(pa0, FA_PK(l0, h0), od, 0, 0, 0);
    od = __builtin_amdgcn_mfma_f32_32x32x16_bf16(pa1, FA_PK(l1, h1), od, 0, 0, 0);
    od = __builtin_amdgcn_mfma_f32_32x32x16_bf16(pa2, FA_PK(l2, h2), od, 0, 0, 0);
    od = __builtin_amdgcn_mfma_f32_32x32x16_bf16(pa3, FA_PK(l3, h3), od, 0, 0, 0);
#undef FA_PK
}
__device__ __forceinline__ void pv_d0(f32x16* o, int vb, bf16x8 pa0, bf16x8 pa1, bf16x8 pa2, bf16x8 pa3) {
    pv_one<0>(o[0], vb, pa0, pa1, pa2, pa3); pv_one<1>(o[1], vb, pa0, pa1, pa2, pa3); pv_one<2>(o[2], vb, pa0, pa1, pa2, pa3); pv_one<3>(o[3], vb, pa0, pa1, pa2, pa3);
}
template <int P1T> __device__ __forceinline__ void qkt(f32x16& p0, f32x16& p1, const LAS unsigned char* Ks, const bf16x8* qr, int r32, int hi, const LAS float* tb) {
#pragma unroll
    for (int r = 0; r < 16; ++r) { const int k0 = (r & 3) + 8 * (r >> 2); p0[r] = tb[k0]; p1[r] = tb[P1T + k0]; }
#ifndef FA_KBATCH
#define FA_KBATCH 2
#endif
#pragma unroll
    for (int g = 0; g < 8 / FA_KBATCH; ++g) { bf16x8 kf0[FA_KBATCH], kf1[FA_KBATCH];
#pragma unroll
        for (int d = 0; d < FA_KBATCH; ++d) { const int cb = ((g * FA_KBATCH + d) * 16 + hi * 8) * 2; kf0[d] = *(const LAS bf16x8*)(Ks + FA_KSWZ(r32, cb)); kf1[d] = *(const LAS bf16x8*)(Ks + FA_KSWZ(32 + r32, cb)); }
        FA_SBAR();
#pragma unroll
        for (int d = 0; d < FA_KBATCH; ++d) { p0 = __builtin_amdgcn_mfma_f32_32x32x16_bf16(kf0[d], qr[g * FA_KBATCH + d], p0, 0, 0, 0); p1 = __builtin_amdgcn_mfma_f32_32x32x16_bf16(kf1[d], qr[g * FA_KBATCH + d], p1, 0, 0, 0); }
        FA_SBAR(); }
}
template <int P1V> __device__ __forceinline__ void apply_bias(f32x16& p0, f32x16& p1, int vb, unsigned vl0, unsigned vl1, float C) {
#pragma unroll
    for (int r = 0; r < 16; ++r) { const int k0 = (r & 3) + 8 * (r >> 2);
        const float x0 = p0[r] * C, x1 = p1[r] * C;
        p0[r] = ((unsigned)(vb + k0) < vl0) ? x0 : NEG; p1[r] = ((unsigned)(vb + P1V + k0) < vl1) ? x1 : NEG; }
}
__device__ __forceinline__ void partialSM(f32x16& p0, f32x16& p1, float& m_reg, float& alpha) {
    float pmax = p0[0];
#pragma unroll
    for (int r = 1; r < 16; ++r) pmax = fmaxf(pmax, p0[r]);
#pragma unroll
    for (int r = 0; r < 16; ++r) pmax = fmaxf(pmax, p1[r]);
    { auto rr = __builtin_amdgcn_permlane32_swap(__float_as_uint(pmax), __float_as_uint(pmax), false, false); pmax = fmaxf(__uint_as_float(rr[0]), __uint_as_float(rr[1])); }
    if (__builtin_expect(__all(pmax - m_reg <= THR2), 1)) { alpha = 1.f; }
    else { const float mn = fmaxf(m_reg, pmax); alpha = __builtin_amdgcn_exp2f(m_reg - mn); m_reg = mn; }
#pragma unroll
    for (int r = 0; r < 16; ++r) { p0[r] = __builtin_amdgcn_exp2f(p0[r] - m_reg); p1[r] = p1[r] - m_reg; }
}
#define FA_PK4(P, BASE, OUT) do { const unsigned a0 = cvt_pk_bf16(P[BASE + 0], P[BASE + 1]), a1 = cvt_pk_bf16(P[BASE + 2], P[BASE + 3]);   \
    const unsigned b0 = cvt_pk_bf16(P[BASE + 4], P[BASE + 5]), b1 = cvt_pk_bf16(P[BASE + 6], P[BASE + 7]);                              \
    auto r0 = __builtin_amdgcn_permlane32_swap(a0, b0, false, false); auto r1 = __builtin_amdgcn_permlane32_swap(a1, b1, false, false); \
    u32x4 w = {r0[0], r1[0], r0[1], r1[1]}; OUT = __builtin_bit_cast(bf16x8, w); } while (0)
__device__ __forceinline__ void finishSM(f32x16& p0, f32x16& p1, float alpha, float& l_reg, bf16x8& pa0, bf16x8& pa1, bf16x8& pa2, bf16x8& pa3) {
#pragma unroll
    for (int r = 0; r < 16; ++r) p1[r] = __builtin_amdgcn_exp2f(p1[r]);
    float ps = 0.f;
#pragma unroll
    for (int r = 0; r < 16; ++r) ps += p0[r];
#pragma unroll
    for (int r = 0; r < 16; ++r) ps += p1[r];
    { auto rr = __builtin_amdgcn_permlane32_swap(__float_as_uint(ps), __float_as_uint(ps), false, false); ps = __uint_as_float(rr[0]) + __uint_as_float(rr[1]); }
    l_reg = l_reg * alpha + ps;
    FA_PK4(p0, 0, pa0); FA_PK4(p0, 8, pa1); FA_PK4(p1, 0, pa2); FA_PK4(p1, 8, pa3);
}

struct FlashUnit {
    const bf16_t *Q, *K, *V, *Z; bf16_t* O;
    int NT, jlo, jhi;
    int tblo;
    float tv; int tcnt;
    int rsl;
    int lane_off, jstride, vbase, vstride; unsigned vlim;
    float m_init, l_init, C;
};
template <bool NA2>
__device__ __forceinline__ void flash_unit(LAS unsigned char* lds, const FlashUnit& U, int tid) {
    const int wid = __builtin_amdgcn_readfirstlane(tid >> 6), lane = tid & 63, r32 = lane & 31, hi = lane >> 5;
    constexpr int EHI = NA2 ? 64 : 16, KROW1 = NA2 ? 64 : 32, KTILE = NA2 ? 128 : 64, P1T = NA2 ? 31 : 32, P1V = NA2 ? 0 : 32;
    constexpr int KP = GATES_FP8 ? 128 : INW;
    const int ebase = NA2 ? wid * 128 : wid * 32;
    LAS unsigned char* V_lds = lds + OFF_V; LAS unsigned char* K_lds = lds + OFF_K;
    LAS float* wsx = (LAS float*)(lds + OFF_WS) + wid * 64; LAS float* li_l = wsx; LAS float* al_l = wsx + 32;
    const LAS float* tbl = (const LAS float*)(lds + U.tblo) + TBL_PAD + U.lane_off;
    float m_reg = U.m_init, l_reg = U.l_init; f32x16 o[4] = {}; bf16x8 qr[8];
    { const GAS char* Qw = (const GAS char*)U.Q; const unsigned qo = (unsigned)((ebase + (r32 & 15) + (r32 >> 4) * EHI) * INW + hi * 8) * 2u;
#pragma unroll
      for (int d0 = 0; d0 < 8; ++d0) qr[d0] = *(const GAS bf16x8*)(Qw + qo + d0 * 32); }
    const int sr = tid >> 4, sc = (tid & 15) * 8, vst0 = v_st(sr, sc), vst1 = v_st(32 + sr, sc), kst0 = FA_KSWZ(sr, sc * 2), kst1 = FA_KSWZ(32 + sr, sc * 2);
    const int vb0 = (int)(unsigned)(size_t)V_lds + v_rd_base(lane);
    const unsigned go0 = (unsigned)(sr * KP + sc) * 2u, go1 = (unsigned)((KROW1 + sr) * KP + sc) * 2u;
    constexpr size_t TILE_B = (size_t)KTILE * KP * 2;
    bf16x8 sv0[2], sv1[2], sk0[2], sk1[2];
#define FA_SLOAD(i, j) do { const GAS char* kt = (const GAS char*)U.K + (size_t)(j) * TILE_B; const GAS char* vt = (const GAS char*)U.V + (size_t)(j) * TILE_B; \
    sv0[i] = *(const GAS bf16x8*)(vt + go0); sv1[i] = *(const GAS bf16x8*)(vt + go1); sk0[i] = *(const GAS bf16x8*)(kt + go0); sk1[i] = *(const GAS bf16x8*)(kt + go1); } while (0)
#define FA_SWRITE(b, i) do { *(LAS bf16x8*)(V_lds + (b) * SHM_V + vst0) = sv0[i]; *(LAS bf16x8*)(V_lds + (b) * SHM_V + vst1) = sv1[i]; \
    *(LAS bf16x8*)(K_lds + (b) * SHM_K + kst0) = sk0[i]; *(LAS bf16x8*)(K_lds + (b) * SHM_K + kst1) = sk1[i]; } while (0)
    const int NT = U.NT;
    FA_SLOAD(0, 0); if (1 < NT) FA_SLOAD(1, 1);
    __builtin_amdgcn_sched_barrier(0);
    if (tid < U.tcnt) ((LAS float*)(lds + U.tblo))[TBL_PAD + tid] = U.tv * 11.313708498984761f;
#define FA_TILE(j, BUF) do { \
    FA_SWRITE(BUF, BUF); __syncthreads(); \
    if ((j) + 2 < NT) FA_SLOAD(BUF, (j) + 2); \
    if ((j) >= U.jlo && (j) < U.jhi) { f32x16 p0, p1; float alpha; bf16x8 pa0, pa1, pa2, pa3; \
        qkt<P1T>(p0, p1, K_lds + (BUF) * SHM_K, qr, r32, hi, tbl + (j) * U.jstride); \
        unsigned vl0 = U.vlim, vl1 = U.vlim; if constexpr (NA2) { vl0 = ((unsigned)(2 * (j) - U.rsl) < 8u) ? 16u : 0u; vl1 = ((unsigned)(2 * (j) + 1 - U.rsl) < 8u) ? 16u : 0u; } \
        apply_bias<P1V>(p0, p1, U.vbase + (j) * U.vstride, vl0, vl1, U.C); \
        partialSM(p0, p1, m_reg, alpha); finishSM(p0, p1, alpha, l_reg, pa0, pa1, pa2, pa3); \
        if (__any(alpha < 1.f)) { if (hi == 0) al_l[r32] = alpha; asm volatile("s_waitcnt lgkmcnt(0)" ::: "memory"); \
            _Pragma("unroll") for (int d = 0; d < 4; ++d) _Pragma("unroll") for (int r = 0; r < 16; ++r) o[d][r] *= al_l[crow(r, hi)]; } \
        pv_d0(o, vb0 + (BUF) * SHM_V, pa0, pa1, pa2, pa3); } } while (0)
    int j = 0;
    for (; j + 1 < NT; j += 2) { FA_TILE(j, 0); FA_TILE(j + 1, 1); }
    if (j < NT) FA_TILE(j, 0);
    { const GAS bf16_t* zb = (const GAS bf16_t*)U.Z + (size_t)ebase * INW; GAS bf16_t* ob = (GAS bf16_t*)U.O + (size_t)ebase * DM;
      int ln2 = lane; asm volatile("" : "+v"(ln2));
      u32x4 zv[8];
#pragma unroll
      for (int k = 0; k < 8; ++k) { const int ch = ln2 + 64 * k, row = ch >> 4, c16 = ch & 15, grow = (row & 15) + (row >> 4) * EHI; zv[k] = *(const GAS u32x4*)(zb + (size_t)grow * INW + c16 * 8); }
      if (hi == 0) li_l[r32] = l_reg; asm volatile("s_waitcnt lgkmcnt(0)" ::: "memory");
      LAS unsigned char* stg = lds + OFF_OST + wid * 8192;
#pragma unroll
      for (int r = 0; r < 16; ++r) { const int lr = crow(r, hi); const float rl = __builtin_amdgcn_rcpf(li_l[lr]);
#pragma unroll
          for (int d0 = 0; d0 < 4; ++d0) *(LAS bf16_t*)(stg + lr * 256 + (d0 * 32 + r32) * 2) = (bf16_t)f2bf(o[d0][r] * rl); }
      asm volatile("s_waitcnt lgkmcnt(0)" ::: "memory"); __builtin_amdgcn_sched_barrier(0);
#pragma unroll
      for (int k = 0; k < 8; ++k) { const int ch = ln2 + 64 * k, row = ch >> 4, c16 = ch & 15, grow = (row & 15) + (row >> 4) * EHI; const u32x4 ov = *(const LAS u32x4*)(stg + row * 256 + c16 * 16); const u32x4 z = zv[k];
          u32x4 w; w.x = cvt_pk_bf16(bf_lo(ov.x) * bf_lo(z.x), bf_hi(ov.x) * bf_hi(z.x)); w.y = cvt_pk_bf16(bf_lo(ov.y) * bf_lo(z.y), bf_hi(ov.y) * bf_hi(z.y));
          w.z = cvt_pk_bf16(bf_lo(ov.z) * bf_lo(z.z), bf_hi(ov.z) * bf_hi(z.z)); w.w = cvt_pk_bf16(bf_lo(ov.w) * bf_lo(z.w), bf_hi(ov.w) * bf_hi(z.w));
          *(GAS u32x4*)(ob + (size_t)grow * DM + c16 * 8) = w; } }
#undef FA_SLOAD
#undef FA_SWRITE
#undef FA_TILE
}

__device__ __forceinline__ void mem_unit(LAS unsigned char* lds, const bf16_t* Qb, const bf16_t* KVg, const bf16_t* Zb, bf16_t* Ob, int tid) {
    const int wid = __builtin_amdgcn_readfirstlane(tid >> 6), lane = tid & 63, r32 = lane & 31, hi = lane >> 5;
    bf16x8 kv[16];
#pragma unroll
    for (int i = 0; i < 16; ++i) { const int ch = i * 512 + tid, key = ch >> 5, c16 = ch & 31; kv[i] = *(const GAS bf16x8*)((const GAS bf16_t*)KVg + (size_t)key * KVW + c16 * 8); }
    __syncthreads();
#pragma unroll
    for (int i = 0; i < 16; ++i) { const int ch = i * 512 + tid, key = ch >> 5, c16 = ch & 31; *(LAS bf16x8*)(lds + key * 512 + ((c16 * 16) ^ ((key & 7) << 4))) = kv[i]; }
    __syncthreads();
    f32x16 p[8];
#pragma unroll
    for (int kb = 0; kb < 8; ++kb) p[kb] = (f32x16){};
    const GAS bf16_t* Qw = (const GAS bf16_t*)Qb + (size_t)(wid * 32 + r32) * INW + hi * 8;
#pragma unroll
    for (int d0 = 0; d0 < 16; ++d0) { const bf16x8 qf = *(const GAS bf16x8*)(Qw + d0 * 16); const int cb = (d0 * 32 + hi * 16) ^ ((r32 & 7) << 4);
#pragma unroll
        for (int kb = 0; kb < 8; ++kb) { const bf16x8 kf = *(const LAS bf16x8*)(lds + (kb * 32 + r32) * 512 + cb); p[kb] = __builtin_amdgcn_mfma_f32_32x32x16_bf16(kf, qf, p[kb], 0, 0, 0); } }
#pragma unroll
    for (int i = 0; i < 16; ++i) { const int ch = i * 512 + tid, key = ch >> 5, c16 = ch & 31; kv[i] = *(const GAS bf16x8*)((const GAS bf16_t*)KVg + (size_t)key * KVW + 1024 + c16 * 8); }
    constexpr float C2 = 0.0625f * LOG2E;
    float mx = p[0][0];
#pragma unroll
    for (int kb = 0; kb < 8; ++kb)
#pragma unroll
        for (int r = 0; r < 16; ++r) mx = fmaxf(mx, p[kb][r]);
    { auto rr = __builtin_amdgcn_permlane32_swap(__float_as_uint(mx), __float_as_uint(mx), false, false); mx = fmaxf(__uint_as_float(rr[0]), __uint_as_float(rr[1])); }
    const float mc = -mx * C2; float ls = 0.f;
#pragma unroll
    for (int kb = 0; kb < 8; ++kb)
#pragma unroll
        for (int r = 0; r < 16; ++r) { const float e = __builtin_amdgcn_exp2f(fmaf(p[kb][r], C2, mc)); p[kb][r] = e; ls += e; }
    { auto rr = __builtin_amdgcn_permlane32_swap(__float_as_uint(ls), __float_as_uint(ls), false, false); ls = __uint_as_float(rr[0]) + __uint_as_float(rr[1]); }
    bf16x8 pa[4][4];
#pragma unroll
    for (int g = 0; g < 4; ++g) { FA_PK4(p[2 * g], 0, pa[g][0]); FA_PK4(p[2 * g], 8, pa[g][1]); FA_PK4(p[2 * g + 1], 0, pa[g][2]); FA_PK4(p[2 * g + 1], 8, pa[g][3]); }
    __syncthreads();
#pragma unroll
    for (int i = 0; i < 16; ++i) { const int ch = i * 512 + tid, key = ch >> 5, c16 = ch & 31, d = c16 * 8;
        *(LAS bf16x8*)(lds + ((key >> 6) * 2 + (d >> 7)) * 16384 + v_st(key & 63, d & 127)) = kv[i]; }
    __syncthreads();
    const int vb0 = (int)(unsigned)(size_t)lds + v_rd_base(lane);
    LAS float* li_l = (LAS float*)(lds + OFF_WS_MEM) + wid * 32;
    if (hi == 0) li_l[r32] = ls; asm volatile("s_waitcnt lgkmcnt(0)" ::: "memory");
    LAS unsigned char* stg = lds + OFF_OST_MEM + wid * 2048;
#pragma unroll
    for (int dh = 0; dh < 2; ++dh) {
        int ln2 = lane; asm volatile("" : "+v"(ln2));
        const GAS bf16_t* zb = (const GAS bf16_t*)Zb + (size_t)(wid * 32) * INW + dh * 128; GAS bf16_t* ob = (GAS bf16_t*)Ob + (size_t)(wid * 32) * DM + dh * 128;
        u32x4 zv[8];
#pragma unroll
        for (int k = 0; k < 8; ++k) { const int ch = ln2 + 64 * k, row = ch >> 4, c16 = ch & 15; zv[k] = *(const GAS u32x4*)(zb + (size_t)row * INW + c16 * 8); }
        f32x16 o[4] = {};
#pragma unroll
        for (int g = 0; g < 4; ++g) pv_d0(o, vb0 + (g * 2 + dh) * 16384, pa[g][0], pa[g][1], pa[g][2], pa[g][3]);
#pragma unroll
        for (int p = 0; p < 4; ++p) {
#pragma unroll
            for (int q = 0; q < 4; ++q) { const int r = 4 * p + q, lr8 = q + 4 * hi; const float rl = __builtin_amdgcn_rcpf(li_l[8 * p + lr8]);
#pragma unroll
                for (int d0 = 0; d0 < 4; ++d0) *(LAS bf16_t*)(stg + lr8 * 256 + (d0 * 32 + r32) * 2) = (bf16_t)f2bf(o[d0][r] * rl); }
            asm volatile("s_waitcnt lgkmcnt(0)" ::: "memory");
#pragma unroll
            for (int k = 0; k < 2; ++k) { const int ch = ln2 + 64 * k, row8 = ch >> 4, c16 = ch & 15; const u32x4 ov = *(const LAS u32x4*)(stg + row8 * 256 + c16 * 16); const u32x4 z = zv[2 * p + k];
                u32x4 w; w.x = cvt_pk_bf16(bf_lo(ov.x) * bf_lo(z.x), bf_hi(ov.x) * bf_hi(z.x)); w.y = cvt_pk_bf16(bf_lo(ov.y) * bf_lo(z.y), bf_hi(ov.y) * bf_hi(z.y));
                w.z = cvt_pk_bf16(bf_lo(ov.z) * bf_lo(z.z), bf_hi(ov.z) * bf_hi(z.z)); w.w = cvt_pk_bf16(bf_lo(ov.w) * bf_lo(z.w), bf_hi(ov.w) * bf_hi(z.w));
                *(GAS u32x4*)(ob + (size_t)(8 * p + row8) * DM + c16 * 8) = w; }
            asm volatile("s_waitcnt lgkmcnt(0)" ::: "memory");
        }
    }
}
}

#ifndef FLASH_NA
#define FLASH_NA 1
#endif
#ifndef FLASH_SW
#define FLASH_SW 1
#endif
#ifndef FLASH_MEM
#define FLASH_MEM 1
#endif
__device__ __forceinline__ void attention_phase(Frame& F, int l, int mask = 7) {
    LAS unsigned char* lds = F.lds; const int tid = F.tid, G = F.G;
    int tpar = 0;
    const int wid = F.wave;
    if (FLASH_NA && (mask & 1)) for (int i = 0;; ++i) {
        const int u = i * G + F.vcu; if (u >= 1152) break;
        const int bh = u >> 3, blk = u & 7, b = bh / 12, h = bh % 12;
        const int ln = lane_id_hw(), r32 = ln & 31, hi = ln >> 5;
        fa::FlashUnit U; U.C = 0.08838834764831845f * LOG2E; U.tblo = fa::OFF_TBL + tpar * 4096; tpar ^= 1;
        const int rb = blk >> 2, cb = blk & 3, lo = rb ? 12 : 0; U.NT = 10;
        int c0 = 16 * cb - 8; c0 = c0 < 0 ? 0 : (c0 > 32 ? 32 : c0);
        const size_t tok0 = (size_t)b * SEQ + rb * 1024 + cb * 16;
        const int qr = 16 * rb + 2 * wid + (r32 >> 4), qc = 16 * cb + (r32 & 15);
        int rs = qr - 4; rs = rs < 0 ? 0 : (rs > 24 ? 24 : rs); int cs = qc - 8; cs = cs < 0 ? 0 : (cs > 48 ? 48 : cs);
        int rsA = 16 * rb + 2 * wid - 4; rsA = rsA < 0 ? 0 : (rsA > 24 ? 24 : rsA); int rsB = 16 * rb + 2 * wid - 3; rsB = rsB < 0 ? 0 : (rsB > 24 ? 24 : rsB);
        U.Q = F.P + tok0 * INW + QA + h * 128; if (GATES_FP8) { const size_t ko = ((size_t)(b * 12 + h) * SEQ + lo * 64 + c0) * 128; U.K = (const bf16_t*)(F.ws + WS_KNA) + ko; U.V = (const bf16_t*)(F.ws + WS_VNA) + ko; }
        else { U.K = F.P + ((size_t)b * SEQ + lo * 64 + c0) * INW + KA + h * 128; U.V = U.K + (VA - KA); } U.Z = F.P + tok0 * INW + ZA + h * 128; U.O = F.X + tok0 * DM + h * 128;
        U.jlo = (rsA - lo) >> 1; U.jhi = ((rsB + 7 - lo) >> 1) + 1; U.rsl = rs - lo;
        U.lane_off = (lo - qr + 7) * 31 + (c0 - qc + 15) + 4 * hi; U.jstride = 62; U.vbase = c0 - cs + 4 * hi; U.vstride = 0; U.vlim = 16u;
        U.m_init = -30000.f; U.l_init = 0.f;
        const float* rp = F.rpb + (size_t)(l * 12 + h) * 465;
        { const int k = wid * 64 + ln; U.tcnt = 465; U.tv = (k < 465) ? ((const GAS float*)rp)[k] : 0.f; }
        if (mask & 8) U.jhi = U.jlo;
        fa::flash_unit<true>(lds, U, wid * 64 + ln);
    }
    if (FLASH_SW && (mask & 2)) for (int i = 0;; ++i) {
        int u = i * G + F.vcu; if (u >= 1152) break;
        int bh, blk;
        if (u < 864) { bh = u / 6; blk = 1 + u % 6; } else { u -= 864; bh = u >> 1; blk = (u & 1) * 7; }
        const int b = bh / 12, h = bh % 12;
        const int ln = lane_id_hw(), r32 = ln & 31, hi = ln >> 5;
        fa::FlashUnit U; U.C = 0.08838834764831845f * LOG2E; U.tblo = fa::OFF_TBL + tpar * 4096; tpar ^= 1; const size_t row0 = (size_t)b * SEQ + blk * 256;
        const int t0 = 256 * blk, kt0 = (blk == 0) ? 0 : t0 - 128; U.NT = (blk == 0 || blk == 7) ? 6 : 8;
        const int tq = t0 + 32 * wid + r32;
        U.Q = F.P + row0 * INW + QB + h * 128; if (GATES_FP8) { const size_t ko = ((size_t)(b * 4 + h / 3) * SEQ + kt0) * 128; U.K = (const bf16_t*)(F.ws + WS_KSW) + ko; U.V = (const bf16_t*)(F.ws + WS_VSW) + ko; }
        else { U.K = F.P + ((size_t)b * SEQ + kt0) * INW + KB + (h / 3) * 128; U.V = U.K + (VB - KB); } U.Z = F.P + row0 * INW + ZB + h * 128; U.O = F.X + row0 * DM + 1536 + h * 128;
        const int a = t0 + 32 * wid - 128 - kt0, bnd = t0 + 32 * wid + 159 - kt0; U.jlo = a <= 0 ? 0 : (a >> 6); { const int jh = (bnd >> 6) + 1; U.jhi = jh < U.NT ? jh : U.NT; }
        U.lane_off = kt0 - tq + 128 + 4 * hi; U.jstride = 64; U.vbase = U.lane_off; U.vstride = 64; U.vlim = 257u;
        U.m_init = F.sink[l * 12 + h] * LOG2E; U.l_init = 1.f; U.rsl = 0;
        { const int k = wid * 64 + ln; U.tcnt = 257; U.tv = (k < 257) ? ((const GAS float*)F.t5)[t5_bucket(k - 128) * 12 + h] : 0.f; }
        if (mask & 8) U.jhi = U.jlo;
        fa::flash_unit<false>(lds, U, wid * 64 + ln);
    }
    __syncthreads();
#if FLASH_MEM
    const bf16_t* KV = F.KVM + (size_t)l * MROWS * KVW;
    if (mask & 4) for (int i = 0;; ++i) {
        const int u = i * G + (G - 1 - F.vcu); if (u >= 384) break;
        const int bh = u >> 3, qb = u & 7, b = bh >> 2, h = bh & 3; const size_t row0 = (size_t)b * SEQ + qb * 256;
        fa::mem_unit(lds, F.P + row0 * INW + QM + h * 256, KV + (size_t)b * MEMT * KVW + h * 256, F.P + row0 * INW + ZM + h * 256, F.X + row0 * DM + 3072 + h * 256, F.wave * 64 + lane_id_hw());
    }
    __syncthreads();
#endif
}

__device__ __forceinline__ const float* x_row(const Frame& F, int m) { return m < TP ? F.xp + (size_t)m * DM : F.xs + (size_t)(m - TP) * DM; }

__device__ __forceinline__ void p0_prologue(Frame& F) {
    LAS float* scr = (LAS float*)(F.lds + F.wave * 16384);
    const int gw = F.vcu * NWAVES + F.wave, NGW = F.G * NWAVES;
    constexpr int I_IN = (DM / 64) * (INW / 32), I_KV = (DM / 64) * (KVW / 32), I_A = (1536 / 64) * (DM / 32), I_M = (1024 / 64) * (DM / 32), I_O = (DM / 64) * (DM / 32);
    constexpr int PER_L = I_IN + I_KV + 2 * I_A + I_M + I_O;
    auto decode = [&](int it, TItem& t) {
        const int l = it / PER_L; int r = it - l * PER_L; t.gain = nullptr; t.W8 = nullptr; t.n8 = 0; t.koff = 0; t.ldwt = DM;
        if (r < I_IN) { t.W = F.w_in + (size_t)l * DM * INW; t.N = INW; t.WT = F.WinT + (size_t)l * INW * DM; t.W8 = GATES_FP8 ? F.W8 + (size_t)l * NGATE * DM : nullptr; t.n8 = GA; t.item = r; return; } r -= I_IN;
        if (r < I_KV) { t.W = F.w_kv + (size_t)l * DM * KVW; t.N = KVW; t.WT = F.WkvT + (size_t)l * KVW * DM; t.gain = F.mem_norm + l * DM; t.item = r; return; } r -= I_KV;
        bf16_t* wc = F.WcatT + (size_t)l * DM * DM; t.N = DM; t.WT = wc;
        if (r < I_A) { t.W = F.w_a + (size_t)l * 1536 * DM; t.item = r; return; } r -= I_A;
        if (r < I_A) { t.W = F.w_b + (size_t)l * 1536 * DM; t.koff = 1536; t.item = r; return; } r -= I_A;
        if (r < I_M) { t.W = F.w_m + (size_t)l * 1024 * DM; t.koff = 3072; t.item = r; return; } r -= I_M;
        t.W = F.w_out + (size_t)l * DM * DM; t.WT = F.WoutT + (size_t)l * DM * DM; t.item = r; };
    { constexpr int TOT = DEPTH * PER_L; int it = gw; TItem A, B; float va[32], vb[32];
      if (it < TOT) { decode(it, A); titem_load(A, va, F.lane);
        for (;;) {
            bool hn = it + NGW < TOT; if (hn) { decode(it + NGW, B); titem_load(B, vb, F.lane); }
            titem_finish(A, va, scr, F.lane); if (!hn) break; it += NGW;
            hn = it + NGW < TOT; if (hn) { decode(it + NGW, A); titem_load(A, va, F.lane); }
            titem_finish(B, vb, scr, F.lane); if (!hn) break; it += NGW; } } }
    for (int m = gw; m < T; m += NGW) rms_row_to_bf16(x_row(F, m), F.pre_norm, F.H + (size_t)m * DM, F.lane, GATES_FP8 ? F.H8 + (size_t)m * DM : nullptr);
    for (int m = gw; m < MROWS; m += NGW) rms_row_to_bf16(m < 4 * MEMT ? F.memp + (size_t)m * DM : F.mems + (size_t)(m - 4 * MEMT) * DM, nullptr, F.MEMH + (size_t)m * DM, F.lane);
}
__device__ __forceinline__ void post_norm_phase(Frame& F, int l) {
    const int gw = F.vcu * NWAVES + F.wave, NGW = F.G * NWAVES, lane = F.lane;
    const float* pg = F.post_norm + l * DM; const float* npre = (l + 1 < DEPTH) ? F.pre_norm + (l + 1) * DM : nullptr;
    for (int m = gw; m < T; m += NGW) {
        const GAS u32x2* orow = (const GAS u32x2*)(F.X + (size_t)m * DM) + lane;
        GAS u32x2* x1row = (GAS u32x2*)(F.P + (size_t)m * INW + 18432) + lane;
        GAS f32x4* yo = (GAS f32x4*)(F.out + (size_t)m * DM) + lane;
        f32x4 v[16]; u32x2 ov[16]; float s2 = 0.f;
        if (l == 0) { const GAS f32x4* xr = (const GAS f32x4*)x_row(F, m) + lane;
#pragma unroll
            for (int j = 0; j < 16; ++j) { v[j] = xr[64 * j]; ov[j] = orow[64 * j]; } }
        else {
#pragma unroll
            for (int j = 0; j < 16; ++j) { const u32x2 xw = x1row[64 * j]; ov[j] = orow[64 * j]; v[j].x = bf_lo(xw.x); v[j].y = bf_hi(xw.x); v[j].z = bf_lo(xw.y); v[j].w = bf_hi(xw.y); } }
        f32x4 gv[16];
#pragma unroll
        for (int j = 0; j < 16; ++j) gv[j] = ((const GAS f32x4*)pg)[lane + 64 * j];
        __builtin_amdgcn_sched_barrier(0);
        const float ss = wave_sum(F.RSQ[(size_t)m * 64 + lane], lane);
        const float r = 1.0f / sqrtf(ss * (1.0f / DM) + RMS_EPS);
#pragma unroll
        for (int j = 0; j < 16; ++j) { const f32x4 x = v[j]; const u32x2 ow = ov[j]; const f32x4 g = gv[j];
            f32x4 y; y.x = x.x + bf_lo(ow.x) * r * g.x; y.y = x.y + bf_hi(ow.x) * r * g.y; y.z = x.z + bf_lo(ow.y) * r * g.z; y.w = x.w + bf_hi(ow.y) * r * g.w;
            v[j] = y; s2 += (y.x * y.x + y.y * y.y) + (y.z * y.z + y.w * y.w);
            if (npre) { u32x2 w; w.x = cvt_pk_bf16(y.x, y.y); w.y = cvt_pk_bf16(y.z, y.w); x1row[64 * j] = w; } else yo[64 * j] = y; }
        if (npre) {
#pragma unroll
            for (int j = 0; j < 16; ++j) gv[j] = ((const GAS f32x4*)npre)[lane + 64 * j];
            __builtin_amdgcn_sched_barrier(0);
            const float r2 = 1.0f / sqrtf(wave_sum(s2, lane) * (1.0f / DM) + RMS_EPS);
            GAS u32x2* h8 = (GAS u32x2*)(F.H + (size_t)m * DM) + lane;
#pragma unroll
            for (int j = 0; j < 16; ++j) { const f32x4 g = gv[j];
                const float y0 = v[j].x * r2 * g.x, y1 = v[j].y * r2 * g.y, y2 = v[j].z * r2 * g.z, y3 = v[j].w * r2 * g.w;
                u32x2 w; w.x = cvt_pk_bf16(y0, y1); w.y = cvt_pk_bf16(y2, y3); h8[64 * j] = w;
                if (GATES_FP8) ((GAS unsigned*)(F.H8 + (size_t)m * DM))[lane + 64 * j] = pk4_fp8(y0 * H8_SCALE, y1 * H8_SCALE, y2 * H8_SCALE, y3 * H8_SCALE); }
        }
    }
}

constexpr int N_PHASES = 1 + 5 * DEPTH;
__global__ void __launch_bounds__(NWAVES * 64, 2) fwd(Args args) {
    extern __shared__ __attribute__((aligned(16))) unsigned char lds_raw[];
    LAS unsigned char* lds = (LAS unsigned char*)lds_raw;
    const int wave_s = __builtin_amdgcn_readfirstlane((int)threadIdx.x >> 6);
    for (int u = wave_s * 64 + lane_id_hw(); u < (LDS_BYTES - LDSCTL_OFF) / 4; u += NWAVES * 64) ((LAS unsigned*)(lds + LDSCTL_OFF))[u] = 0u;
    __syncthreads();
    unsigned* const barw = (unsigned*)(args.ws + WS_CTL) + CW_BAR;
    XcdBarrier bar; bar.bar = barw; bar.x = 0; bar.st = nullptr;
    if (MK_ONE_LAUNCH) bar = xcd_barrier_post(barw, (volatile LAS unsigned*)(lds + MISC_OFF) + 8, wave_s == 0 && lane_id_hw() == 0);
    const int lo = args.ph_lo, hi = args.ph_hi;
#define IN(k) (lo <= (k) && (k) < hi)
#define SEAM(k) do { if (IN(k) && IN((k) + 1)) xcd_barrier(bar, wave_s == 0 && lane_id_hw() == 0); } while (0)

    const int probe_phase = args.probe_phase, n_iter = DEPTH + args.probe_reps;
    if (IN(0)) { Frame F; make_frame(F, lds, wave_s); p0_prologue(F); SEAM(0); }
    for (int it = 0; it < n_iter; ++it) {
        const bool probing = it >= DEPTH; const int l = probing ? ((it - DEPTH) & 1) : it;
        const int pb = 1 + 5 * l;
        if (probing && it == DEPTH) xcd_barrier(bar, wave_s == 0 && lane_id_hw() == 0);
#define RUN(k) (probing ? (probe_phase == (k)) : IN(pb + (k) - 1))
#define SEAM2(k) do { if (probing || (IN(pb + (k) - 1) && IN(pb + (k)))) xcd_barrier(bar, wave_s == 0 && lane_id_hw() == 0); } while (0)
        if (RUN(1)) {
            Frame F; make_frame(F, lds, wave_s);
            SchedIn S; S.G = F.G; S.c = (int)blockIdx.x; S.nextra = (l == 0) ? 2 * 96 : 0; S.A = (unsigned)WS_H; S.B = (unsigned)(WS_WIN + (size_t)l * INW * DM * 2);
            S.memA = (unsigned)WS_MEMH; S.memB0 = (unsigned)WS_WKV; S.memB1 = (unsigned)(WS_WKV + (size_t)KVW * DM * 2);
            EpiIn E{F.P, F.KVM, F.KVM + (size_t)MROWS * KVW, (bf16_t*)F.ws};
            pg8::gemm_phase<EpiIn, SchedIn>(lds, (const char*)F.ws, S, E, wave_s);
            SEAM2(1);
        }
        if (RUN(2)) { Frame F; make_frame(F, lds, wave_s); attention_phase(F, l); if (!(FLASH_NA && FLASH_SW && FLASH_MEM)) naive_attention(F, l); if (!GATES_FP8) SEAM2(2); }
        if (GATES_FP8 && RUN(2)) {
            Frame F; make_frame(F, lds, wave_s);
            SchedIn8 S8; S8.G = F.G; S8.c = (int)blockIdx.x; S8.A = (unsigned)WS_H8; S8.B = (unsigned)(WS_W8 + (size_t)l * NGATE * DM);
            EpiIn8 E8{F.P};
            pg8::gemm_phase<EpiIn8, SchedIn8, 4096, true>(lds, (const char*)F.ws, S8, E8, wave_s);
            SEAM2(2);
        }
        if (probing && probe_phase >= 6) { Frame F; make_frame(F, lds, wave_s); attention_phase(F, l, probe_phase == 6 ? 1 : probe_phase == 7 ? 2 : probe_phase == 8 ? 4 : probe_phase == 9 ? 9 : 10); xcd_barrier(bar, wave_s == 0 && lane_id_hw() == 0); }
        if (RUN(3)) {
            Frame F; make_frame(F, lds, wave_s);
            SchedBr S; S.G = F.G; S.c = (int)blockIdx.x; S.A = (unsigned)WS_X; S.B = (unsigned)(WS_WCAT + (size_t)l * DM * DM * 2);
            EpiBr E{F.P, F.H};
            pg8::gemm_phase<EpiBr, SchedBr>(lds, (const char*)F.ws, S, E, wave_s);
            SEAM2(3);
        }
        if (RUN(4)) {
            Frame F; make_frame(F, lds, wave_s);
            SchedOut S; S.G = F.G; S.c = (int)blockIdx.x; S.A = (unsigned)WS_H; S.B = (unsigned)(WS_WOUT + (size_t)l * DM * DM * 2);
            EpiOut E{F.X, F.RSQ};
            pg8::gemm_phase<EpiOut, SchedOut>(lds, (const char*)F.ws, S, E, wave_s);
            SEAM2(4);
        }
        if (RUN(5)) { Frame F; make_frame(F, lds, wave_s); if (probing) F.out = (float*)F.P; post_norm_phase(F, probing ? 0 : l); SEAM2(5); }
#undef RUN
#undef SEAM2
    }
#undef IN
#undef SEAM
}

extern "C" void kernel_launch(void* const* d_in, const int* in_sizes, int n_in, void* d_out, int out_size, void* d_ws, size_t ws_size, hipStream_t stream) {
    static int grid = 0;
    if (grid == 0) {
        if (n_in != 16 || in_sizes[0] != TP * DM || in_sizes[1] != (T - TP) * DM || out_size != T * DM || ws_size < WS_END) {
            fprintf(stderr, "kernel_launch: shape mismatch (n_in %d, in0 %d, in1 %d, out %d, ws %zu need %zu); nothing launched\n", n_in, n_in > 0 ? in_sizes[0] : -1, n_in > 1 ? in_sizes[1] : -1, out_size, ws_size, (size_t)WS_END); grid = -1; return; }
        int dev = 0, cus = 0, per_cu = 0;
        if (hipGetDevice(&dev) != hipSuccess || hipDeviceGetAttribute(&cus, hipDeviceAttributeMultiprocessorCount, dev) != hipSuccess) { grid = -1; return; }
        if (hipFuncSetAttribute((const void*)fwd, hipFuncAttributeMaxDynamicSharedMemorySize, LDS_BYTES) != hipSuccess) { fprintf(stderr, "kernel_launch: hipFuncSetAttribute failed\n"); grid = -1; return; }
        if (hipOccupancyMaxActiveBlocksPerMultiprocessor(&per_cu, (const void*)fwd, NWAVES * 64, LDS_BYTES) != hipSuccess || per_cu < 1)
            fprintf(stderr, "kernel_launch: note: occupancy query reports %d workgroups per CU\n", per_cu);
        (void)hipGetLastError();
        grid = cus;
    }
    if (grid < 0) return;
    if (hipMemsetAsync((char*)d_ws + WS_CTL, 0, CTL_ZERO_BYTES, stream) != hipSuccess) { fprintf(stderr, "kernel_launch: memset failed\n"); return; }
    Args a{};
    for (int i = 0; i < 16; ++i) a.in[i] = (const float*)d_in[i];
    a.out = (float*)d_out; a.ws = (unsigned char*)d_ws; a.probe_phase = PROBE_PHASE; a.probe_reps = PROBE_REPS;
#if MK_ONE_LAUNCH
    a.ph_lo = 0; a.ph_hi = N_PHASES;
    hipLaunchKernelGGL(fwd, dim3(grid), dim3(NWAVES * 64), LDS_BYTES, stream, a);
#else
    for (int p = 0; p < N_PHASES; ++p) { a.ph_lo = p; a.ph_hi = p + 1; hipLaunchKernelGGL(fwd, dim3(grid), dim3(NWAVES * 64), LDS_BYTES, stream, a); }
#endif
    const hipError_t le = hipPeekAtLastError();
    if (le != hipSuccess) fprintf(stderr, "kernel_launch: launch failed: %s\n", hipGetErrorName(le));
}
```

```cpp
#include <hip/hip_runtime.h>
#include <cstdio>
#include <cstdint>

#ifndef FLASH_NA
#define FLASH_NA 1
#endif
#ifndef FLASH_SW
#define FLASH_SW 1
#endif
#ifndef FLASH_MEM
#define FLASH_MEM 1
#endif
#ifndef PROBE_PHASE
#define PROBE_PHASE 0
#endif
#ifndef PROBE_REPS
#define PROBE_REPS 0
#endif
#ifndef GATE_U8
#define GATE_U8 1
#endif
#ifndef GATES_FP8
#define GATES_FP8 1
#endif
#ifndef WGM_IN
#define WGM_IN 4
#endif
#ifndef WGM_SM
#define WGM_SM 4
#endif
#ifndef MK_ONE_LAUNCH
#define MK_ONE_LAUNCH 1
#endif

#define LAS __attribute__((address_space(3)))
#define GAS __attribute__((address_space(1)))
typedef unsigned short bf16_t;
typedef short bf16x8 __attribute__((ext_vector_type(8)));
typedef float f32x4 __attribute__((ext_vector_type(4)));
typedef float f32x2 __attribute__((ext_vector_type(2)));
typedef unsigned u32x4 __attribute__((ext_vector_type(4)));
typedef unsigned u32x2 __attribute__((ext_vector_type(2)));

constexpr int DM = 4096, NSEQ = 12, SEQ = 2048, T = NSEQ * SEQ  , DEPTH = 2, TP = 4 * SEQ  ;
constexpr int INW = 24576;
constexpr int MEMT = 256, MROWS = NSEQ * MEMT;
constexpr int KVW = 2048;
constexpr int QA = 0, KA = 1536, VA = 3072, ZA = 4608, QB = 6144, KB = 7680, VB = 8192, ZB = 8704, QM = 10240, ZM = 11264, GA = 12288;
constexpr float RMS_EPS = 1e-6f;
constexpr float LOG2E = 1.4426950408889634f;

constexpr size_t MiB = 1u << 20;
constexpr size_t WS_CTL = 0, CTL_ZERO_BYTES = 64 * 1024;
constexpr size_t WS_WIN = 1 * MiB;
constexpr size_t WS_WKV = WS_WIN + 2 * 192 * MiB;
constexpr size_t WS_WCAT = WS_WKV + 2 * 16 * MiB;
constexpr size_t WS_WOUT = WS_WCAT + 2 * 32 * MiB;
constexpr size_t WS_H = WS_WOUT + 2 * 32 * MiB;
constexpr size_t WS_X = WS_H + 192 * MiB;
constexpr size_t WS_P = WS_X + 192 * MiB;
constexpr size_t WS_MEMH = WS_P + 1152 * MiB;
constexpr size_t WS_KVM = WS_MEMH + 24 * MiB;
constexpr size_t WS_RSQ = WS_KVM + 2 * 12 * MiB;
constexpr size_t WS_H8 = WS_RSQ + 6 * MiB;
constexpr size_t WS_W8 = WS_H8 + 96 * MiB;
constexpr size_t WS_END = WS_W8 + 2 * 48 * MiB;
constexpr size_t WS_KNA = WS_WIN + 96 * MiB, WS_KSW = WS_KNA + 72 * MiB;
constexpr size_t WS_VNA = WS_WIN + 192 * MiB + 96 * MiB, WS_VSW = WS_VNA + 72 * MiB;
constexpr float H8_SCALE = 8.f, W8_SCALE = 256.f, G8_DESCALE = 1.0f / (8.f * 256.f);
constexpr int NGATE = 3 * DM;
constexpr int CW_BAR = 4096;

constexpr int RING_BYTES = 131072;
constexpr int LDSCTL_OFF = RING_BYTES, MISC_OFF = LDSCTL_OFF + 320;
constexpr int LDS_BYTES = 163840;
constexpr int NWAVES = 8;

__device__ __forceinline__ int lane_id_hw() { int l; asm volatile("v_mbcnt_lo_u32_b32 %0, -1, 0\n\tv_mbcnt_hi_u32_b32 %0, -1, %0" : "=v"(l)); return l; }
typedef float f32x2_t_ __attribute__((ext_vector_type(2))); typedef __bf16 bf16x2_t_ __attribute__((ext_vector_type(2)));
__device__ __forceinline__ unsigned cvt_pk_bf16(float lo, float hi) { const f32x2_t_ v = {lo, hi}; const bf16x2_t_ b = __builtin_convertvector(v, bf16x2_t_); return __builtin_bit_cast(unsigned, b); }
__device__ __forceinline__ unsigned pk4_fp8(float a, float b, float c, float d) { int w = __builtin_amdgcn_cvt_pk_fp8_f32(a, b, 0, false); w = __builtin_amdgcn_cvt_pk_fp8_f32(c, d, w, true); return (unsigned)w; }
__device__ __forceinline__ float bf_lo(unsigned w) { return __uint_as_float(w << 16); }
__device__ __forceinline__ float bf_hi(unsigned w) { return __uint_as_float(w & 0xffff0000u); }
__device__ __forceinline__ float sigmoid_f(float x) { return __builtin_amdgcn_rcpf(1.0f + __builtin_amdgcn_exp2f(-x * LOG2E)); }
__device__ __forceinline__ unsigned gate_q8(float g) { return (unsigned)fmaxf(g * 255.0f + 0.5f, 1.0f); }
__device__ __forceinline__ unsigned gate_pk4(const f32x4& g) { return gate_q8(g[0]) | (gate_q8(g[1]) << 8) | (gate_q8(g[2]) << 16) | (gate_q8(g[3]) << 24); }
__device__ __forceinline__ float ub0(unsigned w) { return (float)(w & 0xffu); }
__device__ __forceinline__ float ub1(unsigned w) { return (float)((w >> 8) & 0xffu); }
__device__ __forceinline__ float ub2(unsigned w) { return (float)((w >> 16) & 0xffu); }
__device__ __forceinline__ float ub3(unsigned w) { return (float)(w >> 24); }
__device__ __forceinline__ void gate_ratio4(f32x4& v, unsigned n, unsigned d) {
    v[0] *= ub0(n) * __builtin_amdgcn_rcpf(ub0(d)); v[1] *= ub1(n) * __builtin_amdgcn_rcpf(ub1(d)); v[2] *= ub2(n) * __builtin_amdgcn_rcpf(ub2(d)); v[3] *= ub3(n) * __builtin_amdgcn_rcpf(ub3(d)); }
__device__ __forceinline__ void gate_mul4(f32x4& v, unsigned g) { const float s = 1.0f / 255.0f; v[0] *= ub0(g) * s; v[1] *= ub1(g) * s; v[2] *= ub2(g) * s; v[3] *= ub3(g) * s; }

namespace pg8 {
constexpr int BM = 256, BK = 64, HALF = 128, HTB = HALF * BK * 2, STAGE_BYTES = 8 * HTB, NXCD = 8, WGM = 8;
constexpr size_t KSTEP = (size_t)BK * 2;
constexpr size_t TSTEP16 = (size_t)256 * 4096 * 2, TSTEP8 = (size_t)256 * 4096;
typedef int i32x4 __attribute__((ext_vector_type(4)));
typedef int i32x8 __attribute__((ext_vector_type(8)));
__device__ __forceinline__ i32x8 cat8(bf16x8 lo, bf16x8 hi) { return __builtin_shufflevector(__builtin_bit_cast(i32x4, lo), __builtin_bit_cast(i32x4, hi), 0, 1, 2, 3, 4, 5, 6, 7); }
__host__ __device__ __forceinline__ int lds_byte(int r, int c) { const int st = (r >> 4) * 2 + (c >> 5), rr = r & 15, cc = c & 31, ob = rr * 64 + cc * 2; return st * 1024 + (ob ^ (((ob >> 9) & 1) << 5)); }
__host__ __device__ __forceinline__ void stage_rc(int b, int& R, int& C) { const int st = b / 1024, sb = b % 1024, swz = sb ^ (((sb >> 9) & 1) << 5); R = (st >> 1) * 16 + swz / 64; C = (st & 1) * 32 + (swz % 64) / 2; }
__host__ __device__ __forceinline__ int perm32(int rho) { const int n = rho >> 4, i = rho & 15; return 8 * (i >> 2) + 4 * n + (i & 3); }

struct GUnit { unsigned ao, bo; int nt, pm, pn, kind; };

template <int WGM_> __device__ __forceinline__ void tile_of(int L, int nM, int nN, int& pm, int& pn) {
    const int nwg = nM * nN; int wgid = L;
    { const int q = nwg / NXCD, r = nwg % NXCD, xcd = wgid % NXCD, off = wgid / NXCD; wgid = (xcd < r ? xcd * (q + 1) : r * (q + 1) + (xcd - r) * q) + off; }
    const int nig = WGM_ * nN, gid = wgid / nig, fm = gid * WGM_, gsz = (nM - fm) < WGM_ ? (nM - fm) : WGM_;
    pm = fm + ((wgid % nig) % gsz); pn = (wgid % nig) / gsz;
}

#ifndef PG8_SP2
#define PG8_SP2 true
#endif
template <class Epi, class Sched, int PITCH = 8192, bool F8 = false, bool SP2 = PG8_SP2>
__device__ __forceinline__ void gemm_phase(LAS unsigned char* lds, const char* wsb, const Sched& S, const Epi& E, int wave_s) {
    const int lane = lane_id_hw(), wid = wave_s, tid = wid * 64 + lane;
    const int wr = wid >> 2, wc = wid & 3, fr = lane & 15, fq = lane >> 4;
    unsigned voffA[2], voffB[2];
#pragma unroll
    for (int i = 0; i < 2; ++i) { int R, C; stage_rc(tid * 16 + i * 8192, R, C); const int Rb = (R & ~31) + perm32(R & 31);
        voffA[i] = (unsigned)(R * PITCH + C * 2); voffB[i] = (unsigned)(Rb * PITCH + C * 2); }
    const unsigned kstep = (unsigned)KSTEP, hstep = (unsigned)HALF * PITCH;
    const unsigned ldsw = (unsigned)wid * 1024u;
    const int aoff = lds_byte(wr * 64 + fr, fq * 8), boff = lds_byte(wc * 32 + fr, fq * 8);
#define PG8_SA(b, h) (((b) * 2 + (h)) * HTB)
#define PG8_SB(b, h) ((4 + (b) * 2 + (h)) * HTB)
#define PG8_STAGE(bufoff, gbase, voff) do { unsigned _g = (gbase); asm volatile("" : "+s"(_g));   _Pragma("unroll") for (int _i = 0; _i < 2; ++_i) \
        __builtin_amdgcn_global_load_lds((const unsigned*)(wsb + (size_t)(unsigned)(_g + (voff)[_i])), (LAS unsigned*)(lds + (bufoff) + ldsw + _i * 8192), 16, 0, 0); } while (0)
#define PG8_LDA(dst, b, h) do { if constexpr (F8) { _Pragma("unroll") for (int m = 0; m < 4; ++m) dst##8[m] = cat8(*(const LAS bf16x8*)(lds + PG8_SA(b, h) + aoff + m * 2048), *(const LAS bf16x8*)(lds + PG8_SA(b, h) + aoff + m * 2048 + 1024)); } \
      else { _Pragma("unroll") for (int m = 0; m < 4; ++m) _Pragma("unroll") for (int k = 0; k < 2; ++k) dst[m][k] = *(const LAS bf16x8*)(lds + PG8_SA(b, h) + aoff + m * 2048 + k * 1024); } } while (0)
#define PG8_LDB(dst, b, h) do { if constexpr (F8) { _Pragma("unroll") for (int n = 0; n < 2; ++n) dst##8[n] = cat8(*(const LAS bf16x8*)(lds + PG8_SB(b, h) + boff + n * 2048), *(const LAS bf16x8*)(lds + PG8_SB(b, h) + boff + n * 2048 + 1024)); } \
      else { _Pragma("unroll") for (int n = 0; n < 2; ++n) _Pragma("unroll") for (int k = 0; k < 2; ++k) dst[n][k] = *(const LAS bf16x8*)(lds + PG8_SB(b, h) + boff + n * 2048 + k * 1024); } } while (0)
#define PG8_MMA(ai, bj, At, Bt) do { __builtin_amdgcn_s_setprio(1); if constexpr (F8) { _Pragma("unroll") for (int m = 0; m < 4; ++m) _Pragma("unroll") for (int n = 0; n < 2; ++n) \
        acc[ai][bj][m][n] = __builtin_amdgcn_mfma_scale_f32_16x16x128_f8f6f4(Bt##8[n], At##8[m], acc[ai][bj][m][n], 0, 0, 0, 0, 0, 0); } \
      else { _Pragma("unroll") for (int m = 0; m < 4; ++m) _Pragma("unroll") for (int n = 0; n < 2; ++n) _Pragma("unroll") for (int k = 0; k < 2; ++k) \
        acc[ai][bj][m][n] = __builtin_amdgcn_mfma_f32_16x16x32_bf16(Bt[n][k], At[m][k], acc[ai][bj][m][n], 0, 0, 0); } __builtin_amdgcn_s_setprio(0); } while (0)
#define PG8_WAIT_V(n) asm volatile("s_waitcnt vmcnt(" #n ")" ::: "memory")
#define PG8_WAIT_L(n) asm volatile("s_waitcnt lgkmcnt(" #n ")" ::: "memory")
#define PG8_BAR __builtin_amdgcn_s_barrier()
#define PG8_SCHED __builtin_amdgcn_sched_barrier(0)
    GUnit cur, nxt; int ui = 0;
    if (!S.next(0, cur)) return;
    f32x4 acc[2][2][4][2];
#pragma unroll
    for (int a = 0; a < 2; ++a)
#pragma unroll
        for (int b = 0; b < 2; ++b)
#pragma unroll
            for (int m = 0; m < 4; ++m)
#pragma unroll
                for (int n = 0; n < 2; ++n) acc[a][b][m][n] = (f32x4){0.f, 0.f, 0.f, 0.f};
    bf16x8 At[4][2], B0[2][2], B1[2][2]; i32x8 At8[4], B08[2], B18[2];
    unsigned cA = cur.ao, cB = cur.bo;
    if constexpr (SP2) {
        PG8_STAGE(PG8_SB(0, 0), cB, voffB); PG8_STAGE(PG8_SB(0, 1), cB + hstep, voffB); PG8_STAGE(PG8_SA(0, 0), cA, voffA); PG8_STAGE(PG8_SA(0, 1), cA + hstep, voffA);
        if (wr == 1) PG8_BAR;
        PG8_WAIT_V(2); PG8_BAR;
        PG8_STAGE(PG8_SB(1, 0), cB + kstep, voffB); PG8_STAGE(PG8_SA(1, 0), cA + kstep, voffA); PG8_STAGE(PG8_SB(1, 1), cB + hstep + kstep, voffB);
        PG8_WAIT_V(6); PG8_BAR;
    } else {
    PG8_STAGE(PG8_SB(0, 0), cB, voffB); PG8_STAGE(PG8_SA(0, 0), cA, voffA); PG8_STAGE(PG8_SB(0, 1), cB + hstep, voffB); PG8_STAGE(PG8_SA(0, 1), cA + hstep, voffA);
    if (wr == 1) PG8_BAR;
    PG8_WAIT_V(4); PG8_BAR;
    PG8_STAGE(PG8_SB(1, 0), cB + kstep, voffB); PG8_STAGE(PG8_SA(1, 0), cA + kstep, voffA); PG8_STAGE(PG8_SB(1, 1), cB + hstep + kstep, voffB);
    PG8_WAIT_V(6); PG8_BAR;
    }
    for (;;) {
        const bool has_next = S.next(ui + 1, nxt);
        const unsigned nA = has_next ? nxt.ao : cA, nB = has_next ? nxt.bo : cB;
        const int nt = cur.nt;
        for (int t = 0; t < nt; t += 2) {
            if constexpr (Epi::HAS_MID) { if (t == Epi::MID0 || t == Epi::MID1) { const int l2 = lane_id_hw(); E.mid(acc, cur, t == Epi::MID0 ? 0 : 1, wr, wc, l2 & 15, l2 >> 4); } }
            const bool last = (t == nt - 2);
            const unsigned a1 = cA + (unsigned)(t + 1) * kstep;
            const unsigned a2 = last ? nA : cA + (unsigned)(t + 2) * kstep, b2 = last ? nB : cB + (unsigned)(t + 2) * kstep;
            const unsigned a3 = a2 + kstep, b3 = b2 + kstep;
            if constexpr (SP2) {
            PG8_LDB(B0, 0, 0); PG8_LDB(B1, 0, 1); PG8_SCHED; PG8_LDA(At, 0, 0); PG8_STAGE(PG8_SA(1, 1), a1 + hstep, voffA);
            PG8_WAIT_V(8); PG8_WAIT_L(0); PG8_BAR; PG8_MMA(0, 0, At, B0); PG8_MMA(0, 1, At, B1); PG8_BAR; PG8_SCHED;
            PG8_LDA(At, 0, 1); PG8_STAGE(PG8_SB(0, 0), b2, voffB); PG8_STAGE(PG8_SB(0, 1), b2 + hstep, voffB); PG8_STAGE(PG8_SA(0, 0), a2, voffA);
            PG8_WAIT_V(8); PG8_WAIT_L(0); PG8_BAR; PG8_MMA(1, 0, At, B0); PG8_MMA(1, 1, At, B1); PG8_BAR; PG8_SCHED;
            PG8_LDB(B0, 1, 0); PG8_LDB(B1, 1, 1); PG8_SCHED; PG8_LDA(At, 1, 0); PG8_STAGE(PG8_SA(0, 1), a2 + hstep, voffA);
            PG8_WAIT_V(8); PG8_WAIT_L(0); PG8_BAR; PG8_MMA(0, 0, At, B0); PG8_MMA(0, 1, At, B1); PG8_BAR; PG8_SCHED;
            PG8_LDA(At, 1, 1); PG8_STAGE(PG8_SB(1, 0), b3, voffB); PG8_STAGE(PG8_SB(1, 1), b3 + hstep, voffB); PG8_STAGE(PG8_SA(1, 0), a3, voffA);
            PG8_WAIT_V(8); PG8_WAIT_L(0); PG8_BAR; PG8_MMA(1, 0, At, B0); PG8_MMA(1, 1, At, B1); PG8_BAR; PG8_SCHED;
            } else {
            PG8_LDB(B0, 0, 0); PG8_SCHED; PG8_LDA(At, 0, 0); PG8_STAGE(PG8_SA(1, 1), a1 + hstep, voffA);
            PG8_WAIT_L(8); PG8_BAR; PG8_WAIT_L(0); PG8_MMA(0, 0, At, B0); PG8_BAR; PG8_SCHED;
            PG8_LDB(B1, 0, 1); PG8_STAGE(PG8_SB(0, 0), b2, voffB);
            PG8_BAR; PG8_WAIT_L(0); PG8_MMA(0, 1, At, B1); PG8_BAR;
            PG8_LDA(At, 0, 1); PG8_STAGE(PG8_SA(0, 0), a2, voffA);
            PG8_BAR; PG8_WAIT_L(0); PG8_MMA(1, 0, At, B0); PG8_BAR; PG8_SCHED;
            PG8_STAGE(PG8_SB(0, 1), b2 + hstep, voffB);
            PG8_WAIT_V(6); PG8_BAR; PG8_MMA(1, 1, At, B1); PG8_BAR;
            PG8_LDB(B0, 1, 0); PG8_SCHED; PG8_LDA(At, 1, 0); PG8_STAGE(PG8_SA(0, 1), a2 + hstep, voffA);
            PG8_WAIT_L(8); PG8_BAR; PG8_WAIT_L(0); PG8_MMA(0, 0, At, B0); PG8_BAR; PG8_SCHED;
            PG8_LDB(B1, 1, 1); PG8_STAGE(PG8_SB(1, 0), b3, voffB);
            PG8_BAR; PG8_WAIT_L(0); PG8_MMA(0, 1, At, B1); PG8_BAR;
            PG8_LDA(At, 1, 1); PG8_STAGE(PG8_SA(1, 0), a3, voffA);
            PG8_BAR; PG8_WAIT_L(0); PG8_MMA(1, 0, At, B0); PG8_BAR; PG8_SCHED;
            PG8_STAGE(PG8_SB(1, 1), b3 + hstep, voffB);
            PG8_WAIT_V(6); PG8_BAR; PG8_MMA(1, 1, At, B1); PG8_BAR;
            }
        }
        { const int l2 = lane_id_hw(); E(acc, cur, wr, wc, l2 & 15, l2 >> 4); }
        if (!has_next) break;
#pragma unroll
        for (int a = 0; a < 2; ++a)
#pragma unroll
            for (int b = 0; b < 2; ++b)
#pragma unroll
                for (int m = 0; m < 4; ++m)
#pragma unroll
                    for (int n = 0; n < 2; ++n) acc[a][b][m][n] = (f32x4){0.f, 0.f, 0.f, 0.f};
        cur = nxt; cA = nA; cB = nB; ++ui;
    }
    PG8_WAIT_V(0);
    if (wr == 0) PG8_BAR;
    PG8_BAR;
#undef PG8_SA
#undef PG8_SB
#undef PG8_STAGE
#undef PG8_LDA
#undef PG8_LDB
#undef PG8_MMA
#undef PG8_WAIT_V
#undef PG8_WAIT_L
#undef PG8_BAR
#undef PG8_SCHED
}
}

struct SchedIn {
    int G, c, nextra; unsigned A, B, memA, memB0, memB1;
    __device__ __forceinline__ bool next(int i, pg8::GUnit& u) const {
        int L = i * G + c;
        constexpr int NN = GATES_FP8 ? 48 : 96;
        if (L < 96 * NN) { int pm, pn; pg8::tile_of<WGM_IN>(L, 96, NN, pm, pn); u.ao = A + (unsigned)pm * (unsigned)pg8::TSTEP16; u.bo = B + (unsigned)pn * (unsigned)pg8::TSTEP16; u.nt = 64; u.pm = pm; u.pn = pn; u.kind = 0; return true; }
        L -= 96 * NN; if (L >= nextra) return false;
        const int le = L / 96, r = L % 96, pm = r % 12, pn = r / 12;
        u.ao = memA + (unsigned)pm * (unsigned)pg8::TSTEP16; u.bo = (le ? memB1 : memB0) + (unsigned)pn * (unsigned)pg8::TSTEP16; u.nt = 64; u.pm = pm; u.pn = pn; u.kind = 1 + le; return true;
    }
};
struct EpiIn {   static constexpr bool HAS_MID = false; static constexpr int MID0 = -1, MID1 = -1;
    bf16_t* P; bf16_t* KVM0; bf16_t* KVM1; bf16_t* wsb16;
    __device__ __forceinline__ void operator()(const f32x4 (&acc)[2][2][4][2], const pg8::GUnit& u, int wr, int wc, int fr, int fq) const {
        bf16_t* base; int ldc, mode = 0, bjs = 128; int rowb = u.pm * 256 + wr * 64 + fr, colb = u.pn * 256 + wc * 32 + 8 * fq;
        if (u.kind == 0) { base = P; ldc = INW; const int pn = u.pn; if (pn >= GA / 256) mode = 1; else if ((pn >= ZA / 256 && pn < QB / 256) || (pn >= ZB / 256 && pn < QM / 256) || (pn >= ZM / 256)) mode = 2;
            if (GATES_FP8) {
                int nh = 0, hp = 0; size_t off = 0;
                if (pn >= KA / 256 && pn < VA / 256) { nh = 12; hp = pn - KA / 256; off = WS_KNA; } else if (pn >= VA / 256 && pn < ZA / 256) { nh = 12; hp = pn - VA / 256; off = WS_VNA; }
                else if (pn >= KB / 256 && pn < VB / 256) { nh = 4; hp = pn - KB / 256; off = WS_KSW; } else if (pn >= VB / 256 && pn < ZB / 256) { nh = 4; hp = pn - VB / 256; off = WS_VSW; }
                if (nh) { const int b = u.pm >> 3; base = wsb16 + off / 2; ldc = 128; bjs = SEQ * 128; rowb = (b * nh + 2 * hp) * SEQ + (u.pm & 7) * 256 + wr * 64 + fr; colb = wc * 32 + 8 * fq; } } }
        else { base = (u.kind == 1) ? KVM0 : KVM1; ldc = KVW; }
#pragma unroll
        for (int ai = 0; ai < 2; ++ai)
#pragma unroll
            for (int m = 0; m < 4; ++m) { GAS bf16_t* rowp = (GAS bf16_t*)base + (size_t)(rowb + ai * 128 + m * 16) * ldc + colb;
#pragma unroll
                for (int bj = 0; bj < 2; ++bj) { f32x4 v0 = acc[ai][bj][m][0], v1 = acc[ai][bj][m][1];
                    if (mode == 1) {
#pragma unroll
                        for (int j = 0; j < 4; ++j) { v0[j] = sigmoid_f(v0[j]); v1[j] = sigmoid_f(v1[j]); } }
                    else if (mode == 2) {
#pragma unroll
                        for (int j = 0; j < 4; ++j) { v0[j] = v0[j] * sigmoid_f(v0[j]); v1[j] = v1[j] * sigmoid_f(v1[j]); } }
                    u32x4 w; w.x = cvt_pk_bf16(v0[0], v0[1]); w.y = cvt_pk_bf16(v0[2], v0[3]); w.z = cvt_pk_bf16(v1[0], v1[1]); w.w = cvt_pk_bf16(v1[2], v1[3]);
                    *(GAS u32x4*)(rowp + (size_t)bj * bjs) = w; } }
    }
};
struct SchedIn8 {
    int G, c; unsigned A, B;
    __device__ __forceinline__ bool next(int i, pg8::GUnit& u) const {
        const int L = i * G + c; if (L >= 96 * 48) return false;
        int pm, pn; pg8::tile_of<WGM_IN>(L, 96, 48, pm, pn);
        u.ao = A + (unsigned)pm * (unsigned)pg8::TSTEP8; u.bo = B + (unsigned)pn * (unsigned)pg8::TSTEP8; u.nt = 32; u.pm = pm; u.pn = pn; u.kind = 0; return true;
    }
};
struct EpiIn8 {   static constexpr bool HAS_MID = false; static constexpr int MID0 = -1, MID1 = -1;
    bf16_t* P;
    __device__ __forceinline__ void operator()(const f32x4 (&acc)[2][2][4][2], const pg8::GUnit& u, int wr, int wc, int fr, int fq) const {
#if GATE_U8
        GAS unsigned char* gb = (GAS unsigned char*)P + (size_t)(u.pm * 256 + (wr * 4 + wc) * 32 + fq) * (INW * 2) + (GA * 2 + u.pn * 256 + fr * 16);
#pragma unroll
        for (int ai = 0; ai < 2; ++ai)
#pragma unroll
            for (int m = 0; m < 4; ++m) { u32x4 w; unsigned wq[4];
#pragma unroll
                for (int bj = 0; bj < 2; ++bj)
#pragma unroll
                    for (int n = 0; n < 2; ++n) { f32x4 v = acc[ai][bj][m][n];
#pragma unroll
                        for (int j = 0; j < 4; ++j) v[j] = __builtin_amdgcn_rcpf(1.0f + __builtin_amdgcn_exp2f(v[j] * (-LOG2E * G8_DESCALE)));
                        wq[bj * 2 + n] = gate_pk4(v); }
                w.x = wq[0]; w.y = wq[1]; w.z = wq[2]; w.w = wq[3];
                *(GAS u32x4*)(gb + (size_t)((ai * 4 + m) * 4) * (INW * 2)) = w; }
#else
        const int row0 = u.pm * 256 + wr * 64 + fr, col0 = GA + u.pn * 256 + wc * 32 + 8 * fq;
#pragma unroll
        for (int ai = 0; ai < 2; ++ai)
#pragma unroll
            for (int m = 0; m < 4; ++m) { GAS bf16_t* rowp = (GAS bf16_t*)P + (size_t)(row0 + ai * 128 + m * 16) * INW + col0;
#pragma unroll
                for (int bj = 0; bj < 2; ++bj) { f32x4 v0 = acc[ai][bj][m][0], v1 = acc[ai][bj][m][1];
#pragma unroll
                    for (int j = 0; j < 4; ++j) { v0[j] = __builtin_amdgcn_rcpf(1.0f + __builtin_amdgcn_exp2f(v0[j] * (-LOG2E * G8_DESCALE))); v1[j] = __builtin_amdgcn_rcpf(1.0f + __builtin_amdgcn_exp2f(v1[j] * (-LOG2E * G8_DESCALE))); }
                    u32x4 w; w.x = cvt_pk_bf16(v0[0], v0[1]); w.y = cvt_pk_bf16(v0[2], v0[3]); w.z = cvt_pk_bf16(v1[0], v1[1]); w.w = cvt_pk_bf16(v1[2], v1[3]);
                    *(GAS u32x4*)(rowp + bj * 128) = w; } }
#endif
    }
};
struct SchedBr {
    int G, c; unsigned A, B;
    __device__ __forceinline__ bool next(int i, pg8::GUnit& u) const {
        const int L = i * G + c; if (L >= 96 * 16) return false;
        int pm, pn; pg8::tile_of<WGM_SM>(L, 96, 16, pm, pn);
        u.ao = A + (unsigned)pm * (unsigned)pg8::TSTEP16; u.bo = B + (unsigned)pn * (unsigned)pg8::TSTEP16; u.nt = 64; u.pm = pm; u.pn = pn; u.kind = 0; return true;
    }
};
struct EpiBr {
    static constexpr bool HAS_MID = true; static constexpr int MID0 = 24, MID1 = 48;
    const bf16_t* P; bf16_t* Mg;
    __device__ __forceinline__ void mid(f32x4 (&acc)[2][2][4][2], const pg8::GUnit& u, int b, int wr, int wc, int fr, int fq) const {
#if GATE_U8
        const GAS unsigned char* gp = (const GAS unsigned char*)P + (size_t)(u.pm * 256 + (wr * 4 + wc) * 32 + fq) * (INW * 2) + (GA * 2 + (b * 16 + u.pn) * 256 + fr * 16);
        u32x4 gn[8], gd[8];
#pragma unroll
        for (int k = 0; k < 8; ++k) { const GAS unsigned char* q = gp + (size_t)(k * 4) * (INW * 2); gn[k] = *(const GAS u32x4*)q; gd[k] = *(const GAS u32x4*)(q + DM); }
#pragma unroll
        for (int k = 0; k < 8; ++k) { const int ai = k >> 2, m = k & 3;
            gate_ratio4(acc[ai][0][m][0], gn[k].x, gd[k].x); gate_ratio4(acc[ai][0][m][1], gn[k].y, gd[k].y); gate_ratio4(acc[ai][1][m][0], gn[k].z, gd[k].z); gate_ratio4(acc[ai][1][m][1], gn[k].w, gd[k].w); }
#else
        const int row0 = u.pm * 256 + wr * 64 + fr, col0 = u.pn * 256 + wc * 32 + 8 * fq;
        const GAS bf16_t* gp = (const GAS bf16_t*)P + (size_t)row0 * INW + GA + b * DM + col0;
#pragma unroll
        for (int ai = 0; ai < 2; ++ai) {
            u32x4 gn[4][2], gd[4][2];
#pragma unroll
            for (int m = 0; m < 4; ++m)
#pragma unroll
                for (int bj = 0; bj < 2; ++bj) { const GAS bf16_t* q = gp + (size_t)(ai * 128 + m * 16) * INW + bj * 128; gn[m][bj] = *(const GAS u32x4*)q; gd[m][bj] = *(const GAS u32x4*)(q + DM); }
#pragma unroll
            for (int m = 0; m < 4; ++m)
#pragma unroll
                for (int bj = 0; bj < 2; ++bj) { const u32x4 n4 = gn[m][bj], d4 = gd[m][bj];
                    f32x4& v0 = acc[ai][bj][m][0]; f32x4& v1 = acc[ai][bj][m][1];
                    v0[0] *= bf_lo(n4.x) * __builtin_amdgcn_rcpf(fmaxf(bf_lo(d4.x), 1e-30f)); v0[1] *= bf_hi(n4.x) * __builtin_amdgcn_rcpf(fmaxf(bf_hi(d4.x), 1e-30f));
                    v0[2] *= bf_lo(n4.y) * __builtin_amdgcn_rcpf(fmaxf(bf_lo(d4.y), 1e-30f)); v0[3] *= bf_hi(n4.y) * __builtin_amdgcn_rcpf(fmaxf(bf_hi(d4.y), 1e-30f));
                    v1[0] *= bf_lo(n4.z) * __builtin_amdgcn_rcpf(fmaxf(bf_lo(d4.z), 1e-30f)); v1[1] *= bf_hi(n4.z) * __builtin_amdgcn_rcpf(fmaxf(bf_hi(d4.z), 1e-30f));
                    v1[2] *= bf_lo(n4.w) * __builtin_amdgcn_rcpf(fmaxf(bf_lo(d4.w), 1e-30f)); v1[3] *= bf_hi(n4.w) * __builtin_amdgcn_rcpf(fmaxf(bf_hi(d4.w), 1e-30f)); }
        }
#endif
    }
    __device__ __forceinline__ void operator()(const f32x4 (&acc)[2][2][4][2], const pg8::GUnit& u, int wr, int wc, int fr, int fq) const {
        const int row0 = u.pm * 256 + wr * 64 + fr, col0 = u.pn * 256 + wc * 32 + 8 * fq;
        GAS bf16_t* mp0 = (GAS bf16_t*)Mg + (size_t)row0 * DM + col0;
#if GATE_U8
        const GAS unsigned char* gp = (const GAS unsigned char*)P + (size_t)(u.pm * 256 + (wr * 4 + wc) * 32 + fq) * (INW * 2) + (GA * 2 + (2 * 16 + u.pn) * 256 + fr * 16);
        u32x4 g[8];
#pragma unroll
        for (int k = 0; k < 8; ++k) g[k] = *(const GAS u32x4*)(gp + (size_t)(k * 4) * (INW * 2));
#pragma unroll
        for (int k = 0; k < 8; ++k) { const int ai = k >> 2, m = k & 3;
#pragma unroll
            for (int bj = 0; bj < 2; ++bj) { f32x4 v0 = acc[ai][bj][m][0], v1 = acc[ai][bj][m][1];
                gate_mul4(v0, bj ? g[k].z : g[k].x); gate_mul4(v1, bj ? g[k].w : g[k].y);
                u32x4 w; w.x = cvt_pk_bf16(v0[0], v0[1]); w.y = cvt_pk_bf16(v0[2], v0[3]); w.z = cvt_pk_bf16(v1[0], v1[1]); w.w = cvt_pk_bf16(v1[2], v1[3]);
                *(GAS u32x4*)(mp0 + (size_t)(ai * 128 + m * 16) * DM + bj * 128) = w; } }
#else
        const GAS bf16_t* gp = (const GAS bf16_t*)P + (size_t)row0 * INW + GA + 2 * DM + col0;
#pragma unroll
        for (int ai = 0; ai < 2; ++ai) {
            u32x4 g[4][2];
#pragma unroll
            for (int m = 0; m < 4; ++m)
#pragma unroll
                for (int bj = 0; bj < 2; ++bj) g[m][bj] = *(const GAS u32x4*)(gp + (size_t)(ai * 128 + m * 16) * INW + bj * 128);
#pragma unroll
            for (int m = 0; m < 4; ++m)
#pragma unroll
                for (int bj = 0; bj < 2; ++bj) { const u32x4 gg = g[m][bj];
                    f32x4 v0 = acc[ai][bj][m][0], v1 = acc[ai][bj][m][1];
                    v0[0] *= bf_lo(gg.x); v0[1] *= bf_hi(gg.x); v0[2] *= bf_lo(gg.y); v0[3] *= bf_hi(gg.y); v1[0] *= bf_lo(gg.z); v1[1] *= bf_hi(gg.z); v1[2] *= bf_lo(gg.w); v1[3] *= bf_hi(gg.w);
                    u32x4 w; w.x = cvt_pk_bf16(v0[0], v0[1]); w.y = cvt_pk_bf16(v0[2], v0[3]); w.z = cvt_pk_bf16(v1[0], v1[1]); w.w = cvt_pk_bf16(v1[2], v1[3]);
                    *(GAS u32x4*)(mp0 + (size_t)(ai * 128 + m * 16) * DM + bj * 128) = w; }
        }
#endif
    }
};
struct SchedOut {
    int G, c; unsigned A, B;
    __device__ __forceinline__ bool next(int i, pg8::GUnit& u) const {
        const int L = i * G + c; if (L >= 96 * 16) return false;
        int pm, pn; pg8::tile_of<WGM_SM>(L, 96, 16, pm, pn);
        u.ao = A + (unsigned)pm * (unsigned)pg8::TSTEP16; u.bo = B + (unsigned)pn * (unsigned)pg8::TSTEP16; u.nt = 64; u.pm = pm; u.pn = pn; u.kind = 0; return true;
    }
};
struct EpiOut {  static constexpr bool HAS_MID = false; static constexpr int MID0 = -1, MID1 = -1;
    bf16_t* O; float* RSQ;
    __device__ __forceinline__ void operator()(const f32x4 (&acc)[2][2][4][2], const pg8::GUnit& u, int wr, int wc, int fr, int fq) const {
        const int row0 = u.pm * 256 + wr * 64 + fr, col0 = u.pn * 256 + wc * 32 + 8 * fq;
#pragma unroll
        for (int ai = 0; ai < 2; ++ai)
#pragma unroll
            for (int m = 0; m < 4; ++m) { const size_t row = (size_t)(row0 + ai * 128 + m * 16); float s = 0.f;
#pragma unroll
                for (int bj = 0; bj < 2; ++bj) { const f32x4 v0 = acc[ai][bj][m][0], v1 = acc[ai][bj][m][1];
                    s += (v0[0] * v0[0] + v0[1] * v0[1]) + (v0[2] * v0[2] + v0[3] * v0[3]) + (v1[0] * v1[0] + v1[1] * v1[1]) + (v1[2] * v1[2] + v1[3] * v1[3]);
                    u32x4 w; w.x = cvt_pk_bf16(v0[0], v0[1]); w.y = cvt_pk_bf16(v0[2], v0[3]); w.z = cvt_pk_bf16(v1[0], v1[1]); w.w = cvt_pk_bf16(v1[2], v1[3]);
                    *(GAS u32x4*)((GAS bf16_t*)O + row * DM + col0 + bj * 128) = w; }
                { const int ln = fr + 16 * fq; s += __int_as_float(__builtin_amdgcn_ds_bpermute((ln ^ 16) << 2, __float_as_int(s))); s += __int_as_float(__builtin_amdgcn_ds_bpermute((ln ^ 32) << 2, __float_as_int(s))); }
                if (fq == 0) ((GAS float*)RSQ)[row * 64 + u.pn * 4 + wc] = s; }
    }
};

static_assert(!GATE_U8 || GATES_FP8, "GATE_U8 lives in the fp8 gate GEMM epilogue");
#define XB_TMO      128
#define XB_XCNT(j)  (256  + 64 * (j))
#define XB_XSUB(j)  (1280 + 64 * (j))
#define XB_XGEN(j)  (2304 + 64 * (j))
#define XB_TOP      3328
#define XB_TOPGEN   3392
#define XCD_BAR_WORDS 3456
#define XB_SPIN_CAP (1u << 18)
__device__ __forceinline__ unsigned xb_ld(unsigned* p)              { return __hip_atomic_load(p, __ATOMIC_RELAXED, __HIP_MEMORY_SCOPE_AGENT); }
__device__ __forceinline__ unsigned xb_add(unsigned* p, unsigned v) { return __hip_atomic_fetch_add(p, v, __ATOMIC_RELAXED, __HIP_MEMORY_SCOPE_AGENT); }
__device__ __forceinline__ unsigned xb_xcc_id() { return (unsigned)__builtin_amdgcn_s_getreg((3 << 11) | 20) & 0xFu; }
#define XB_SPIN(cond, bar) do { unsigned _sp = 0; while (cond) { __builtin_amdgcn_s_sleep(1); \
    if ((++_sp & 255u) == 0u) { if (xb_ld(&(bar)[XB_TMO])) break; if (_sp > XB_SPIN_CAP) { atomicAdd(&(bar)[XB_TMO], 1u); break; } } } } while (0)
struct XcdBarrier { unsigned* bar; unsigned x; volatile LAS unsigned* st; };
__device__ __forceinline__ XcdBarrier xcd_barrier_post(unsigned* bar, volatile LAS unsigned* st, bool leader) {
    XcdBarrier b; b.bar = bar; b.x = xb_xcc_id(); b.st = st;
    if (leader) (void)xb_add(&bar[XB_XCNT(b.x)], 1u);
    return b;
}
__device__ __forceinline__ void xcd_barrier_complete(unsigned* bar, unsigned x, unsigned& nloc, unsigned& nx) {
    const unsigned G = gridDim.x * gridDim.y * gridDim.z;
    unsigned sum, cnt, mine, sp = 0u;
    for (;;) {
        sum = 0u; cnt = 0u; mine = 0u;
#pragma unroll
        for (unsigned j = 0; j < 16; ++j) { const unsigned c = xb_ld(&bar[XB_XCNT(j)]); sum += c; cnt += (c > 0u) ? 1u : 0u; mine = (j == x) ? c : mine; }
        if (sum == G) break;
        __builtin_amdgcn_s_sleep(1);
        if ((++sp & 255u) == 0u) { if (xb_ld(&bar[XB_TMO])) break; if (sp > XB_SPIN_CAP) { atomicAdd(&bar[XB_TMO], 1u); break; } }
    }
    nloc = mine > 0u ? mine : 1u; nx = cnt > 0u ? cnt : 1u;
}
__device__ __forceinline__ void xcd_barrier(const XcdBarrier& b, bool leader) {
    asm volatile("s_waitcnt vmcnt(0)" ::: "memory");
    __syncthreads();
    if (leader) {
        unsigned* bar = b.bar;
        __builtin_amdgcn_s_waitcnt(0);
        unsigned nloc = b.st[0], nx = b.st[1];
        if (nloc == 0u) { xcd_barrier_complete(bar, b.x, nloc, nx); b.st[0] = nloc; b.st[1] = nx; }
        const unsigned old = xb_add(&bar[XB_XSUB(b.x)], 1u);
        const unsigned gen = old / nloc;
        if (old + 1u == (gen + 1u) * nloc) {
            __builtin_amdgcn_fence(__ATOMIC_RELEASE, "agent");
            asm volatile("s_waitcnt vmcnt(0)" ::: "memory");
            const unsigned og = xb_add(&bar[XB_TOP], 1u);
            const unsigned tg = og / nx;
            if (og + 1u == (tg + 1u) * nx) xb_add(&bar[XB_TOPGEN], 1u);
            else XB_SPIN(xb_ld(&bar[XB_TOPGEN]) == tg, bar);
            __builtin_amdgcn_fence(__ATOMIC_ACQUIRE, "agent");
            xb_add(&bar[XB_XGEN(b.x)], 1u);
            asm volatile("s_waitcnt vmcnt(0)" ::: "memory");
        } else {
            XB_SPIN(xb_ld(&bar[XB_XGEN(b.x)]) == gen, bar);
            __builtin_amdgcn_fence(__ATOMIC_ACQUIRE, "agent");
            asm volatile("s_waitcnt vmcnt(0)" ::: "memory");
        }
    }
    __syncthreads();
}

__device__ __forceinline__ float shfl_xor_l(float v, int mask, int lane) { return __int_as_float(__builtin_amdgcn_ds_bpermute((lane ^ mask) << 2, __float_as_int(v))); }
__device__ __forceinline__ float wave_sum(float v, int lane) {
#pragma unroll
    for (int o = 1; o < 64; o <<= 1) v += shfl_xor_l(v, o, lane);
    return v;
}
__device__ __forceinline__ unsigned f2bf(float f) { unsigned u = __builtin_bit_cast(unsigned, f); return (u + 0x7fffu + ((u >> 16) & 1u)) >> 16; }
__device__ __forceinline__ unsigned pk2(float lo, float hi) { return f2bf(lo) | (f2bf(hi) << 16); }

struct TItem { const float* W; int N; bf16_t* WT; int ldwt, koff; const float* gain; unsigned char* W8; int n8, item; };
__device__ __forceinline__ void titem_load(const TItem& t, float (&v)[32], int lane) {
    const int nblk = t.N / 32, kb = t.item / nblk, nb = t.item % nblk, k0 = 64 * kb, n0 = 32 * nb;
    const GAS float* wp = (const GAS float*)t.W + (size_t)(k0 + (lane >> 5)) * t.N + n0 + (lane & 31);
#pragma unroll
    for (int i = 0; i < 32; ++i) v[i] = wp[(size_t)(2 * i) * t.N];
}
__device__ __forceinline__ void titem_finish(const TItem& t, float (&v)[32], LAS float* scr, int lane) {
    const int N = t.N, item = t.item; const float* gain = t.gain; bf16_t* WT = t.WT; const int ldwt = t.ldwt, koff = t.koff; unsigned char* W8 = t.W8; const int n8 = t.n8;
    const int nblk = N / 32, kb = item / nblk, nb = item % nblk, k0 = 64 * kb, n0 = 32 * nb;
    if (gain) {
#pragma unroll
        for (int i = 0; i < 32; ++i) v[i] *= ((const GAS float*)gain)[k0 + 2 * i + (lane >> 5)]; }
#pragma unroll
    for (int i = 0; i < 32; ++i) scr[(2 * i + (lane >> 5)) * 33 + (lane & 31)] = v[i];
    asm volatile("s_waitcnt lgkmcnt(0)" ::: "memory");
    const int c = lane & 7;
    if (W8 && n0 >= n8) {
#pragma unroll
        for (int j = 0; j < 4; ++j) { const int n = (lane >> 3) + 8 * j; const LAS float* s = scr + (8 * c) * 33 + n;
            u32x2 o; o.x = pk4_fp8(s[0 * 33] * W8_SCALE, s[1 * 33] * W8_SCALE, s[2 * 33] * W8_SCALE, s[3 * 33] * W8_SCALE); o.y = pk4_fp8(s[4 * 33] * W8_SCALE, s[5 * 33] * W8_SCALE, s[6 * 33] * W8_SCALE, s[7 * 33] * W8_SCALE);
            *(GAS u32x2*)(W8 + (size_t)(n0 - n8 + n) * DM + k0 + 8 * c) = o; }
    } else {
#pragma unroll
    for (int j = 0; j < 4; ++j) { const int n = (lane >> 3) + 8 * j; const LAS float* s = scr + (8 * c) * 33 + n;
        u32x4 o; o.x = pk2(s[0 * 33], s[1 * 33]); o.y = pk2(s[2 * 33], s[3 * 33]); o.z = pk2(s[4 * 33], s[5 * 33]); o.w = pk2(s[6 * 33], s[7 * 33]);
        *(GAS u32x4*)(WT + (size_t)(n0 + n) * ldwt + koff + k0 + 8 * c) = o; }
    }
    asm volatile("s_waitcnt lgkmcnt(0)" ::: "memory");
}
__device__ __forceinline__ void rms_row_to_bf16(const float* xrow, const float* gain, bf16_t* orow, int lane, unsigned char* o8row = nullptr) {
    const GAS f32x4* xr = (const GAS f32x4*)xrow + lane;
    f32x4 v[16]; float s = 0.f;
#pragma unroll
    for (int j = 0; j < 16; ++j) v[j] = xr[64 * j];
    f32x4 gv[16];
#pragma unroll
    for (int j = 0; j < 16; ++j) gv[j] = gain ? ((const GAS f32x4*)gain)[lane + 64 * j] : (f32x4){1.f, 1.f, 1.f, 1.f};
#pragma unroll
    for (int j = 0; j < 16; ++j) s += (v[j].x * v[j].x + v[j].y * v[j].y) + (v[j].z * v[j].z + v[j].w * v[j].w);
    const float r = 1.0f / sqrtf(wave_sum(s, lane) * (1.0f / DM) + RMS_EPS);
    GAS u32x2* o8 = (GAS u32x2*)orow + lane;
#pragma unroll
    for (int j = 0; j < 16; ++j) { const f32x4 g = gv[j];
        const float y0 = v[j].x * r * g.x, y1 = v[j].y * r * g.y, y2 = v[j].z * r * g.z, y3 = v[j].w * r * g.w;
        u32x2 w; w.x = cvt_pk_bf16(y0, y1); w.y = cvt_pk_bf16(y2, y3); o8[64 * j] = w;
        if (o8row) ((GAS unsigned*)o8row)[lane + 64 * j] = pk4_fp8(y0 * H8_SCALE, y1 * H8_SCALE, y2 * H8_SCALE, y3 * H8_SCALE); }
}

__device__ __forceinline__ int t5_bucket(int rel) {
    const int n = rel < 0 ? -rel : rel;
    const int b = n < 8 ? n : 8 + (n >= 12) + (n >= 16) + (n >= 23) + (n >= 32) + (n >= 46) + (n >= 64) + (n >= 91);
    return b + (rel > 0 ? 16 : 0);
}

struct Args { const float* in[16]; float* out; unsigned char* ws; int ph_lo, ph_hi, probe_phase, probe_reps; };
struct Frame {
    LAS unsigned char* lds;
    int tid, lane, wave, vcu, G;
    const float *xp, *xs, *memp, *mems, *pre_norm, *post_norm, *mem_norm, *w_in, *w_kv, *w_a, *w_b, *w_m, *w_out, *rpb, *sink, *t5;
    float* out;
    bf16_t *WinT, *WkvT, *WcatT, *WoutT, *H, *X, *P, *MEMH, *KVM; float* RSQ; unsigned char *H8, *W8, *ws;
};
__device__ __forceinline__ void make_frame(Frame& F, LAS unsigned char* lds, int wave_s) {
    const Args* ka = (const Args*)__builtin_amdgcn_kernarg_segment_ptr(); asm volatile("" : "+s"(ka));
    const int lane = lane_id_hw();
    F.lds = lds; F.lane = lane; F.wave = wave_s; F.tid = wave_s * 64 + lane;
    F.G = gridDim.x; { const int bx = blockIdx.x; F.vcu = (F.G % 8 == 0) ? (bx % 8) * (F.G / 8) + bx / 8 : bx; }
    F.xp = ka->in[0]; F.xs = ka->in[1]; F.memp = ka->in[2]; F.mems = ka->in[3]; F.pre_norm = ka->in[4]; F.post_norm = ka->in[5]; F.mem_norm = ka->in[6];
    F.w_in = ka->in[7]; F.w_kv = ka->in[8]; F.w_a = ka->in[9]; F.w_b = ka->in[10]; F.w_m = ka->in[11]; F.w_out = ka->in[12]; F.rpb = ka->in[13]; F.sink = ka->in[14]; F.t5 = ka->in[15];
    F.out = ka->out; unsigned char* ws = ka->ws; F.ws = ws;
    F.WinT = (bf16_t*)(ws + WS_WIN); F.WkvT = (bf16_t*)(ws + WS_WKV); F.WcatT = (bf16_t*)(ws + WS_WCAT); F.WoutT = (bf16_t*)(ws + WS_WOUT);
    F.H = (bf16_t*)(ws + WS_H); F.X = (bf16_t*)(ws + WS_X); F.P = (bf16_t*)(ws + WS_P); F.MEMH = (bf16_t*)(ws + WS_MEMH); F.KVM = (bf16_t*)(ws + WS_KVM); F.RSQ = (float*)(ws + WS_RSQ); F.H8 = ws + WS_H8; F.W8 = ws + WS_W8;
}

__device__ __forceinline__ void naive_attention(Frame& F, int l) {
    const int gw = F.vcu * NWAVES + F.wave, NGW = F.G * NWAVES, lane = F.lane;
    const bf16_t* P = F.P; bf16_t* X = F.X;
    if (!FLASH_NA) for (int it = gw; it < NSEQ * 12 * SEQ; it += NGW) {
        const int p = it % SEQ, h = (it / SEQ) % 12, b = it / (SEQ * 12);
        const int r = p >> 6, c = p & 63; int rs = r - 4; rs = rs < 0 ? 0 : (rs > 24 ? 24 : rs); int cs = c - 8; cs = cs < 0 ? 0 : (cs > 48 ? 48 : cs);
        const size_t row = (size_t)b * SEQ + p;
        const unsigned qw = *(const unsigned*)(P + row * INW + QA + h * 128 + 2 * lane); const float q0 = bf_lo(qw), q1 = bf_hi(qw);
        const float* rp = F.rpb + (size_t)(l * 12 + h) * 15 * 31;
        float m = -1e30f, ls = 0.f, o0 = 0.f, o1 = 0.f;
        for (int kr = rs; kr < rs + 8; ++kr)
#pragma unroll 4
          for (int kc = cs; kc < cs + 16; ++kc) {
            const size_t krow = (size_t)b * SEQ + kr * 64 + kc;
            const unsigned kw = *(const unsigned*)(P + krow * INW + KA + h * 128 + 2 * lane), vw = *(const unsigned*)(P + krow * INW + VA + h * 128 + 2 * lane);
            const float s = wave_sum(q0 * bf_lo(kw) + q1 * bf_hi(kw), lane) * 0.08838834764831845f + rp[(kr - r + 7) * 31 + (kc - c + 15)];
            const float mn = fmaxf(m, s), a = __expf(m - mn), pe = __expf(s - mn);
            ls = ls * a + pe; o0 = o0 * a + pe * bf_lo(vw); o1 = o1 * a + pe * bf_hi(vw); m = mn;
        }
        const unsigned zw = *(const unsigned*)(P + row * INW + ZA + h * 128 + 2 * lane); const float inv = 1.0f / ls;
        *(unsigned*)(X + row * DM + h * 128 + 2 * lane) = cvt_pk_bf16(o0 * inv * bf_lo(zw), o1 * inv * bf_hi(zw));
    }
    if (!FLASH_SW) for (int it = gw; it < NSEQ * 12 * SEQ; it += NGW) {
        const int p = it % SEQ, h = (it / SEQ) % 12, b = it / (SEQ * 12), kvh = h / 3;
        const size_t row = (size_t)b * SEQ + p;
        const unsigned qw = *(const unsigned*)(P + row * INW + QB + h * 128 + 2 * lane); const float q0 = bf_lo(qw), q1 = bf_hi(qw);
        float m = F.sink[l * 12 + h], ls = 1.f, o0 = 0.f, o1 = 0.f;
        const int j0 = p - 128 < 0 ? 0 : p - 128, j1 = p + 128 > SEQ - 1 ? SEQ - 1 : p + 128;
#pragma unroll 4
        for (int j = j0; j <= j1; ++j) {
            const size_t krow = (size_t)b * SEQ + j;
            const unsigned kw = *(const unsigned*)(P + krow * INW + KB + kvh * 128 + 2 * lane), vw = *(const unsigned*)(P + krow * INW + VB + kvh * 128 + 2 * lane);
            const float s = wave_sum(q0 * bf_lo(kw) + q1 * bf_hi(kw), lane) * 0.08838834764831845f + F.t5[t5_bucket(j - p) * 12 + h];
            const float mn = fmaxf(m, s), a = __expf(m - mn), pe = __expf(s - mn);
            ls = ls * a + pe; o0 = o0 * a + pe * bf_lo(vw); o1 = o1 * a + pe * bf_hi(vw); m = mn;
        }
        const unsigned zw = *(const unsigned*)(P + row * INW + ZB + h * 128 + 2 * lane); const float inv = 1.0f / ls;
        *(unsigned*)(X + row * DM + 1536 + h * 128 + 2 * lane) = cvt_pk_bf16(o0 * inv * bf_lo(zw), o1 * inv * bf_hi(zw));
    }
    const bf16_t* KV = F.KVM + (size_t)l * MROWS * KVW;
    if (!FLASH_MEM) for (int it = gw; it < NSEQ * 4 * SEQ; it += NGW) {
        const int p = it % SEQ, h = (it / SEQ) % 4, b = it / (SEQ * 4);
        const size_t row = (size_t)b * SEQ + p;
        const u32x2 qw = *(const u32x2*)(P + row * INW + QM + h * 256 + 4 * lane); const float q0 = bf_lo(qw.x), q1 = bf_hi(qw.x), q2 = bf_lo(qw.y), q3 = bf_hi(qw.y);
        float m = -1e30f, ls = 0.f, o0 = 0.f, o1 = 0.f, o2 = 0.f, o3 = 0.f;
#pragma unroll 4
        for (int j = 0; j < MEMT; ++j) {
            const size_t krow = (size_t)b * MEMT + j;
            const u32x2 kw = *(const u32x2*)(KV + krow * KVW + h * 256 + 4 * lane), vw = *(const u32x2*)(KV + krow * KVW + 1024 + h * 256 + 4 * lane);
            const float s = wave_sum((q0 * bf_lo(kw.x) + q1 * bf_hi(kw.x)) + (q2 * bf_lo(kw.y) + q3 * bf_hi(kw.y)), lane) * 0.0625f;
            const float mn = fmaxf(m, s), a = __expf(m - mn), pe = __expf(s - mn);
            ls = ls * a + pe; o0 = o0 * a + pe * bf_lo(vw.x); o1 = o1 * a + pe * bf_hi(vw.x); o2 = o2 * a + pe * bf_lo(vw.y); o3 = o3 * a + pe * bf_hi(vw.y); m = mn;
        }
        const u32x2 zw = *(const u32x2*)(P + row * INW + ZM + h * 256 + 4 * lane); const float inv = 1.0f / ls;
        u32x2 w; w.x = cvt_pk_bf16(o0 * inv * bf_lo(zw.x), o1 * inv * bf_hi(zw.x)); w.y = cvt_pk_bf16(o2 * inv * bf_lo(zw.y), o3 * inv * bf_hi(zw.y));
        *(u32x2*)(X + row * DM + 3072 + h * 256 + 4 * lane) = w;
    }
}


namespace fa {
typedef float f32x16 __attribute__((ext_vector_type(16)));
typedef short s16x4 __attribute__((ext_vector_type(4)));
constexpr int SHM_V = 16384, SHM_K = 16384;
constexpr int OFF_V = 0, OFF_K = 32768, OFF_OST = 65536  , OFF_WS = RING_BYTES + 2048, OFF_TBL = RING_BYTES + 4096, TBL_PAD = 256;
constexpr int OFF_WS_MEM = RING_BYTES + 1024, OFF_OST_MEM = RING_BYTES + 16384;
constexpr float THR2 = 11.5f;
constexpr float NEG = -1e30f;
#define FA_KSWZ(row, colB) ((row) * 256 + ((colB) ^ (((row) & 7) << 4)))
#define FA_SBAR() __builtin_amdgcn_sched_barrier(0)
__device__ __forceinline__ int crow(int r, int hi) { return (r & 3) + 8 * (r >> 2) + 4 * hi; }
__device__ __forceinline__ int v_st(int k, int c) { const int kk = (k & ~0xC) | ((k & 4) << 1) | ((k & 8) >> 1); return ((kk >> 3) * 4 + (c >> 5)) * 512 + ((kk & 7) * 32 + (c & 31)) * 2; }
__device__ __forceinline__ int v_rd_base(int lane) { return ((lane & 3) << 3) | (((lane >> 2) & 3) << 6) | (((lane >> 4) & 1) << 5) | (((lane >> 5) & 1) << 8); }
constexpr int v_rd_off(int d0, int ks, int half) { return d0 * 512 + ks * 4096 + half * 2048; }
template <int OFF> __device__ __forceinline__ s16x4 tr_read(int vb) { s16x4 r; asm volatile("ds_read_b64_tr_b16 %0, %1 offset:%2" : "=&v"(r) : "v"(vb), "i"(OFF) : "memory"); return r; }
template <int D0> __device__ __forceinline__ void pv_one(f32x16& od, int vb, bf16x8 pa0, bf16x8 pa1, bf16x8 pa2, bf16x8 pa3) {
    const s16x4 l0 = tr_read<v_rd_off(D0, 0, 0)>(vb), h0 = tr_read<v_rd_off(D0, 0, 1)>(vb), l1 = tr_read<v_rd_off(D0, 1, 0)>(vb), h1 = tr_read<v_rd_off(D0, 1, 1)>(vb);
    const s16x4 l2 = tr_read<v_rd_off(D0, 2, 0)>(vb), h2 = tr_read<v_rd_off(D0, 2, 1)>(vb), l3 = tr_read<v_rd_off(D0, 3, 0)>(vb), h3 = tr_read<v_rd_off(D0, 3, 1)>(vb);
    asm volatile("s_waitcnt lgkmcnt(0)" ::: "memory"); FA_SBAR();
#define FA_PK(L, H) (bf16x8){L[0], L[1], L[2], L[3], H[0], H[1], H[2], H[3]}
    od = __builtin_amdgcn_mfma_f32_32x32x16_bf16(pa0, FA_PK(l0, h0), od, 0, 0, 0);
    od = __builtin_amdgcn_mfma_f32_32x32x16_bf16(pa1, FA_PK(l1, h1), od, 0, 0, 0);
    od = __builtin_amdgcn_mfma_f32_32x32x16_bf16(pa2, FA_PK(l2, h2), od, 0, 0, 0);
    od = __builtin_amdgcn_mfma_f32_32x32x16_bf16(pa3, FA_PK(l3, h3), od, 0, 0, 0);
#undef FA_PK
}
__device__ __forceinline__ void pv_d0(f32x16* o, int vb, bf16x8 pa0, bf16x8 pa1, bf16x8 pa2, bf16x8 pa3) {
    pv_one<0>(o[0], vb, pa0, pa1, pa2, pa3); pv_one<1>(o[1], vb, pa0, pa1, pa2, pa3); pv_one<2>(o[2], vb, pa0, pa1, pa2, pa3); pv_one<3>(o[3], vb, pa0, pa1, pa2, pa3);
}
template <int P1T> __device__ __forceinline__ void qkt(f32x16& p0, f32x16& p1, const LAS unsigned char* Ks, const bf16x8* qr, int r32, int hi, const LAS float* tb) {
#pragma unroll
    for (int r = 0; r < 16; ++r) { const int k0 = (r & 3) + 8 * (r >> 2); p0[r] = tb[k0]; p1[r] = tb[P1T + k0]; }
#ifndef FA_KBATCH
#define FA_KBATCH 2
#endif
#pragma unroll
    for (int g = 0; g < 8 / FA_KBATCH; ++g) { bf16x8 kf0[FA_KBATCH], kf1[FA_KBATCH];
#pragma unroll
        for (int d = 0; d < FA_KBATCH; ++d) { const int cb = ((g * FA_KBATCH + d) * 16 + hi * 8) * 2; kf0[d] = *(const LAS bf16x8*)(Ks + FA_KSWZ(r32, cb)); kf1[d] = *(const LAS bf16x8*)(Ks + FA_KSWZ(32 + r32, cb)); }
        FA_SBAR();
#pragma unroll
        for (int d = 0; d < FA_KBATCH; ++d) { p0 = __builtin_amdgcn_mfma_f32_32x32x16_bf16(kf0[d], qr[g * FA_KBATCH + d], p0, 0, 0, 0); p1 = __builtin_amdgcn_mfma_f32_32x32x16_bf16(kf1[d], qr[g * FA_KBATCH + d], p1, 0, 0, 0); }
        FA_SBAR(); }
}
template <int P1V> __device__ __forceinline__ void apply_bias(f32x16& p0, f32x16& p1, int vb, unsigned vl0, unsigned vl1, float C) {
#pragma unroll
    for (int r = 0; r < 16; ++r) { const int k0 = (r & 3) + 8 * (r >> 2);
        const float x0 = p0[r] * C, x1 = p1[r] * C;
        p0[r] = ((unsigned)(vb + k0) < vl0) ? x0 : NEG; p1[r] = ((unsigned)(vb + P1V + k0) < vl1) ? x1 : NEG; }
}
__device__ __forceinline__ void partialSM(f32x16& p0, f32x16& p1, float& m_reg, float& alpha) {
    float pmax = p0[0];
#pragma unroll
    for (int r = 1; r < 16; ++r) pmax = fmaxf(pmax, p0[r]);
#pragma unroll
    for (int r = 0; r < 16; ++r) pmax = fmaxf(pmax, p1[r]);
    { auto rr = __builtin_amdgcn_permlane32_swap(__float_as_uint(pmax), __float_as_uint(pmax), false, false); pmax = fmaxf(__uint_as_float(rr[0]), __uint_as_float(rr[1])); }
    if (__builtin_expect(__all(pmax - m_reg <= THR2), 1)) { alpha = 1.f; }
    else { const float mn = fmaxf(m_reg, pmax); alpha = __builtin_amdgcn_exp2f(m_reg - mn); m_reg = mn; }
#pragma unroll
    for (int r = 0; r < 16; ++r) { p0[r] = __builtin_amdgcn_exp2f(p0[r] - m_reg); p1[r] = p1[r] - m_reg; }
}
#define FA_PK4(P, BASE, OUT) do { const unsigned a0 = cvt_pk_bf16(P[BASE + 0], P[BASE + 1]), a1 = cvt_pk_bf16(P[BASE + 2], P[BASE + 3]);   \
    const unsigned b0 = cvt_pk_bf16(P[BASE + 4], P[BASE + 5]), b1 = cvt_pk_bf16(P[BASE + 6], P[BASE + 7]);                              \
    auto r0 = __builtin_amdgcn_permlane32_swap(a0, b0, false, false); auto r1 = __builtin_amdgcn_permlane32_swap(a1, b1, false, false); \
    u32x4 w = {r0[0], r1[0], r0[1], r1[1]}; OUT = __builtin_bit_cast(bf16x8, w); } while (0)
__device__ __forceinline__ void finishSM(f32x16& p0, f32x16& p1, float alpha, float& l_reg, bf16x8& pa0, bf16x8& pa1, bf16x8& pa2, bf16x8& pa3) {
#pragma unroll
    for (int r = 0; r < 16; ++r) p1[r] = __builtin_amdgcn_exp2f(p1[r]);
    float ps = 0.f;
#pragma unroll
    for (int r = 0; r < 16; ++r) ps += p0[r];
#pragma unroll
    for (int r = 0; r < 16; ++r) ps += p1[r];
    { auto rr = __builtin_amdgcn_permlane32_swap(__float_as_uint(ps), __float_as_uint(ps), false, false); ps = __uint_as_float(rr[0]) + __uint_as_float(rr[1]); }
    l_reg = l_reg * alpha + ps;
    FA_PK4(p0, 0, pa0); FA_PK4(p0, 8, pa1); FA_PK4(p1, 0, pa2); FA_PK4(p1, 8, pa3);
}

struct FlashUnit {
    const bf16_t *Q, *K, *V, *Z; bf16_t* O;
    int NT, jlo, jhi;
    int tblo;
    float tv; int tcnt;
    int rsl;
    int lane_off, jstride, vbase, vstride; unsigned vlim;
    float m_init, l_init, C;
};
template <bool NA2>
__device__ __forceinline__ void flash_unit(LAS unsigned char* lds, const FlashUnit& U, int tid) {
    const int wid = __builtin_amdgcn_readfirstlane(tid >> 6), lane = tid & 63, r32 = lane & 31, hi = lane >> 5;
    constexpr int EHI = NA2 ? 64 : 16, KROW1 = NA2 ? 64 : 32, KTILE = NA2 ? 128 : 64, P1T = NA2 ? 31 : 32, P1V = NA2 ? 0 : 32;
    constexpr int KP = GATES_FP8 ? 128 : INW;
    const int ebase = NA2 ? wid * 128 : wid * 32;
    LAS unsigned char* V_lds = lds + OFF_V; LAS unsigned char* K_lds = lds + OFF_K;
    LAS float* wsx = (LAS float*)(lds + OFF_WS) + wid * 64; LAS float* li_l = wsx; LAS float* al_l = wsx + 32;
    const LAS float* tbl = (const LAS float*)(lds + U.tblo) + TBL_PAD + U.lane_off;
    float m_reg = U.m_init, l_reg = U.l_init; f32x16 o[4] = {}; bf16x8 qr[8];
    { const GAS char* Qw = (const GAS char*)U.Q; const unsigned qo = (unsigned)((ebase + (r32 & 15) + (r32 >> 4) * EHI) * INW + hi * 8) * 2u;
#pragma unroll
      for (int d0 = 0; d0 < 8; ++d0) qr[d0] = *(const GAS bf16x8*)(Qw + qo + d0 * 32); }
    const int sr = tid >> 4, sc = (tid & 15) * 8, vst0 = v_st(sr, sc), vst1 = v_st(32 + sr, sc), kst0 = FA_KSWZ(sr, sc * 2), kst1 = FA_KSWZ(32 + sr, sc * 2);
    const int vb0 = (int)(unsigned)(size_t)V_lds + v_rd_base(lane);
    const unsigned go0 = (unsigned)(sr * KP + sc) * 2u, go1 = (unsigned)((KROW1 + sr) * KP + sc) * 2u;
    constexpr size_t TILE_B = (size_t)KTILE * KP * 2;
    bf16x8 sv0[2], sv1[2], sk0[2], sk1[2];
#define FA_SLOAD(i, j) do { const GAS char* kt = (const GAS char*)U.K + (size_t)(j) * TILE_B; const GAS char* vt = (const GAS char*)U.V + (size_t)(j) * TILE_B; \
    sv0[i] = *(const GAS bf16x8*)(vt + go0); sv1[i] = *(const GAS bf16x8*)(vt + go1); sk0[i] = *(const GAS bf16x8*)(kt + go0); sk1[i] = *(const GAS bf16x8*)(kt + go1); } while (0)
#define FA_SWRITE(b, i) do { *(LAS bf16x8*)(V_lds + (b) * SHM_V + vst0) = sv0[i]; *(LAS bf16x8*)(V_lds + (b) * SHM_V + vst1) = sv1[i]; \
    *(LAS bf16x8*)(K_lds + (b) * SHM_K + kst0) = sk0[i]; *(LAS bf16x8*)(K_lds + (b) * SHM_K + kst1) = sk1[i]; } while (0)
    const int NT = U.NT;
    FA_SLOAD(0, 0); if (1 < NT) FA_SLOAD(1, 1);
    __builtin_amdgcn_sched_barrier(0);
    if (tid < U.tcnt) ((LAS float*)(lds + U.tblo))[TBL_PAD + tid] = U.tv * 11.313708498984761f;
#define FA_TILE(j, BUF) do { \
    FA_SWRITE(BUF, BUF); __syncthreads(); \
    if ((j) + 2 < NT) FA_SLOAD(BUF, (j) + 2); \
    if ((j) >= U.jlo && (j) < U.jhi) { f32x16 p0, p1; float alpha; bf16x8 pa0, pa1, pa2, pa3; \
        qkt<P1T>(p0, p1, K_lds + (BUF) * SHM_K, qr, r32, hi, tbl + (j) * U.jstride); \
        unsigned vl0 = U.vlim, vl1 = U.vlim; if constexpr (NA2) { vl0 = ((unsigned)(2 * (j) - U.rsl) < 8u) ? 16u : 0u; vl1 = ((unsigned)(2 * (j) + 1 - U.rsl) < 8u) ? 16u : 0u; } \
        apply_bias<P1V>(p0, p1, U.vbase + (j) * U.vstride, vl0, vl1, U.C); \
        partialSM(p0, p1, m_reg, alpha); finishSM(p0, p1, alpha, l_reg, pa0, pa1, pa2, pa3); \
        if (__any(alpha < 1.f)) { if (hi == 0) al_l[r32] = alpha; asm volatile("s_waitcnt lgkmcnt(0)" ::: "memory"); \
            _Pragma("unroll") for (int d = 0; d < 4; ++d) _Pragma("unroll") for (int r = 0; r < 16; ++r) o[d][r] *= al_l[crow(r, hi)]; } \
        pv_d0(o, vb0 + (BUF) * SHM_V, pa0, pa1, pa2, pa3); } } while (0)
    int j = 0;
    for (; j + 1 < NT; j += 2) { FA_TILE(j, 0); FA_TILE(j + 1, 1); }
    if (j < NT) FA_TILE(j, 0);
    { const GAS bf16_t* zb = (const GAS bf16_t*)U.Z + (size_t)ebase * INW; GAS bf16_t* ob = (GAS bf16_t*)U.O + (size_t)ebase * DM;
      int ln2 = lane; asm volatile("" : "+v"(ln2));
      u32x4 zv[8];
#pragma unroll
      for (int k = 0; k < 8; ++k) { const int ch = ln2 + 64 * k, row = ch >> 4, c16 = ch & 15, grow = (row & 15) + (row >> 4) * EHI; zv[k] = *(const GAS u32x4*)(zb + (size_t)grow * INW + c16 * 8); }
      if (hi == 0) li_l[r32] = l_reg; asm volatile("s_waitcnt lgkmcnt(0)" ::: "memory");
      LAS unsigned char* stg = lds + OFF_OST + wid * 8192;
#pragma unroll
      for (int r = 0; r < 16; ++r) { const int lr = crow(r, hi); const float rl = __builtin_amdgcn_rcpf(li_l[lr]);
#pragma unroll
          for (int d0 = 0; d0 < 4; ++d0) *(LAS bf16_t*)(stg + lr * 256 + (d0 * 32 + r32) * 2) = (bf16_t)f2bf(o[d0][r] * rl); }
      asm volatile("s_waitcnt lgkmcnt(0)" ::: "memory"); __builtin_amdgcn_sched_barrier(0);
#pragma unroll
      for (int k = 0; k < 8; ++k) { const int ch = ln2 + 64 * k, row = ch >> 4, c16 = ch & 15, grow = (row & 15) + (row >> 4) * EHI; const u32x4 ov = *(const LAS u32x4*)(stg + row * 256 + c16 * 16); const u32x4 z = zv[k];
          u32x4 w; w.x = cvt_pk_bf16(bf_lo(ov.x) * bf_lo(z.x), bf_hi(ov.x) * bf_hi(z.x)); w.y = cvt_pk_bf16(bf_lo(ov.y) * bf_lo(z.y), bf_hi(ov.y) * bf_hi(z.y));
          w.z = cvt_pk_bf16(bf_lo(ov.z) * bf_lo(z.z), bf_hi(ov.z) * bf_hi(z.z)); w.w = cvt_pk_bf16(bf_lo(ov.w) * bf_lo(z.w), bf_hi(ov.w) * bf_hi(z.w));
          *(GAS u32x4*)(ob + (size_t)grow * DM + c16 * 8) = w; } }
#undef FA_SLOAD
#undef FA_SWRITE
#undef FA_TILE
}

__device__ __forceinline__ void mem_unit(LAS unsigned char* lds, const bf16_t* Qb, const bf16_t* KVg, const bf16_t* Zb, bf16_t* Ob, int tid) {
    const int wid = __builtin_amdgcn_readfirstlane(tid >> 6), lane = tid & 63, r32 = lane & 31, hi = lane >> 5;
    bf16x8 kv[16];
#pragma unroll
    for (int i = 0; i < 16; ++i) { const int ch = i * 512 + tid, key = ch >> 5, c16 = ch & 31; kv[i] = *(const GAS bf16x8*)((const GAS bf16_t*)KVg + (size_t)key * KVW + c16 * 8); }
    __syncthreads();
#pragma unroll
    for (int i = 0; i < 16; ++i) { const int ch = i * 512 + tid, key = ch >> 5, c16 = ch & 31; *(LAS bf16x8*)(lds + key * 512 + ((c16 * 16) ^ ((key & 7) << 4))) = kv[i]; }
    __syncthreads();
    f32x16 p[8];
#pragma unroll
    for (int kb = 0; kb < 8; ++kb) p[kb] = (f32x16){};
    const GAS bf16_t* Qw = (const GAS bf16_t*)Qb + (size_t)(wid * 32 + r32) * INW + hi * 8;
#pragma unroll
    for (int d0 = 0; d0 < 16; ++d0) { const bf16x8 qf = *(const GAS bf16x8*)(Qw + d0 * 16); const int cb = (d0 * 32 + hi * 16) ^ ((r32 & 7) << 4);
#pragma unroll
        for (int kb = 0; kb < 8; ++kb) { const bf16x8 kf = *(const LAS bf16x8*)(lds + (kb * 32 + r32) * 512 + cb); p[kb] = __builtin_amdgcn_mfma_f32_32x32x16_bf16(kf, qf, p[kb], 0, 0, 0); } }
#pragma unroll
    for (int i = 0; i < 16; ++i) { const int ch = i * 512 + tid, key = ch >> 5, c16 = ch & 31; kv[i] = *(const GAS bf16x8*)((const GAS bf16_t*)KVg + (size_t)key * KVW + 1024 + c16 * 8); }
    constexpr float C2 = 0.0625f * LOG2E;
    float mx = p[0][0];
#pragma unroll
    for (int kb = 0; kb < 8; ++kb)
#pragma unroll
        for (int r = 0; r < 16; ++r) mx = fmaxf(mx, p[kb][r]);
    { auto rr = __builtin_amdgcn_permlane32_swap(__float_as_uint(mx), __float_as_uint(mx), false, false); mx = fmaxf(__uint_as_float(rr[0]), __uint_as_float(rr[1])); }
    const float mc = -mx * C2; float ls = 0.f;
#pragma unroll
    for (int kb = 0; kb < 8; ++kb)
#pragma unroll
        for (int r = 0; r < 16; ++r) { const float e = __builtin_amdgcn_exp2f(fmaf(p[kb][r], C2, mc)); p[kb][r] = e; ls += e; }
    { auto rr = __builtin_amdgcn_permlane32_swap(__float_as_uint(ls), __float_as_uint(ls), false, false); ls = __uint_as_float(rr[0]) + __uint_as_float(rr[1]); }
    bf16x8 pa[4][4];
#pragma unroll
    for (int g = 0; g < 4; ++g) { FA_PK4(p[2 * g], 0, pa[g][0]); FA_PK4(p[2 * g], 8, pa[g][1]); FA_PK4(p[2 * g + 1], 0, pa[g][2]); FA_PK4(p[2 * g + 1], 8, pa[g][3]); }
    __syncthreads();
#pragma unroll
    for (int i = 0; i < 16; ++i) { const int ch = i * 512 + tid, key = ch >> 5, c16 = ch & 31, d = c16 * 8;
        *(LAS bf16x8*)(lds + ((key >> 6) * 2 + (d >> 7)) * 16384 + v_st(key & 63, d & 127)) = kv[i]; }
    __syncthreads();
    const int vb0 = (int)(unsigned)(size_t)lds + v_rd_base(lane);
    LAS float* li_l = (LAS float*)(lds + OFF_WS_MEM) + wid * 32;
    if (hi == 0) li_l[r32] = ls; asm volatile("s_waitcnt lgkmcnt(0)" ::: "memory");
    LAS unsigned char* stg = lds + OFF_OST_MEM + wid * 2048;
#pragma unroll
    for (int dh = 0; dh < 2; ++dh) {
        int ln2 = lane; asm volatile("" : "+v"(ln2));
        const GAS bf16_t* zb = (const GAS bf16_t*)Zb + (size_t)(wid * 32) * INW + dh * 128; GAS bf16_t* ob = (GAS bf16_t*)Ob + (size_t)(wid * 32) * DM + dh * 128;
        u32x4 zv[8];
#pragma unroll
        for (int k = 0; k < 8; ++k) { const int ch = ln2 + 64 * k, row = ch >> 4, c16 = ch & 15; zv[k] = *(const GAS u32x4*)(zb + (size_t)row * INW + c16 * 8); }
        f32x16 o[4] = {};
#pragma unroll
        for (int g = 0; g < 4; ++g) pv_d0(o, vb0 + (g * 2 + dh) * 16384, pa[g][0], pa[g][1], pa[g][2], pa[g][3]);
#pragma unroll
        for (int p = 0; p < 4; ++p) {
#pragma unroll
            for (int q = 0; q < 4; ++q) { const int r = 4 * p + q, lr8 = q + 4 * hi; const float rl = __builtin_amdgcn_rcpf(li_l[8 * p + lr8]);
#pragma unroll
                for (int d0 = 0; d0 < 4; ++d0) *(LAS bf16_t*)(stg + lr8 * 256 + (d0 * 32 + r32) * 2) = (bf16_t)f2bf(o[d0][r] * rl); }
            asm volatile("s_waitcnt lgkmcnt(0)" ::: "memory");
#pragma unroll
            for (int k = 0; k < 2; ++k) { const int ch = ln2 + 64 * k, row8 = ch >> 4, c16 = ch & 15; const u32x4 ov = *(const LAS u32x4*)(stg + row8 * 256 + c16 * 16); const u32x4 z = zv[2 * p + k];
                u32x4 w; w.x = cvt_pk_bf16(bf_lo(ov.x) * bf_lo(z.x), bf_hi(ov.x) * bf_hi(z.x)); w.y = cvt_pk_bf16(bf_lo(ov.y) * bf_lo(z.y), bf_hi(ov.y) * bf_hi(z.y));
                w.z = cvt_pk_bf16(bf_lo(ov.z) * bf_lo(z.z), bf_hi(ov.z) * bf_hi(z.z)); w.w = cvt_pk_bf16(bf_lo(ov.w) * bf_lo(z.w), bf_hi(ov.w) * bf_hi(z.w));
                *(GAS u32x4*)(ob + (size_t)(8 * p + row8) * DM + c16 * 8) = w; }
            asm volatile("s_waitcnt lgkmcnt(0)" ::: "memory");
        }
    }
}
}

#ifndef FLASH_NA
#define FLASH_NA 1
#endif
#ifndef FLASH_SW
#define FLASH_SW 1
#endif
#ifndef FLASH_MEM
#define FLASH_MEM 1
#endif
__device__ __forceinline__ void attention_phase(Frame& F, int l, int mask = 7) {
    LAS unsigned char* lds = F.lds; const int tid = F.tid, G = F.G;
    int tpar = 0;
    const int wid = F.wave;
    if (FLASH_NA && (mask & 1)) for (int i = 0;; ++i) {
        const int u = i * G + F.vcu; if (u >= 1152) break;
        const int bh = u >> 3, blk = u & 7, b = bh / 12, h = bh % 12;
        const int ln = lane_id_hw(), r32 = ln & 31, hi = ln >> 5;
        fa::FlashUnit U; U.C = 0.08838834764831845f * LOG2E; U.tblo = fa::OFF_TBL + tpar * 4096; tpar ^= 1;
        const int rb = blk >> 2, cb = blk & 3, lo = rb ? 12 : 0; U.NT = 10;
        int c0 = 16 * cb - 8; c0 = c0 < 0 ? 0 : (c0 > 32 ? 32 : c0);
        const size_t tok0 = (size_t)b * SEQ + rb * 1024 + cb * 16;
        const int qr = 16 * rb + 2 * wid + (r32 >> 4), qc = 16 * cb + (r32 & 15);
        int rs = qr - 4; rs = rs < 0 ? 0 : (rs > 24 ? 24 : rs); int cs = qc - 8; cs = cs < 0 ? 0 : (cs > 48 ? 48 : cs);
        int rsA = 16 * rb + 2 * wid - 4; rsA = rsA < 0 ? 0 : (rsA > 24 ? 24 : rsA); int rsB = 16 * rb + 2 * wid - 3; rsB = rsB < 0 ? 0 : (rsB > 24 ? 24 : rsB);
        U.Q = F.P + tok0 * INW + QA + h * 128; if (GATES_FP8) { const size_t ko = ((size_t)(b * 12 + h) * SEQ + lo * 64 + c0) * 128; U.K = (const bf16_t*)(F.ws + WS_KNA) + ko; U.V = (const bf16_t*)(F.ws + WS_VNA) + ko; }
        else { U.K = F.P + ((size_t)b * SEQ + lo * 64 + c0) * INW + KA + h * 128; U.V = U.K + (VA - KA); } U.Z = F.P + tok0 * INW + ZA + h * 128; U.O = F.X + tok0 * DM + h * 128;
        U.jlo = (rsA - lo) >> 1; U.jhi = ((rsB + 7 - lo) >> 1) + 1; U.rsl = rs - lo;
        U.lane_off = (lo - qr + 7) * 31 + (c0 - qc + 15) + 4 * hi; U.jstride = 62; U.vbase = c0 - cs + 4 * hi; U.vstride = 0; U.vlim = 16u;
        U.m_init = -30000.f; U.l_init = 0.f;
        const float* rp = F.rpb + (size_t)(l * 12 + h) * 465;
        { const int k = wid * 64 + ln; U.tcnt = 465; U.tv = (k < 465) ? ((const GAS float*)rp)[k] : 0.f; }
        if (mask & 8) U.jhi = U.jlo;
        fa::flash_unit<true>(lds, U, wid * 64 + ln);
    }
    if (FLASH_SW && (mask & 2)) for (int i = 0;; ++i) {
        int u = i * G + F.vcu; if (u >= 1152) break;
        int bh, blk;
        if (u < 864) { bh = u / 6; blk = 1 + u % 6; } else { u -= 864; bh = u >> 1; blk = (u & 1) * 7; }
        const int b = bh / 12, h = bh % 12;
        const int ln = lane_id_hw(), r32 = ln & 31, hi = ln >> 5;
        fa::FlashUnit U; U.C = 0.08838834764831845f * LOG2E; U.tblo = fa::OFF_TBL + tpar * 4096; tpar ^= 1; const size_t row0 = (size_t)b * SEQ + blk * 256;
        const int t0 = 256 * blk, kt0 = (blk == 0) ? 0 : t0 - 128; U.NT = (blk == 0 || blk == 7) ? 6 : 8;
        const int tq = t0 + 32 * wid + r32;
        U.Q = F.P + row0 * INW + QB + h * 128; if (GATES_FP8) { const size_t ko = ((size_t)(b * 4 + h / 3) * SEQ + kt0) * 128; U.K = (const bf16_t*)(F.ws + WS_KSW) + ko; U.V = (const bf16_t*)(F.ws + WS_VSW) + ko; }
        else { U.K = F.P + ((size_t)b * SEQ + kt0) * INW + KB + (h / 3) * 128; U.V = U.K + (VB - KB); } U.Z = F.P + row0 * INW + ZB + h * 128; U.O = F.X + row0 * DM + 1536 + h * 128;
        const int a = t0 + 32 * wid - 128 - kt0, bnd = t0 + 32 * wid + 159 - kt0; U.jlo = a <= 0 ? 0 : (a >> 6); { const int jh = (bnd >> 6) + 1; U.jhi = jh < U.NT ? jh : U.NT; }
        U.lane_off = kt0 - tq + 128 + 4 * hi; U.jstride = 64; U.vbase = U.lane_off; U.vstride = 64; U.vlim = 257u;
        U.m_init = F.sink[l * 12 + h] * LOG2E; U.l_init = 1.f; U.rsl = 0;
        { const int k = wid * 64 + ln; U.tcnt = 257; U.tv = (k < 257) ? ((const GAS float*)F.t5)[t5_bucket(k - 128) * 12 + h] : 0.f; }
        if (mask & 8) U.jhi = U.jlo;
        fa::flash_unit<false>(lds, U, wid * 64 + ln);
    }
    __syncthreads();
#if FLASH_MEM
    const bf16_t* KV = F.KVM + (size_t)l * MROWS * KVW;
    if (mask & 4) for (int i = 0;; ++i) {
        const int u = i * G + (G - 1 - F.vcu); if (u >= 384) break;
        const int bh = u >> 3, qb = u & 7, b = bh >> 2, h = bh & 3; const size_t row0 = (size_t)b * SEQ + qb * 256;
        fa::mem_unit(lds, F.P + row0 * INW + QM + h * 256, KV + (size_t)b * MEMT * KVW + h * 256, F.P + row0 * INW + ZM + h * 256, F.X + row0 * DM + 3072 + h * 256, F.wave * 64 + lane_id_hw());
    }
    __syncthreads();
#endif
}

__device__ __forceinline__ const float* x_row(const Frame& F, int m) { return m < TP ? F.xp + (size_t)m * DM : F.xs + (size_t)(m - TP) * DM; }

__device__ __forceinline__ void p0_prologue(Frame& F) {
    LAS float* scr = (LAS float*)(F.lds + F.wave * 16384);
    const int gw = F.vcu * NWAVES + F.wave, NGW = F.G * NWAVES;
    constexpr int I_IN = (DM / 64) * (INW / 32), I_KV = (DM / 64) * (KVW / 32), I_A = (1536 / 64) * (DM / 32), I_M = (1024 / 64) * (DM / 32), I_O = (DM / 64) * (DM / 32);
    constexpr int PER_L = I_IN + I_KV + 2 * I_A + I_M + I_O;
    auto decode = [&](int it, TItem& t) {
        const int l = it / PER_L; int r = it - l * PER_L; t.gain = nullptr; t.W8 = nullptr; t.n8 = 0; t.koff = 0; t.ldwt = DM;
        if (r < I_IN) { t.W = F.w_in + (size_t)l * DM * INW; t.N = INW; t.WT = F.WinT + (size_t)l * INW * DM; t.W8 = GATES_FP8 ? F.W8 + (size_t)l * NGATE * DM : nullptr; t.n8 = GA; t.item = r; return; } r -= I_IN;
        if (r < I_KV) { t.W = F.w_kv + (size_t)l * DM * KVW; t.N = KVW; t.WT = F.WkvT + (size_t)l * KVW * DM; t.gain = F.mem_norm + l * DM; t.item = r; return; } r -= I_KV;
        bf16_t* wc = F.WcatT + (size_t)l * DM * DM; t.N = DM; t.WT = wc;
        if (r < I_A) { t.W = F.w_a + (size_t)l * 1536 * DM; t.item = r; return; } r -= I_A;
        if (r < I_A) { t.W = F.w_b + (size_t)l * 1536 * DM; t.koff = 1536; t.item = r; return; } r -= I_A;
        if (r < I_M) { t.W = F.w_m + (size_t)l * 1024 * DM; t.koff = 3072; t.item = r; return; } r -= I_M;
        t.W = F.w_out + (size_t)l * DM * DM; t.WT = F.WoutT + (size_t)l * DM * DM; t.item = r; };
    { constexpr int TOT = DEPTH * PER_L; int it = gw; TItem A, B; float va[32], vb[32];
      if (it < TOT) { decode(it, A); titem_load(A, va, F.lane);
        for (;;) {
            bool hn = it + NGW < TOT; if (hn) { decode(it + NGW, B); titem_load(B, vb, F.lane); }
            titem_finish(A, va, scr, F.lane); if (!hn) break; it += NGW;
            hn = it + NGW < TOT; if (hn) { decode(it + NGW, A); titem_load(A, va, F.lane); }
            titem_finish(B, vb, scr, F.lane); if (!hn) break; it += NGW; } } }
    for (int m = gw; m < T; m += NGW) rms_row_to_bf16(x_row(F, m), F.pre_norm, F.H + (size_t)m * DM, F.lane, GATES_FP8 ? F.H8 + (size_t)m * DM : nullptr);
    for (int m = gw; m < MROWS; m += NGW) rms_row_to_bf16(m < 4 * MEMT ? F.memp + (size_t)m * DM : F.mems + (size_t)(m - 4 * MEMT) * DM, nullptr, F.MEMH + (size_t)m * DM, F.lane);
}
__device__ __forceinline__ void pnl_load(const Frame& F, int m, int lane, u32x2 (&xw)[16], u32x2 (&ov)[16]) {
    const GAS u32x2* x1row = (const GAS u32x2*)(F.P + (size_t)m * INW + 18432) + lane; const GAS u32x2* orow = (const GAS u32x2*)(F.X + (size_t)m * DM) + lane;
#pragma unroll
    for (int j = 0; j < 16; ++j) { xw[j] = x1row[64 * j]; ov[j] = orow[64 * j]; }
}
__device__ __forceinline__ void pnl_finish(const Frame& F, int m, int lane, const u32x2 (&xw)[16], const u32x2 (&ov)[16], const f32x4 (&gv)[16]) {
    GAS f32x4* yo = (GAS f32x4*)(F.out + (size_t)m * DM) + lane;
    const float ss = wave_sum(F.RSQ[(size_t)m * 64 + lane], lane);
    const float r = 1.0f / sqrtf(ss * (1.0f / DM) + RMS_EPS);
#pragma unroll
    for (int j = 0; j < 16; ++j) { const u32x2 x = xw[j], ow = ov[j]; const f32x4 g = gv[j];
        f32x4 y; y.x = bf_lo(x.x) + bf_lo(ow.x) * r * g.x; y.y = bf_hi(x.x) + bf_hi(ow.x) * r * g.y; y.z = bf_lo(x.y) + bf_lo(ow.y) * r * g.z; y.w = bf_hi(x.y) + bf_hi(ow.y) * r * g.w;
        yo[64 * j] = y; }
}
__device__ __forceinline__ void post_norm_phase(Frame& F, int l) {
    const int gw = F.vcu * NWAVES + F.wave, NGW = F.G * NWAVES, lane = F.lane;
    const float* pg = F.post_norm + l * DM; const float* npre = (l + 1 < DEPTH) ? F.pre_norm + (l + 1) * DM : nullptr;
    if (l > 0 && !npre) {
        f32x4 gv[16]; u32x2 xa[16], oa[16], xb[16], ob[16];
#pragma unroll
        for (int j = 0; j < 16; ++j) gv[j] = ((const GAS f32x4*)pg)[lane + 64 * j];
        int m = gw; if (m >= T) return;
        pnl_load(F, m, lane, xa, oa);
        for (;;) {
            bool hn = m + NGW < T; if (hn) pnl_load(F, m + NGW, lane, xb, ob);
            pnl_finish(F, m, lane, xa, oa, gv); if (!hn) break; m += NGW;
            hn = m + NGW < T; if (hn) pnl_load(F, m + NGW, lane, xa, oa);
            pnl_finish(F, m, lane, xb, ob, gv); if (!hn) break; m += NGW; }
        return; }
    for (int m = gw; m < T; m += NGW) {
        const GAS u32x2* orow = (const GAS u32x2*)(F.X + (size_t)m * DM) + lane;
        GAS u32x2* x1row = (GAS u32x2*)(F.P + (size_t)m * INW + 18432) + lane;
        GAS f32x4* yo = (GAS f32x4*)(F.out + (size_t)m * DM) + lane;
        f32x4 v[16]; u32x2 ov[16]; float s2 = 0.f;
        if (l == 0) { const GAS f32x4* xr = (const GAS f32x4*)x_row(F, m) + lane;
#pragma unroll
            for (int j = 0; j < 16; ++j) { v[j] = xr[64 * j]; ov[j] = orow[64 * j]; } }
        else {
#pragma unroll
            for (int j = 0; j < 16; ++j) { const u32x2 xw = x1row[64 * j]; ov[j] = orow[64 * j]; v[j].x = bf_lo(xw.x); v[j].y = bf_hi(xw.x); v[j].z = bf_lo(xw.y); v[j].w = bf_hi(xw.y); } }
        f32x4 gv[16];
#pragma unroll
        for (int j = 0; j < 16; ++j) gv[j] = ((const GAS f32x4*)pg)[lane + 64 * j];
        __builtin_amdgcn_sched_barrier(0);
        const float ss = wave_sum(F.RSQ[(size_t)m * 64 + lane], lane);
        const float r = 1.0f / sqrtf(ss * (1.0f / DM) + RMS_EPS);
#pragma unroll
        for (int j = 0; j < 16; ++j) { const f32x4 x = v[j]; const u32x2 ow = ov[j]; const f32x4 g = gv[j];
            f32x4 y; y.x = x.x + bf_lo(ow.x) * r * g.x; y.y = x.y + bf_hi(ow.x) * r * g.y; y.z = x.z + bf_lo(ow.y) * r * g.z; y.w = x.w + bf_hi(ow.y) * r * g.w;
            v[j] = y; s2 += (y.x * y.x + y.y * y.y) + (y.z * y.z + y.w * y.w);
            if (npre) { u32x2 w; w.x = cvt_pk_bf16(y.x, y.y); w.y = cvt_pk_bf16(y.z, y.w); x1row[64 * j] = w; } else yo[64 * j] = y; }
        if (npre) {
#pragma unroll
            for (int j = 0; j < 16; ++j) gv[j] = ((const GAS f32x4*)npre)[lane + 64 * j];
            __builtin_amdgcn_sched_barrier(0);
            const float r2 = 1.0f / sqrtf(wave_sum(s2, lane) * (1.0f / DM) + RMS_EPS);
            GAS u32x2* h8 = (GAS u32x2*)(F.H + (size_t)m * DM) + lane;
#pragma unroll
            for (int j = 0; j < 16; ++j) { const f32x4 g = gv[j];
                const float y0 = v[j].x * r2 * g.x, y1 = v[j].y * r2 * g.y, y2 = v[j].z * r2 * g.z, y3 = v[j].w * r2 * g.w;
                u32x2 w; w.x = cvt_pk_bf16(y0, y1); w.y = cvt_pk_bf16(y2, y3); h8[64 * j] = w;
                if (GATES_FP8) ((GAS unsigned*)(F.H8 + (size_t)m * DM))[lane + 64 * j] = pk4_fp8(y0 * H8_SCALE, y1 * H8_SCALE, y2 * H8_SCALE, y3 * H8_SCALE); }
        }
    }
}

constexpr int N_PHASES = 1 + 5 * DEPTH;
__global__ void __launch_bounds__(NWAVES * 64, 2) fwd(Args args) {
    extern __shared__ __attribute__((aligned(16))) unsigned char lds_raw[];
    LAS unsigned char* lds = (LAS unsigned char*)lds_raw;
    const int wave_s = __builtin_amdgcn_readfirstlane((int)threadIdx.x >> 6);
    for (int u = wave_s * 64 + lane_id_hw(); u < (LDS_BYTES - LDSCTL_OFF) / 4; u += NWAVES * 64) ((LAS unsigned*)(lds + LDSCTL_OFF))[u] = 0u;
    __syncthreads();
    unsigned* const barw = (unsigned*)(args.ws + WS_CTL) + CW_BAR;
    XcdBarrier bar; bar.bar = barw; bar.x = 0; bar.st = nullptr;
    if (MK_ONE_LAUNCH) bar = xcd_barrier_post(barw, (volatile LAS unsigned*)(lds + MISC_OFF) + 8, wave_s == 0 && lane_id_hw() == 0);
    const int lo = args.ph_lo, hi = args.ph_hi;
#define IN(k) (lo <= (k) && (k) < hi)
#define SEAM(k) do { if (IN(k) && IN((k) + 1)) xcd_barrier(bar, wave_s == 0 && lane_id_hw() == 0); } while (0)

    const int probe_phase = args.probe_phase, n_iter = DEPTH + args.probe_reps;
    if (IN(0)) { Frame F; make_frame(F, lds, wave_s); p0_prologue(F); SEAM(0); }
    for (int it = 0; it < n_iter; ++it) {
        const bool probing = it >= DEPTH; const int l = probing ? ((it - DEPTH) & 1) : it;
        const int pb = 1 + 5 * l;
        if (probing && it == DEPTH) xcd_barrier(bar, wave_s == 0 && lane_id_hw() == 0);
#define RUN(k) (probing ? (probe_phase == (k)) : IN(pb + (k) - 1))
#define SEAM2(k) do { if (probing || (IN(pb + (k) - 1) && IN(pb + (k)))) xcd_barrier(bar, wave_s == 0 && lane_id_hw() == 0); } while (0)
        if (RUN(1)) {
            Frame F; make_frame(F, lds, wave_s);
            SchedIn S; S.G = F.G; S.c = (int)blockIdx.x; S.nextra = (l == 0) ? 2 * 96 : 0; S.A = (unsigned)WS_H; S.B = (unsigned)(WS_WIN + (size_t)l * INW * DM * 2);
            S.memA = (unsigned)WS_MEMH; S.memB0 = (unsigned)WS_WKV; S.memB1 = (unsigned)(WS_WKV + (size_t)KVW * DM * 2);
            EpiIn E{F.P, F.KVM, F.KVM + (size_t)MROWS * KVW, (bf16_t*)F.ws};
            pg8::gemm_phase<EpiIn, SchedIn>(lds, (const char*)F.ws, S, E, wave_s);
            SEAM2(1);
        }
        if (RUN(2)) { Frame F; make_frame(F, lds, wave_s); attention_phase(F, l); if (!(FLASH_NA && FLASH_SW && FLASH_MEM)) naive_attention(F, l); if (!GATES_FP8) SEAM2(2); }
        if (GATES_FP8 && RUN(2)) {
            Frame F; make_frame(F, lds, wave_s);
            SchedIn8 S8; S8.G = F.G; S8.c = (int)blockIdx.x; S8.A = (unsigned)WS_H8; S8.B = (unsigned)(WS_W8 + (size_t)l * NGATE * DM);
            EpiIn8 E8{F.P};
            pg8::gemm_phase<EpiIn8, SchedIn8, 4096, true>(lds, (const char*)F.ws, S8, E8, wave_s);
            SEAM2(2);
        }
        if (probing && probe_phase >= 6) { Frame F; make_frame(F, lds, wave_s); attention_phase(F, l, probe_phase == 6 ? 1 : probe_phase == 7 ? 2 : probe_phase == 8 ? 4 : probe_phase == 9 ? 9 : 10); xcd_barrier(bar, wave_s == 0 && lane_id_hw() == 0); }
        if (RUN(3)) {
            Frame F; make_frame(F, lds, wave_s);
            SchedBr S; S.G = F.G; S.c = (int)blockIdx.x; S.A = (unsigned)WS_X; S.B = (unsigned)(WS_WCAT + (size_t)l * DM * DM * 2);
            EpiBr E{F.P, F.H};
            pg8::gemm_phase<EpiBr, SchedBr>(lds, (const char*)F.ws, S, E, wave_s);
            SEAM2(3);
        }
        if (RUN(4)) {
            Frame F; make_frame(F, lds, wave_s);
            SchedOut S; S.G = F.G; S.c = (int)blockIdx.x; S.A = (unsigned)WS_H; S.B = (unsigned)(WS_WOUT + (size_t)l * DM * DM * 2);
            EpiOut E{F.X, F.RSQ};
            pg8::gemm_phase<EpiOut, SchedOut>(lds, (const char*)F.ws, S, E, wave_s);
            SEAM2(4);
        }
        if (RUN(5)) { Frame F; make_frame(F, lds, wave_s); if (probing) F.out = (float*)F.P; post_norm_phase(F, probing ? 0 : l); SEAM2(5); }
#undef RUN
#undef SEAM2
    }
#undef IN
#undef SEAM
}

extern "C" void kernel_launch(void* const* d_in, const int* in_sizes, int n_in, void* d_out, int out_size, void* d_ws, size_t ws_size, hipStream_t stream) {
    static int grid = 0;
    if (grid == 0) {
        if (n_in != 16 || in_sizes[0] != TP * DM || in_sizes[1] != (T - TP) * DM || out_size != T * DM || ws_size < WS_END) {
            fprintf(stderr, "kernel_launch: shape mismatch (n_in %d, in0 %d, in1 %d, out %d, ws %zu need %zu); nothing launched\n", n_in, n_in > 0 ? in_sizes[0] : -1, n_in > 1 ? in_sizes[1] : -1, out_size, ws_size, (size_t)WS_END); grid = -1; return; }
        int dev = 0, cus = 0, per_cu = 0;
        if (hipGetDevice(&dev) != hipSuccess || hipDeviceGetAttribute(&cus, hipDeviceAttributeMultiprocessorCount, dev) != hipSuccess) { grid = -1; return; }
        if (hipFuncSetAttribute((const void*)fwd, hipFuncAttributeMaxDynamicSharedMemorySize, LDS_BYTES) != hipSuccess) { fprintf(stderr, "kernel_launch: hipFuncSetAttribute failed\n"); grid = -1; return; }
        if (hipOccupancyMaxActiveBlocksPerMultiprocessor(&per_cu, (const void*)fwd, NWAVES * 64, LDS_BYTES) != hipSuccess || per_cu < 1)
            fprintf(stderr, "kernel_launch: note: occupancy query reports %d workgroups per CU\n", per_cu);
        (void)hipGetLastError();
        grid = cus;
    }
    if (grid < 0) return;
    if (hipMemsetAsync((char*)d_ws + WS_CTL, 0, CTL_ZERO_BYTES, stream) != hipSuccess) { fprintf(stderr, "kernel_launch: memset failed\n"); return; }
    Args a{};
    for (int i = 0; i < 16; ++i) a.in[i] = (const float*)d_in[i];
    a.out = (float*)d_out; a.ws = (unsigned char*)d_ws; a.probe_phase = PROBE_PHASE; a.probe_reps = PROBE_REPS;
#if MK_ONE_LAUNCH
    a.ph_lo = 0; a.ph_hi = N_PHASES;
    hipLaunchKernelGGL(fwd, dim3(grid), dim3(NWAVES * 64), LDS_BYTES, stream, a);
#else
    for (int p = 0; p < N_PHASES; ++p) { a.ph_lo = p; a.ph_hi = p + 1; hipLaunchKernelGGL(fwd, dim3(grid), dim3(NWAVES * 64), LDS_BYTES, stream, a); }
#endif
    const hipError_t le = hipPeekAtLastError();
    if (le != hipSuccess) fprintf(stderr, "kernel_launch: launch failed: %s\n", hipGetErrorName(le));
}
```

```cpp
#include <hip/hip_runtime.h>
#include <cstdio>
#include <cstdint>

#ifndef FLASH_NA
#define FLASH_NA 1
#endif
#ifndef FLASH_SW
#define FLASH_SW 1
#endif
#ifndef FLASH_MEM
#define FLASH_MEM 1
#endif
#ifndef PROBE_PHASE
#define PROBE_PHASE 0
#endif
#ifndef PROBE_REPS
#define PROBE_REPS 0
#endif
#ifndef GATE_U8
#define GATE_U8 1
#endif
#ifndef GATES_FP8
#define GATES_FP8 1
#endif
#ifndef WGM_IN
#define WGM_IN 4
#endif
#ifndef WGM_SM
#define WGM_SM 4
#endif
#ifndef MK_ONE_LAUNCH
#define MK_ONE_LAUNCH 1
#endif

#define LAS __attribute__((address_space(3)))
#define GAS __attribute__((address_space(1)))
typedef unsigned short bf16_t;
typedef short bf16x8 __attribute__((ext_vector_type(8)));
typedef float f32x4 __attribute__((ext_vector_type(4)));
typedef float f32x2 __attribute__((ext_vector_type(2)));
typedef unsigned u32x4 __attribute__((ext_vector_type(4)));
typedef unsigned u32x2 __attribute__((ext_vector_type(2)));

constexpr int DM = 4096, NSEQ = 12, SEQ = 2048, T = NSEQ * SEQ  , DEPTH = 2, TP = 4 * SEQ  ;
constexpr int INW = 24576;
constexpr int MEMT = 256, MROWS = NSEQ * MEMT;
constexpr int KVW = 2048;
constexpr int QA = 0, KA = 1536, VA = 3072, ZA = 4608, QB = 6144, KB = 7680, VB = 8192, ZB = 8704, QM = 10240, ZM = 11264, GA = 12288;
constexpr float RMS_EPS = 1e-6f;
constexpr float LOG2E = 1.4426950408889634f;

constexpr size_t MiB = 1u << 20;
constexpr size_t WS_CTL = 0, CTL_ZERO_BYTES = 64 * 1024;
constexpr size_t WS_WIN = 1 * MiB;
constexpr size_t WS_WKV = WS_WIN + 2 * 192 * MiB;
constexpr size_t WS_WCAT = WS_WKV + 2 * 16 * MiB;
constexpr size_t WS_WOUT = WS_WCAT + 2 * 32 * MiB;
constexpr size_t WS_H = WS_WOUT + 2 * 32 * MiB;
constexpr size_t WS_X = WS_H + 192 * MiB;
constexpr size_t WS_P = WS_X + 192 * MiB;
constexpr size_t WS_MEMH = WS_P + 1152 * MiB;
constexpr size_t WS_KVM = WS_MEMH + 24 * MiB;
constexpr size_t WS_RSQ = WS_KVM + 2 * 12 * MiB;
constexpr size_t WS_H8 = WS_RSQ + 6 * MiB;
constexpr size_t WS_W8 = WS_H8 + 96 * MiB;
constexpr size_t WS_END = WS_W8 + 2 * 48 * MiB;
constexpr size_t WS_KNA = WS_WIN + 96 * MiB, WS_KSW = WS_KNA + 72 * MiB;
constexpr size_t WS_VNA = WS_WIN + 192 * MiB + 96 * MiB, WS_VSW = WS_VNA + 72 * MiB;
constexpr float H8_SCALE = 8.f, W8_SCALE = 256.f, G8_DESCALE = 1.0f / (8.f * 256.f);
constexpr int NGATE = 3 * DM;
constexpr int CW_BAR = 4096;

constexpr int RING_BYTES = 131072;
constexpr int LDSCTL_OFF = RING_BYTES, MISC_OFF = LDSCTL_OFF + 320;
constexpr int LDS_BYTES = 163840;
constexpr int NWAVES = 8;

__device__ __forceinline__ int lane_id_hw() { int l; asm volatile("v_mbcnt_lo_u32_b32 %0, -1, 0\n\tv_mbcnt_hi_u32_b32 %0, -1, %0" : "=v"(l)); return l; }
typedef float f32x2_t_ __attribute__((ext_vector_type(2))); typedef __bf16 bf16x2_t_ __attribute__((ext_vector_type(2)));
__device__ __forceinline__ unsigned cvt_pk_bf16(float lo, float hi) { const f32x2_t_ v = {lo, hi}; const bf16x2_t_ b = __builtin_convertvector(v, bf16x2_t_); return __builtin_bit_cast(unsigned, b); }
__device__ __forceinline__ unsigned pk4_fp8(float a, float b, float c, float d) { int w = __builtin_amdgcn_cvt_pk_fp8_f32(a, b, 0, false); w = __builtin_amdgcn_cvt_pk_fp8_f32(c, d, w, true); return (unsigned)w; }
__device__ __forceinline__ float bf_lo(unsigned w) { return __uint_as_float(w << 16); }
__device__ __forceinline__ float bf_hi(unsigned w) { return __uint_as_float(w & 0xffff0000u); }
__device__ __forceinline__ float sigmoid_f(float x) { return __builtin_amdgcn_rcpf(1.0f + __builtin_amdgcn_exp2f(-x * LOG2E)); }
__device__ __forceinline__ unsigned gate_q8(float g) { return (unsigned)fmaxf(g * 255.0f + 0.5f, 1.0f); }
__device__ __forceinline__ unsigned gate_pk4(const f32x4& g) { return gate_q8(g[0]) | (gate_q8(g[1]) << 8) | (gate_q8(g[2]) << 16) | (gate_q8(g[3]) << 24); }
__device__ __forceinline__ float ub0(unsigned w) { return (float)(w & 0xffu); }
__device__ __forceinline__ float ub1(unsigned w) { return (float)((w >> 8) & 0xffu); }
__device__ __forceinline__ float ub2(unsigned w) { return (float)((w >> 16) & 0xffu); }
__device__ __forceinline__ float ub3(unsigned w) { return (float)(w >> 24); }
__device__ __forceinline__ void gate_ratio4(f32x4& v, unsigned n, unsigned d) {
    v[0] *= ub0(n) * __builtin_amdgcn_rcpf(ub0(d)); v[1] *= ub1(n) * __builtin_amdgcn_rcpf(ub1(d)); v[2] *= ub2(n) * __builtin_amdgcn_rcpf(ub2(d)); v[3] *= ub3(n) * __builtin_amdgcn_rcpf(ub3(d)); }
__device__ __forceinline__ void gate_mul4(f32x4& v, unsigned g) { const float s = 1.0f / 255.0f; v[0] *= ub0(g) * s; v[1] *= ub1(g) * s; v[2] *= ub2(g) * s; v[3] *= ub3(g) * s; }

namespace pg8 {
constexpr int BM = 256, BK = 64, HALF = 128, HTB = HALF * BK * 2, STAGE_BYTES = 8 * HTB, NXCD = 8, WGM = 8;
constexpr size_t KSTEP = (size_t)BK * 2;
constexpr size_t TSTEP16 = (size_t)256 * 4096 * 2, TSTEP8 = (size_t)256 * 4096;
typedef int i32x4 __attribute__((ext_vector_type(4)));
typedef int i32x8 __attribute__((ext_vector_type(8)));
__device__ __forceinline__ i32x8 cat8(bf16x8 lo, bf16x8 hi) { return __builtin_shufflevector(__builtin_bit_cast(i32x4, lo), __builtin_bit_cast(i32x4, hi), 0, 1, 2, 3, 4, 5, 6, 7); }
__host__ __device__ __forceinline__ int lds_byte(int r, int c) { const int st = (r >> 4) * 2 + (c >> 5), rr = r & 15, cc = c & 31, ob = rr * 64 + cc * 2; return st * 1024 + (ob ^ (((ob >> 9) & 1) << 5)); }
__host__ __device__ __forceinline__ void stage_rc(int b, int& R, int& C) { const int st = b / 1024, sb = b % 1024, swz = sb ^ (((sb >> 9) & 1) << 5); R = (st >> 1) * 16 + swz / 64; C = (st & 1) * 32 + (swz % 64) / 2; }
__host__ __device__ __forceinline__ int perm32(int rho) { const int n = rho >> 4, i = rho & 15; return 8 * (i >> 2) + 4 * n + (i & 3); }

struct GUnit { unsigned ao, bo; int nt, pm, pn, kind; };

template <int WGM_> __device__ __forceinline__ void tile_of(int L, int nM, int nN, int& pm, int& pn) {
    const int nwg = nM * nN; int wgid = L;
    { const int q = nwg / NXCD, r = nwg % NXCD, xcd = wgid % NXCD, off = wgid / NXCD; wgid = (xcd < r ? xcd * (q + 1) : r * (q + 1) + (xcd - r) * q) + off; }
    const int nig = WGM_ * nN, gid = wgid / nig, fm = gid * WGM_, gsz = (nM - fm) < WGM_ ? (nM - fm) : WGM_;
    pm = fm + ((wgid % nig) % gsz); pn = (wgid % nig) / gsz;
}

#ifndef PG8_SP2
#define PG8_SP2 true
#endif
template <class Epi, class Sched, int PITCH = 8192, bool F8 = false, bool SP2 = PG8_SP2>
__device__ __forceinline__ void gemm_phase(LAS unsigned char* lds, const char* wsb, const Sched& S, const Epi& E, int wave_s) {
    const int lane = lane_id_hw(), wid = wave_s, tid = wid * 64 + lane;
    const int wr = wid >> 2, wc = wid & 3, fr = lane & 15, fq = lane >> 4;
    unsigned voffA[2], voffB[2];
#pragma unroll
    for (int i = 0; i < 2; ++i) { int R, C; stage_rc(tid * 16 + i * 8192, R, C); const int Rb = (R & ~31) + perm32(R & 31);
        voffA[i] = (unsigned)(R * PITCH + C * 2); voffB[i] = (unsigned)(Rb * PITCH + C * 2); }
    const unsigned kstep = (unsigned)KSTEP, hstep = (unsigned)HALF * PITCH;
    const unsigned ldsw = (unsigned)wid * 1024u;
    const int aoff = lds_byte(wr * 64 + fr, fq * 8), boff = lds_byte(wc * 32 + fr, fq * 8);
#define PG8_SA(b, h) (((b) * 2 + (h)) * HTB)
#define PG8_SB(b, h) ((4 + (b) * 2 + (h)) * HTB)
#define PG8_STAGE(bufoff, gbase, voff) do { unsigned _g = (gbase); asm volatile("" : "+s"(_g));   _Pragma("unroll") for (int _i = 0; _i < 2; ++_i) \
        __builtin_amdgcn_global_load_lds((const unsigned*)(wsb + (size_t)(unsigned)(_g + (voff)[_i])), (LAS unsigned*)(lds + (bufoff) + ldsw + _i * 8192), 16, 0, 0); } while (0)
#define PG8_LDA(dst, b, h) do { if constexpr (F8) { _Pragma("unroll") for (int m = 0; m < 4; ++m) dst##8[m] = cat8(*(const LAS bf16x8*)(lds + PG8_SA(b, h) + aoff + m * 2048), *(const LAS bf16x8*)(lds + PG8_SA(b, h) + aoff + m * 2048 + 1024)); } \
      else { _Pragma("unroll") for (int m = 0; m < 4; ++m) _Pragma("unroll") for (int k = 0; k < 2; ++k) dst[m][k] = *(const LAS bf16x8*)(lds + PG8_SA(b, h) + aoff + m * 2048 + k * 1024); } } while (0)
#define PG8_LDB(dst, b, h) do { if constexpr (F8) { _Pragma("unroll") for (int n = 0; n < 2; ++n) dst##8[n] = cat8(*(const LAS bf16x8*)(lds + PG8_SB(b, h) + boff + n * 2048), *(const LAS bf16x8*)(lds + PG8_SB(b, h) + boff + n * 2048 + 1024)); } \
      else { _Pragma("unroll") for (int n = 0; n < 2; ++n) _Pragma("unroll") for (int k = 0; k < 2; ++k) dst[n][k] = *(const LAS bf16x8*)(lds + PG8_SB(b, h) + boff + n * 2048 + k * 1024); } } while (0)
#define PG8_MMA(ai, bj, At, Bt) do { __builtin_amdgcn_s_setprio(1); if constexpr (F8) { _Pragma("unroll") for (int m = 0; m < 4; ++m) _Pragma("unroll") for (int n = 0; n < 2; ++n) \
        acc[ai][bj][m][n] = __builtin_amdgcn_mfma_scale_f32_16x16x128_f8f6f4(Bt##8[n], At##8[m], acc[ai][bj][m][n], 0, 0, 0, 0, 0, 0); } \
      else { _Pragma("unroll") for (int m = 0; m < 4; ++m) _Pragma("unroll") for (int n = 0; n < 2; ++n) _Pragma("unroll") for (int k = 0; k < 2; ++k) \
        acc[ai][bj][m][n] = __builtin_amdgcn_mfma_f32_16x16x32_bf16(Bt[n][k], At[m][k], acc[ai][bj][m][n], 0, 0, 0); } __builtin_amdgcn_s_setprio(0); } while (0)
#define PG8_WAIT_V(n) asm volatile("s_waitcnt vmcnt(" #n ")" ::: "memory")
#define PG8_WAIT_L(n) asm volatile("s_waitcnt lgkmcnt(" #n ")" ::: "memory")
#define PG8_BAR __builtin_amdgcn_s_barrier()
#define PG8_SCHED __builtin_amdgcn_sched_barrier(0)
    GUnit cur, nxt; int ui = 0;
    if (!S.next(0, cur)) return;
    f32x4 acc[2][2][4][2];
#pragma unroll
    for (int a = 0; a < 2; ++a)
#pragma unroll
        for (int b = 0; b < 2; ++b)
#pragma unroll
            for (int m = 0; m < 4; ++m)
#pragma unroll
                for (int n = 0; n < 2; ++n) acc[a][b][m][n] = (f32x4){0.f, 0.f, 0.f, 0.f};
    bf16x8 At[4][2], B0[2][2], B1[2][2]; i32x8 At8[4], B08[2], B18[2];
    unsigned cA = cur.ao, cB = cur.bo;
    if constexpr (SP2) {
        PG8_STAGE(PG8_SB(0, 0), cB, voffB); PG8_STAGE(PG8_SB(0, 1), cB + hstep, voffB); PG8_STAGE(PG8_SA(0, 0), cA, voffA); PG8_STAGE(PG8_SA(0, 1), cA + hstep, voffA);
        if (wr == 1) PG8_BAR;
        PG8_WAIT_V(2); PG8_BAR;
        PG8_STAGE(PG8_SB(1, 0), cB + kstep, voffB); PG8_STAGE(PG8_SA(1, 0), cA + kstep, voffA); PG8_STAGE(PG8_SB(1, 1), cB + hstep + kstep, voffB);
        PG8_WAIT_V(6); PG8_BAR;
    } else {
    PG8_STAGE(PG8_SB(0, 0), cB, voffB); PG8_STAGE(PG8_SA(0, 0), cA, voffA); PG8_STAGE(PG8_SB(0, 1), cB + hstep, voffB); PG8_STAGE(PG8_SA(0, 1), cA + hstep, voffA);
    if (wr == 1) PG8_BAR;
    PG8_WAIT_V(4); PG8_BAR;
    PG8_STAGE(PG8_SB(1, 0), cB + kstep, voffB); PG8_STAGE(PG8_SA(1, 0), cA + kstep, voffA); PG8_STAGE(PG8_SB(1, 1), cB + hstep + kstep, voffB);
    PG8_WAIT_V(6); PG8_BAR;
    }
    for (;;) {
        const bool has_next = S.next(ui + 1, nxt);
        const unsigned nA = has_next ? nxt.ao : cA, nB = has_next ? nxt.bo : cB;
        const int nt = cur.nt;
        for (int t = 0; t < nt; t += 2) {
            if constexpr (Epi::HAS_MID) { if (t == Epi::MID0 || t == Epi::MID1) { const int l2 = lane_id_hw(); E.mid(acc, cur, t == Epi::MID0 ? 0 : 1, wr, wc, l2 & 15, l2 >> 4); } }
            const bool last = (t == nt - 2);
            const unsigned a1 = cA + (unsigned)(t + 1) * kstep;
            const unsigned a2 = last ? nA : cA + (unsigned)(t + 2) * kstep, b2 = last ? nB : cB + (unsigned)(t + 2) * kstep;
            const unsigned a3 = a2 + kstep, b3 = b2 + kstep;
            if constexpr (SP2) {
            PG8_LDB(B0, 0, 0); PG8_LDB(B1, 0, 1); PG8_SCHED; PG8_LDA(At, 0, 0); PG8_STAGE(PG8_SA(1, 1), a1 + hstep, voffA);
            PG8_WAIT_V(8); PG8_WAIT_L(0); PG8_BAR; PG8_MMA(0, 0, At, B0); PG8_MMA(0, 1, At, B1); PG8_BAR; PG8_SCHED;
            PG8_LDA(At, 0, 1); PG8_STAGE(PG8_SB(0, 0), b2, voffB); PG8_STAGE(PG8_SB(0, 1), b2 + hstep, voffB); PG8_STAGE(PG8_SA(0, 0), a2, voffA);
            PG8_WAIT_V(8); PG8_WAIT_L(0); PG8_BAR; PG8_MMA(1, 0, At, B0); PG8_MMA(1, 1, At, B1); PG8_BAR; PG8_SCHED;
            PG8_LDB(B0, 1, 0); PG8_LDB(B1, 1, 1); PG8_SCHED; PG8_LDA(At, 1, 0); PG8_STAGE(PG8_SA(0, 1), a2 + hstep, voffA);
            PG8_WAIT_V(8); PG8_WAIT_L(0); PG8_BAR; PG8_MMA(0, 0, At, B0); PG8_MMA(0, 1, At, B1); PG8_BAR; PG8_SCHED;
            PG8_LDA(At, 1, 1); PG8_STAGE(PG8_SB(1, 0), b3, voffB); PG8_STAGE(PG8_SB(1, 1), b3 + hstep, voffB); PG8_STAGE(PG8_SA(1, 0), a3, voffA);
            PG8_WAIT_V(8); PG8_WAIT_L(0); PG8_BAR; PG8_MMA(1, 0, At, B0); PG8_MMA(1, 1, At, B1); PG8_BAR; PG8_SCHED;
            } else {
            PG8_LDB(B0, 0, 0); PG8_SCHED; PG8_LDA(At, 0, 0); PG8_STAGE(PG8_SA(1, 1), a1 + hstep, voffA);
            PG8_WAIT_L(8); PG8_BAR; PG8_WAIT_L(0); PG8_MMA(0, 0, At, B0); PG8_BAR; PG8_SCHED;
            PG8_LDB(B1, 0, 1); PG8_STAGE(PG8_SB(0, 0), b2, voffB);
            PG8_BAR; PG8_WAIT_L(0); PG8_MMA(0, 1, At, B1); PG8_BAR;
            PG8_LDA(At, 0, 1); PG8_STAGE(PG8_SA(0, 0), a2, voffA);
            PG8_BAR; PG8_WAIT_L(0); PG8_MMA(1, 0, At, B0); PG8_BAR; PG8_SCHED;
            PG8_STAGE(PG8_SB(0, 1), b2 + hstep, voffB);
            PG8_WAIT_V(6); PG8_BAR; PG8_MMA(1, 1, At, B1); PG8_BAR;
            PG8_LDB(B0, 1, 0); PG8_SCHED; PG8_LDA(At, 1, 0); PG8_STAGE(PG8_SA(0, 1), a2 + hstep, voffA);
            PG8_WAIT_L(8); PG8_BAR; PG8_WAIT_L(0); PG8_MMA(0, 0, At, B0); PG8_BAR; PG8_SCHED;
            PG8_LDB(B1, 1, 1); PG8_STAGE(PG8_SB(1, 0), b3, voffB);
            PG8_BAR; PG8_WAIT_L(0); PG8_MMA(0, 1, At, B1); PG8_BAR;
            PG8_LDA(At, 1, 1); PG8_STAGE(PG8_SA(1, 0), a3, voffA);
            PG8_BAR; PG8_WAIT_L(0); PG8_MMA(1, 0, At, B0); PG8_BAR; PG8_SCHED;
            PG8_STAGE(PG8_SB(1, 1), b3 + hstep, voffB);
            PG8_WAIT_V(6); PG8_BAR; PG8_MMA(1, 1, At, B1); PG8_BAR;
            }
        }
        { const int l2 = lane_id_hw(); E(acc, cur, wr, wc, l2 & 15, l2 >> 4); }
        if (!has_next) break;
#pragma unroll
        for (int a = 0; a < 2; ++a)
#pragma unroll
            for (int b = 0; b < 2; ++b)
#pragma unroll
                for (int m = 0; m < 4; ++m)
#pragma unroll
                    for (int n = 0; n < 2; ++n) acc[a][b][m][n] = (f32x4){0.f, 0.f, 0.f, 0.f};
        cur = nxt; cA = nA; cB = nB; ++ui;
    }
    PG8_WAIT_V(0);
    if (wr == 0) PG8_BAR;
    PG8_BAR;
#undef PG8_SA
#undef PG8_SB
#undef PG8_STAGE
#undef PG8_LDA
#undef PG8_LDB
#undef PG8_MMA
#undef PG8_WAIT_V
#undef PG8_WAIT_L
#undef PG8_BAR
#undef PG8_SCHED
}
}

struct SchedIn {
    int G, c, nextra; unsigned A, B, memA, memB0, memB1;
    __device__ __forceinline__ bool next(int i, pg8::GUnit& u) const {
        int L = i * G + c;
        constexpr int NN = GATES_FP8 ? 48 : 96;
        if (L < 96 * NN) { int pm, pn; pg8::tile_of<WGM_IN>(L, 96, NN, pm, pn); u.ao = A + (unsigned)pm * (unsigned)pg8::TSTEP16; u.bo = B + (unsigned)pn * (unsigned)pg8::TSTEP16; u.nt = 64; u.pm = pm; u.pn = pn; u.kind = 0; return true; }
        L -= 96 * NN; if (L >= nextra) return false;
        const int le = L / 96, r = L % 96, pm = r % 12, pn = r / 12;
        u.ao = memA + (unsigned)pm * (unsigned)pg8::TSTEP16; u.bo = (le ? memB1 : memB0) + (unsigned)pn * (unsigned)pg8::TSTEP16; u.nt = 64; u.pm = pm; u.pn = pn; u.kind = 1 + le; return true;
    }
};
struct EpiIn {   static constexpr bool HAS_MID = false; static constexpr int MID0 = -1, MID1 = -1;
    bf16_t* P; bf16_t* KVM0; bf16_t* KVM1; bf16_t* wsb16;
    __device__ __forceinline__ void operator()(const f32x4 (&acc)[2][2][4][2], const pg8::GUnit& u, int wr, int wc, int fr, int fq) const {
        bf16_t* base; int ldc, mode = 0, bjs = 128; int rowb = u.pm * 256 + wr * 64 + fr, colb = u.pn * 256 + wc * 32 + 8 * fq;
        if (u.kind == 0) { base = P; ldc = INW; const int pn = u.pn; if (pn >= GA / 256) mode = 1; else if ((pn >= ZA / 256 && pn < QB / 256) || (pn >= ZB / 256 && pn < QM / 256) || (pn >= ZM / 256)) mode = 2;
            if (GATES_FP8) {
                int nh = 0, hp = 0; size_t off = 0;
                if (pn >= KA / 256 && pn < VA / 256) { nh = 12; hp = pn - KA / 256; off = WS_KNA; } else if (pn >= VA / 256 && pn < ZA / 256) { nh = 12; hp = pn - VA / 256; off = WS_VNA; }
                else if (pn >= KB / 256 && pn < VB / 256) { nh = 4; hp = pn - KB / 256; off = WS_KSW; } else if (pn >= VB / 256 && pn < ZB / 256) { nh = 4; hp = pn - VB / 256; off = WS_VSW; }
                if (nh) { const int b = u.pm >> 3; base = wsb16 + off / 2; ldc = 128; bjs = SEQ * 128; rowb = (b * nh + 2 * hp) * SEQ + (u.pm & 7) * 256 + wr * 64 + fr; colb = wc * 32 + 8 * fq; } } }
        else { base = (u.kind == 1) ? KVM0 : KVM1; ldc = KVW; }
#pragma unroll
        for (int ai = 0; ai < 2; ++ai)
#pragma unroll
            for (int m = 0; m < 4; ++m) { GAS bf16_t* rowp = (GAS bf16_t*)base + (size_t)(rowb + ai * 128 + m * 16) * ldc + colb;
#pragma unroll
                for (int bj = 0; bj < 2; ++bj) { f32x4 v0 = acc[ai][bj][m][0], v1 = acc[ai][bj][m][1];
                    if (mode == 1) {
#pragma unroll
                        for (int j = 0; j < 4; ++j) { v0[j] = sigmoid_f(v0[j]); v1[j] = sigmoid_f(v1[j]); } }
                    else if (mode == 2) {
#pragma unroll
                        for (int j = 0; j < 4; ++j) { v0[j] = v0[j] * sigmoid_f(v0[j]); v1[j] = v1[j] * sigmoid_f(v1[j]); } }
                    u32x4 w; w.x = cvt_pk_bf16(v0[0], v0[1]); w.y = cvt_pk_bf16(v0[2], v0[3]); w.z = cvt_pk_bf16(v1[0], v1[1]); w.w = cvt_pk_bf16(v1[2], v1[3]);
                    *(GAS u32x4*)(rowp + (size_t)bj * bjs) = w; } }
    }
};
struct SchedIn8 {
    int G, c; unsigned A, B;
    __device__ __forceinline__ bool next(int i, pg8::GUnit& u) const {
        const int L = i * G + c; if (L >= 96 * 48) return false;
        int pm, pn; pg8::tile_of<WGM_IN>(L, 96, 48, pm, pn);
        u.ao = A + (unsigned)pm * (unsigned)pg8::TSTEP8; u.bo = B + (unsigned)pn * (unsigned)pg8::TSTEP8; u.nt = 32; u.pm = pm; u.pn = pn; u.kind = 0; return true;
    }
};
struct EpiIn8 {   static constexpr bool HAS_MID = false; static constexpr int MID0 = -1, MID1 = -1;
    bf16_t* P;
    __device__ __forceinline__ void operator()(const f32x4 (&acc)[2][2][4][2], const pg8::GUnit& u, int wr, int wc, int fr, int fq) const {
#if GATE_U8
        GAS unsigned char* gb = (GAS unsigned char*)P + (size_t)(u.pm * 256 + (wr * 4 + wc) * 32 + fq) * (INW * 2) + (GA * 2 + u.pn * 256 + fr * 16);
#pragma unroll
        for (int ai = 0; ai < 2; ++ai)
#pragma unroll
            for (int m = 0; m < 4; ++m) { u32x4 w; unsigned wq[4];
#pragma unroll
                for (int bj = 0; bj < 2; ++bj)
#pragma unroll
                    for (int n = 0; n < 2; ++n) { f32x4 v = acc[ai][bj][m][n];
#pragma unroll
                        for (int j = 0; j < 4; ++j) v[j] = __builtin_amdgcn_rcpf(1.0f + __builtin_amdgcn_exp2f(v[j] * (-LOG2E * G8_DESCALE)));
                        wq[bj * 2 + n] = gate_pk4(v); }
                w.x = wq[0]; w.y = wq[1]; w.z = wq[2]; w.w = wq[3];
                *(GAS u32x4*)(gb + (size_t)((ai * 4 + m) * 4) * (INW * 2)) = w; }
#else
        const int row0 = u.pm * 256 + wr * 64 + fr, col0 = GA + u.pn * 256 + wc * 32 + 8 * fq;
#pragma unroll
        for (int ai = 0; ai < 2; ++ai)
#pragma unroll
            for (int m = 0; m < 4; ++m) { GAS bf16_t* rowp = (GAS bf16_t*)P + (size_t)(row0 + ai * 128 + m * 16) * INW + col0;
#pragma unroll
                for (int bj = 0; bj < 2; ++bj) { f32x4 v0 = acc[ai][bj][m][0], v1 = acc[ai][bj][m][1];
#pragma unroll
                    for (int j = 0; j < 4; ++j) { v0[j] = __builtin_amdgcn_rcpf(1.0f + __builtin_amdgcn_exp2f(v0[j] * (-LOG2E * G8_DESCALE))); v1[j] = __builtin_amdgcn_rcpf(1.0f + __builtin_amdgcn_exp2f(v1[j] * (-LOG2E * G8_DESCALE))); }
                    u32x4 w; w.x = cvt_pk_bf16(v0[0], v0[1]); w.y = cvt_pk_bf16(v0[2], v0[3]); w.z = cvt_pk_bf16(v1[0], v1[1]); w.w = cvt_pk_bf16(v1[2], v1[3]);
                    *(GAS u32x4*)(rowp + bj * 128) = w; } }
#endif
    }
};
struct SchedBr {
    int G, c; unsigned A, B;
    __device__ __forceinline__ bool next(int i, pg8::GUnit& u) const {
        const int L = i * G + c; if (L >= 96 * 16) return false;
        int pm, pn; pg8::tile_of<WGM_SM>(L, 96, 16, pm, pn);
        u.ao = A + (unsigned)pm * (unsigned)pg8::TSTEP16; u.bo = B + (unsigned)pn * (unsigned)pg8::TSTEP16; u.nt = 64; u.pm = pm; u.pn = pn; u.kind = 0; return true;
    }
};
struct EpiBr {
    static constexpr bool HAS_MID = true; static constexpr int MID0 = 24, MID1 = 48;
    const bf16_t* P; bf16_t* Mg;
    __device__ __forceinline__ void mid(f32x4 (&acc)[2][2][4][2], const pg8::GUnit& u, int b, int wr, int wc, int fr, int fq) const {
#if GATE_U8
        const GAS unsigned char* gp = (const GAS unsigned char*)P + (size_t)(u.pm * 256 + (wr * 4 + wc) * 32 + fq) * (INW * 2) + (GA * 2 + (b * 16 + u.pn) * 256 + fr * 16);
        u32x4 gn[8], gd[8];
#pragma unroll
        for (int k = 0; k < 8; ++k) { const GAS unsigned char* q = gp + (size_t)(k * 4) * (INW * 2); gn[k] = *(const GAS u32x4*)q; gd[k] = *(const GAS u32x4*)(q + DM); }
#pragma unroll
        for (int k = 0; k < 8; ++k) { const int ai = k >> 2, m = k & 3;
            gate_ratio4(acc[ai][0][m][0], gn[k].x, gd[k].x); gate_ratio4(acc[ai][0][m][1], gn[k].y, gd[k].y); gate_ratio4(acc[ai][1][m][0], gn[k].z, gd[k].z); gate_ratio4(acc[ai][1][m][1], gn[k].w, gd[k].w); }
#else
        const int row0 = u.pm * 256 + wr * 64 + fr, col0 = u.pn * 256 + wc * 32 + 8 * fq;
        const GAS bf16_t* gp = (const GAS bf16_t*)P + (size_t)row0 * INW + GA + b * DM + col0;
#pragma unroll
        for (int ai = 0; ai < 2; ++ai) {
            u32x4 gn[4][2], gd[4][2];
#pragma unroll
            for (int m = 0; m < 4; ++m)
#pragma unroll
                for (int bj = 0; bj < 2; ++bj) { const GAS bf16_t* q = gp + (size_t)(ai * 128 + m * 16) * INW + bj * 128; gn[m][bj] = *(const GAS u32x4*)q; gd[m][bj] = *(const GAS u32x4*)(q + DM); }
#pragma unroll
            for (int m = 0; m < 4; ++m)
#pragma unroll
                for (int bj = 0; bj < 2; ++bj) { const u32x4 n4 = gn[m][bj], d4 = gd[m][bj];
                    f32x4& v0 = acc[ai][bj][m][0]; f32x4& v1 = acc[ai][bj][m][1];
                    v0[0] *= bf_lo(n4.x) * __builtin_amdgcn_rcpf(fmaxf(bf_lo(d4.x), 1e-30f)); v0[1] *= bf_hi(n4.x) * __builtin_amdgcn_rcpf(fmaxf(bf_hi(d4.x), 1e-30f));
                    v0[2] *= bf_lo(n4.y) * __builtin_amdgcn_rcpf(fmaxf(bf_lo(d4.y), 1e-30f)); v0[3] *= bf_hi(n4.y) * __builtin_amdgcn_rcpf(fmaxf(bf_hi(d4.y), 1e-30f));
                    v1[0] *= bf_lo(n4.z) * __builtin_amdgcn_rcpf(fmaxf(bf_lo(d4.z), 1e-30f)); v1[1] *= bf_hi(n4.z) * __builtin_amdgcn_rcpf(fmaxf(bf_hi(d4.z), 1e-30f));
                    v1[2] *= bf_lo(n4.w) * __builtin_amdgcn_rcpf(fmaxf(bf_lo(d4.w), 1e-30f)); v1[3] *= bf_hi(n4.w) * __builtin_amdgcn_rcpf(fmaxf(bf_hi(d4.w), 1e-30f)); }
        }
#endif
    }
    __device__ __forceinline__ void operator()(const f32x4 (&acc)[2][2][4][2], const pg8::GUnit& u, int wr, int wc, int fr, int fq) const {
        const int row0 = u.pm * 256 + wr * 64 + fr, col0 = u.pn * 256 + wc * 32 + 8 * fq;
        GAS bf16_t* mp0 = (GAS bf16_t*)Mg + (size_t)row0 * DM + col0;
#if GATE_U8
        const GAS unsigned char* gp = (const GAS unsigned char*)P + (size_t)(u.pm * 256 + (wr * 4 + wc) * 32 + fq) * (INW * 2) + (GA * 2 + (2 * 16 + u.pn) * 256 + fr * 16);
        u32x4 g[8];
#pragma unroll
        for (int k = 0; k < 8; ++k) g[k] = *(const GAS u32x4*)(gp + (size_t)(k * 4) * (INW * 2));
#pragma unroll
        for (int k = 0; k < 8; ++k) { const int ai = k >> 2, m = k & 3;
#pragma unroll
            for (int bj = 0; bj < 2; ++bj) { f32x4 v0 = acc[ai][bj][m][0], v1 = acc[ai][bj][m][1];
                gate_mul4(v0, bj ? g[k].z : g[k].x); gate_mul4(v1, bj ? g[k].w : g[k].y);
                u32x4 w; w.x = cvt_pk_bf16(v0[0], v0[1]); w.y = cvt_pk_bf16(v0[2], v0[3]); w.z = cvt_pk_bf16(v1[0], v1[1]); w.w = cvt_pk_bf16(v1[2], v1[3]);
                *(GAS u32x4*)(mp0 + (size_t)(ai * 128 + m * 16) * DM + bj * 128) = w; } }
#else
        const GAS bf16_t* gp = (const GAS bf16_t*)P + (size_t)row0 * INW + GA + 2 * DM + col0;
#pragma unroll
        for (int ai = 0; ai < 2; ++ai) {
            u32x4 g[4][2];
#pragma unroll
            for (int m = 0; m < 4; ++m)
#pragma unroll
                for (int bj = 0; bj < 2; ++bj) g[m][bj] = *(const GAS u32x4*)(gp + (size_t)(ai * 128 + m * 16) * INW + bj * 128);
#pragma unroll
            for (int m = 0; m < 4; ++m)
#pragma unroll
                for (int bj = 0; bj < 2; ++bj) { const u32x4 gg = g[m][bj];
                    f32x4 v0 = acc[ai][bj][m][0], v1 = acc[ai][bj][m][1];
                    v0[0] *= bf_lo(gg.x); v0[1] *= bf_hi(gg.x); v0[2] *= bf_lo(gg.y); v0[3] *= bf_hi(gg.y); v1[0] *= bf_lo(gg.z); v1[1] *= bf_hi(gg.z); v1[2] *= bf_lo(gg.w); v1[3] *= bf_hi(gg.w);
                    u32x4 w; w.x = cvt_pk_bf16(v0[0], v0[1]); w.y = cvt_pk_bf16(v0[2], v0[3]); w.z = cvt_pk_bf16(v1[0], v1[1]); w.w = cvt_pk_bf16(v1[2], v1[3]);
                    *(GAS u32x4*)(mp0 + (size_t)(ai * 128 + m * 16) * DM + bj * 128) = w; }
        }
#endif
    }
};
struct SchedOut {
    int G, c; unsigned A, B;
    __device__ __forceinline__ bool next(int i, pg8::GUnit& u) const {
        const int L = i * G + c; if (L >= 96 * 16) return false;
        int pm, pn; pg8::tile_of<WGM_SM>(L, 96, 16, pm, pn);
        u.ao = A + (unsigned)pm * (unsigned)pg8::TSTEP16; u.bo = B + (unsigned)pn * (unsigned)pg8::TSTEP16; u.nt = 64; u.pm = pm; u.pn = pn; u.kind = 0; return true;
    }
};
struct EpiOut {  static constexpr bool HAS_MID = false; static constexpr int MID0 = -1, MID1 = -1;
    bf16_t* O; float* RSQ;
    __device__ __forceinline__ void operator()(const f32x4 (&acc)[2][2][4][2], const pg8::GUnit& u, int wr, int wc, int fr, int fq) const {
        const int row0 = u.pm * 256 + wr * 64 + fr, col0 = u.pn * 256 + wc * 32 + 8 * fq;
#pragma unroll
        for (int ai = 0; ai < 2; ++ai)
#pragma unroll
            for (int m = 0; m < 4; ++m) { const size_t row = (size_t)(row0 + ai * 128 + m * 16); float s = 0.f;
#pragma unroll
                for (int bj = 0; bj < 2; ++bj) { const f32x4 v0 = acc[ai][bj][m][0], v1 = acc[ai][bj][m][1];
                    s += (v0[0] * v0[0] + v0[1] * v0[1]) + (v0[2] * v0[2] + v0[3] * v0[3]) + (v1[0] * v1[0] + v1[1] * v1[1]) + (v1[2] * v1[2] + v1[3] * v1[3]);
                    u32x4 w; w.x = cvt_pk_bf16(v0[0], v0[1]); w.y = cvt_pk_bf16(v0[2], v0[3]); w.z = cvt_pk_bf16(v1[0], v1[1]); w.w = cvt_pk_bf16(v1[2], v1[3]);
                    *(GAS u32x4*)((GAS bf16_t*)O + row * DM + col0 + bj * 128) = w; }
                { const int ln = fr + 16 * fq; s += __int_as_float(__builtin_amdgcn_ds_bpermute((ln ^ 16) << 2, __float_as_int(s))); s += __int_as_float(__builtin_amdgcn_ds_bpermute((ln ^ 32) << 2, __float_as_int(s))); }
                if (fq == 0) ((GAS float*)RSQ)[row * 64 + u.pn * 4 + wc] = s; }
    }
};

static_assert(!GATE_U8 || GATES_FP8, "GATE_U8 lives in the fp8 gate GEMM epilogue");
#define XB_TMO      128
#define XB_XCNT(j)  (256  + 64 * (j))
#define XB_XSUB(j)  (1280 + 64 * (j))
#define XB_XGEN(j)  (2304 + 64 * (j))
#define XB_TOP      3328
#define XB_TOPGEN   3392
#define XCD_BAR_WORDS 3456
#define XB_SPIN_CAP (1u << 18)
__device__ __forceinline__ unsigned xb_ld(unsigned* p)              { return __hip_atomic_load(p, __ATOMIC_RELAXED, __HIP_MEMORY_SCOPE_AGENT); }
__device__ __forceinline__ unsigned xb_add(unsigned* p, unsigned v) { return __hip_atomic_fetch_add(p, v, __ATOMIC_RELAXED, __HIP_MEMORY_SCOPE_AGENT); }
__device__ __forceinline__ unsigned xb_xcc_id() { return (unsigned)__builtin_amdgcn_s_getreg((3 << 11) | 20) & 0xFu; }
#define XB_SPIN(cond, bar) do { unsigned _sp = 0; while (cond) { __builtin_amdgcn_s_sleep(1); \
    if ((++_sp & 255u) == 0u) { if (xb_ld(&(bar)[XB_TMO])) break; if (_sp > XB_SPIN_CAP) { atomicAdd(&(bar)[XB_TMO], 1u); break; } } } } while (0)
struct XcdBarrier { unsigned* bar; unsigned x; volatile LAS unsigned* st; };
__device__ __forceinline__ XcdBarrier xcd_barrier_post(unsigned* bar, volatile LAS unsigned* st, bool leader) {
    XcdBarrier b; b.bar = bar; b.x = xb_xcc_id(); b.st = st;
    if (leader) (void)xb_add(&bar[XB_XCNT(b.x)], 1u);
    return b;
}
__device__ __forceinline__ void xcd_barrier_complete(unsigned* bar, unsigned x, unsigned& nloc, unsigned& nx) {
    const unsigned G = gridDim.x * gridDim.y * gridDim.z;
    unsigned sum, cnt, mine, sp = 0u;
    for (;;) {
        sum = 0u; cnt = 0u; mine = 0u;
#pragma unroll
        for (unsigned j = 0; j < 16; ++j) { const unsigned c = xb_ld(&bar[XB_XCNT(j)]); sum += c; cnt += (c > 0u) ? 1u : 0u; mine = (j == x) ? c : mine; }
        if (sum == G) break;
        __builtin_amdgcn_s_sleep(1);
        if ((++sp & 255u) == 0u) { if (xb_ld(&bar[XB_TMO])) break; if (sp > XB_SPIN_CAP) { atomicAdd(&bar[XB_TMO], 1u); break; } }
    }
    nloc = mine > 0u ? mine : 1u; nx = cnt > 0u ? cnt : 1u;
}
__device__ __forceinline__ void xcd_barrier(const XcdBarrier& b, bool leader) {
    asm volatile("s_waitcnt vmcnt(0)" ::: "memory");
    __syncthreads();
    if (leader) {
        unsigned* bar = b.bar;
        __builtin_amdgcn_s_waitcnt(0);
        unsigned nloc = b.st[0], nx = b.st[1];
        if (nloc == 0u) { xcd_barrier_complete(bar, b.x, nloc, nx); b.st[0] = nloc; b.st[1] = nx; }
        const unsigned old = xb_add(&bar[XB_XSUB(b.x)], 1u);
        const unsigned gen = old / nloc;
        if (old + 1u == (gen + 1u) * nloc) {
            __builtin_amdgcn_fence(__ATOMIC_RELEASE, "agent");
            asm volatile("s_waitcnt vmcnt(0)" ::: "memory");
            const unsigned og = xb_add(&bar[XB_TOP], 1u);
            const unsigned tg = og / nx;
            if (og + 1u == (tg + 1u) * nx) xb_add(&bar[XB_TOPGEN], 1u);
            else XB_SPIN(xb_ld(&bar[XB_TOPGEN]) == tg, bar);
            __builtin_amdgcn_fence(__ATOMIC_ACQUIRE, "agent");
            xb_add(&bar[XB_XGEN(b.x)], 1u);
            asm volatile("s_waitcnt vmcnt(0)" ::: "memory");
        } else {
            XB_SPIN(xb_ld(&bar[XB_XGEN(b.x)]) == gen, bar);
            __builtin_amdgcn_fence(__ATOMIC_ACQUIRE, "agent");
            asm volatile("s_waitcnt vmcnt(0)" ::: "memory");
        }
    }
    __syncthreads();
}

__device__ __forceinline__ float shfl_xor_l(float v, int mask, int lane) { return __int_as_float(__builtin_amdgcn_ds_bpermute((lane ^ mask) << 2, __float_as_int(v))); }
__device__ __forceinline__ float wave_sum(float v, int lane) {
#pragma unroll
    for (int o = 1; o < 64; o <<= 1) v += shfl_xor_l(v, o, lane);
    return v;
}
__device__ __forceinline__ unsigned f2bf(float f) { unsigned u = __builtin_bit_cast(unsigned, f); return (u + 0x7fffu + ((u >> 16) & 1u)) >> 16; }
__device__ __forceinline__ unsigned pk2(float lo, float hi) { return f2bf(lo) | (f2bf(hi) << 16); }

struct TItem { const float* W; int N; bf16_t* WT; int ldwt, koff; const float* gain; unsigned char* W8; int n8, item; };
__device__ __forceinline__ void titem_load(const TItem& t, float (&v)[32], int lane) {
    const int nblk = t.N / 32, kb = t.item / nblk, nb = t.item % nblk, k0 = 64 * kb, n0 = 32 * nb;
    const GAS float* wp = (const GAS float*)t.W + (size_t)(k0 + (lane >> 5)) * t.N + n0 + (lane & 31);
#pragma unroll
    for (int i = 0; i < 32; ++i) v[i] = wp[(size_t)(2 * i) * t.N];
}
__device__ __forceinline__ void titem_finish(const TItem& t, float (&v)[32], LAS float* scr, int lane) {
    const int N = t.N, item = t.item; const float* gain = t.gain; bf16_t* WT = t.WT; const int ldwt = t.ldwt, koff = t.koff; unsigned char* W8 = t.W8; const int n8 = t.n8;
    const int nblk = N / 32, kb = item / nblk, nb = item % nblk, k0 = 64 * kb, n0 = 32 * nb;
    if (gain) {
#pragma unroll
        for (int i = 0; i < 32; ++i) v[i] *= ((const GAS float*)gain)[k0 + 2 * i + (lane >> 5)]; }
#pragma unroll
    for (int i = 0; i < 32; ++i) scr[(2 * i + (lane >> 5)) * 33 + (lane & 31)] = v[i];
    asm volatile("s_waitcnt lgkmcnt(0)" ::: "memory");
    const int c = lane & 7;
    if (W8 && n0 >= n8) {
#pragma unroll
        for (int j = 0; j < 4; ++j) { const int n = (lane >> 3) + 8 * j; const LAS float* s = scr + (8 * c) * 33 + n;
            u32x2 o; o.x = pk4_fp8(s[0 * 33] * W8_SCALE, s[1 * 33] * W8_SCALE, s[2 * 33] * W8_SCALE, s[3 * 33] * W8_SCALE); o.y = pk4_fp8(s[4 * 33] * W8_SCALE, s[5 * 33] * W8_SCALE, s[6 * 33] * W8_SCALE, s[7 * 33] * W8_SCALE);
            *(GAS u32x2*)(W8 + (size_t)(n0 - n8 + n) * DM + k0 + 8 * c) = o; }
    } else {
#pragma unroll
    for (int j = 0; j < 4; ++j) { const int n = (lane >> 3) + 8 * j; const LAS float* s = scr + (8 * c) * 33 + n;
        u32x4 o; o.x = pk2(s[0 * 33], s[1 * 33]); o.y = pk2(s[2 * 33], s[3 * 33]); o.z = pk2(s[4 * 33], s[5 * 33]); o.w = pk2(s[6 * 33], s[7 * 33]);
        *(GAS u32x4*)(WT + (size_t)(n0 + n) * ldwt + koff + k0 + 8 * c) = o; }
    }
    asm volatile("s_waitcnt lgkmcnt(0)" ::: "memory");
}
__device__ __forceinline__ void rms_row_to_bf16(const float* xrow, const float* gain, bf16_t* orow, int lane, unsigned char* o8row = nullptr) {
    const GAS f32x4* xr = (const GAS f32x4*)xrow + lane;
    f32x4 v[16]; float s = 0.f;
#pragma unroll
    for (int j = 0; j < 16; ++j) v[j] = xr[64 * j];
    f32x4 gv[16];
#pragma unroll
    for (int j = 0; j < 16; ++j) gv[j] = gain ? ((const GAS f32x4*)gain)[lane + 64 * j] : (f32x4){1.f, 1.f, 1.f, 1.f};
#pragma unroll
    for (int j = 0; j < 16; ++j) s += (v[j].x * v[j].x + v[j].y * v[j].y) + (v[j].z * v[j].z + v[j].w * v[j].w);
    const float r = 1.0f / sqrtf(wave_sum(s, lane) * (1.0f / DM) + RMS_EPS);
    GAS u32x2* o8 = (GAS u32x2*)orow + lane;
#pragma unroll
    for (int j = 0; j < 16; ++j) { const f32x4 g = gv[j];
        const float y0 = v[j].x * r * g.x, y1 = v[j].y * r * g.y, y2 = v[j].z * r * g.z, y3 = v[j].w * r * g.w;
        u32x2 w; w.x = cvt_pk_bf16(y0, y1); w.y = cvt_pk_bf16(y2, y3); o8[64 * j] = w;
        if (o8row) ((GAS unsigned*)o8row)[lane + 64 * j] = pk4_fp8(y0 * H8_SCALE, y1 * H8_SCALE, y2 * H8_SCALE, y3 * H8_SCALE); }
}

__device__ __forceinline__ void rms_row_load(f32x4 (&v)[16], const float* xrow, int lane) { const GAS f32x4* xr = (const GAS f32x4*)xrow + lane;
#pragma unroll
    for (int j = 0; j < 16; ++j) v[j] = xr[64 * j]; }
__device__ __forceinline__ void rms_row_finish(const f32x4 (&v)[16], const f32x4 (&gv)[16], bf16_t* orow, unsigned char* o8row, int lane) {
    float s = 0.f;
#pragma unroll
    for (int j = 0; j < 16; ++j) s += (v[j].x * v[j].x + v[j].y * v[j].y) + (v[j].z * v[j].z + v[j].w * v[j].w);
    const float r = 1.0f / sqrtf(wave_sum(s, lane) * (1.0f / DM) + RMS_EPS);
    GAS u32x2* o8 = (GAS u32x2*)orow + lane;
#pragma unroll
    for (int j = 0; j < 16; ++j) { const f32x4 g = gv[j];
        const float y0 = v[j].x * r * g.x, y1 = v[j].y * r * g.y, y2 = v[j].z * r * g.z, y3 = v[j].w * r * g.w;
        u32x2 w; w.x = cvt_pk_bf16(y0, y1); w.y = cvt_pk_bf16(y2, y3); o8[64 * j] = w;
        if (o8row) ((GAS unsigned*)o8row)[lane + 64 * j] = pk4_fp8(y0 * H8_SCALE, y1 * H8_SCALE, y2 * H8_SCALE, y3 * H8_SCALE); }
}
__device__ __forceinline__ int t5_bucket(int rel) {
    const int n = rel < 0 ? -rel : rel;
    const int b = n < 8 ? n : 8 + (n >= 12) + (n >= 16) + (n >= 23) + (n >= 32) + (n >= 46) + (n >= 64) + (n >= 91);
    return b + (rel > 0 ? 16 : 0);
}

struct Args { const float* in[16]; float* out; unsigned char* ws; int ph_lo, ph_hi, probe_phase, probe_reps; };
struct Frame {
    LAS unsigned char* lds;
    int tid, lane, wave, vcu, G;
    const float *xp, *xs, *memp, *mems, *pre_norm, *post_norm, *mem_norm, *w_in, *w_kv, *w_a, *w_b, *w_m, *w_out, *rpb, *sink, *t5;
    float* out;
    bf16_t *WinT, *WkvT, *WcatT, *WoutT, *H, *X, *P, *MEMH, *KVM; float* RSQ; unsigned char *H8, *W8, *ws;
};
__device__ __forceinline__ void make_frame(Frame& F, LAS unsigned char* lds, int wave_s) {
    const Args* ka = (const Args*)__builtin_amdgcn_kernarg_segment_ptr(); asm volatile("" : "+s"(ka));
    const int lane = lane_id_hw();
    F.lds = lds; F.lane = lane; F.wave = wave_s; F.tid = wave_s * 64 + lane;
    F.G = gridDim.x; { const int bx = blockIdx.x; F.vcu = (F.G % 8 == 0) ? (bx % 8) * (F.G / 8) + bx / 8 : bx; }
    F.xp = ka->in[0]; F.xs = ka->in[1]; F.memp = ka->in[2]; F.mems = ka->in[3]; F.pre_norm = ka->in[4]; F.post_norm = ka->in[5]; F.mem_norm = ka->in[6];
    F.w_in = ka->in[7]; F.w_kv = ka->in[8]; F.w_a = ka->in[9]; F.w_b = ka->in[10]; F.w_m = ka->in[11]; F.w_out = ka->in[12]; F.rpb = ka->in[13]; F.sink = ka->in[14]; F.t5 = ka->in[15];
    F.out = ka->out; unsigned char* ws = ka->ws; F.ws = ws;
    F.WinT = (bf16_t*)(ws + WS_WIN); F.WkvT = (bf16_t*)(ws + WS_WKV); F.WcatT = (bf16_t*)(ws + WS_WCAT); F.WoutT = (bf16_t*)(ws + WS_WOUT);
    F.H = (bf16_t*)(ws + WS_H); F.X = (bf16_t*)(ws + WS_X); F.P = (bf16_t*)(ws + WS_P); F.MEMH = (bf16_t*)(ws + WS_MEMH); F.KVM = (bf16_t*)(ws + WS_KVM); F.RSQ = (float*)(ws + WS_RSQ); F.H8 = ws + WS_H8; F.W8 = ws + WS_W8;
}

__device__ __forceinline__ void naive_attention(Frame& F, int l) {
    const int gw = F.vcu * NWAVES + F.wave, NGW = F.G * NWAVES, lane = F.lane;
    const bf16_t* P = F.P; bf16_t* X = F.X;
    if (!FLASH_NA) for (int it = gw; it < NSEQ * 12 * SEQ; it += NGW) {
        const int p = it % SEQ, h = (it / SEQ) % 12, b = it / (SEQ * 12);
        const int r = p >> 6, c = p & 63; int rs = r - 4; rs = rs < 0 ? 0 : (rs > 24 ? 24 : rs); int cs = c - 8; cs = cs < 0 ? 0 : (cs > 48 ? 48 : cs);
        const size_t row = (size_t)b * SEQ + p;
        const unsigned qw = *(const unsigned*)(P + row * INW + QA + h * 128 + 2 * lane); const float q0 = bf_lo(qw), q1 = bf_hi(qw);
        const float* rp = F.rpb + (size_t)(l * 12 + h) * 15 * 31;
        float m = -1e30f, ls = 0.f, o0 = 0.f, o1 = 0.f;
        for (int kr = rs; kr < rs + 8; ++kr)
#pragma unroll 4
          for (int kc = cs; kc < cs + 16; ++kc) {
            const size_t krow = (size_t)b * SEQ + kr * 64 + kc;
            const unsigned kw = *(const unsigned*)(P + krow * INW + KA + h * 128 + 2 * lane), vw = *(const unsigned*)(P + krow * INW + VA + h * 128 + 2 * lane);
            const float s = wave_sum(q0 * bf_lo(kw) + q1 * bf_hi(kw), lane) * 0.08838834764831845f + rp[(kr - r + 7) * 31 + (kc - c + 15)];
            const float mn = fmaxf(m, s), a = __expf(m - mn), pe = __expf(s - mn);
            ls = ls * a + pe; o0 = o0 * a + pe * bf_lo(vw); o1 = o1 * a + pe * bf_hi(vw); m = mn;
        }
        const unsigned zw = *(const unsigned*)(P + row * INW + ZA + h * 128 + 2 * lane); const float inv = 1.0f / ls;
        *(unsigned*)(X + row * DM + h * 128 + 2 * lane) = cvt_pk_bf16(o0 * inv * bf_lo(zw), o1 * inv * bf_hi(zw));
    }
    if (!FLASH_SW) for (int it = gw; it < NSEQ * 12 * SEQ; it += NGW) {
        const int p = it % SEQ, h = (it / SEQ) % 12, b = it / (SEQ * 12), kvh = h / 3;
        const size_t row = (size_t)b * SEQ + p;
        const unsigned qw = *(const unsigned*)(P + row * INW + QB + h * 128 + 2 * lane); const float q0 = bf_lo(qw), q1 = bf_hi(qw);
        float m = F.sink[l * 12 + h], ls = 1.f, o0 = 0.f, o1 = 0.f;
        const int j0 = p - 128 < 0 ? 0 : p - 128, j1 = p + 128 > SEQ - 1 ? SEQ - 1 : p + 128;
#pragma unroll 4
        for (int j = j0; j <= j1; ++j) {
            const size_t krow = (size_t)b * SEQ + j;
            const unsigned kw = *(const unsigned*)(P + krow * INW + KB + kvh * 128 + 2 * lane), vw = *(const unsigned*)(P + krow * INW + VB + kvh * 128 + 2 * lane);
            const float s = wave_sum(q0 * bf_lo(kw) + q1 * bf_hi(kw), lane) * 0.08838834764831845f + F.t5[t5_bucket(j - p) * 12 + h];
            const float mn = fmaxf(m, s), a = __expf(m - mn), pe = __expf(s - mn);
            ls = ls * a + pe; o0 = o0 * a + pe * bf_lo(vw); o1 = o1 * a + pe * bf_hi(vw); m = mn;
        }
        const unsigned zw = *(const unsigned*)(P + row * INW + ZB + h * 128 + 2 * lane); const float inv = 1.0f / ls;
        *(unsigned*)(X + row * DM + 1536 + h * 128 + 2 * lane) = cvt_pk_bf16(o0 * inv * bf_lo(zw), o1 * inv * bf_hi(zw));
    }
    const bf16_t* KV = F.KVM + (size_t)l * MROWS * KVW;
    if (!FLASH_MEM) for (int it = gw; it < NSEQ * 4 * SEQ; it += NGW) {
        const int p = it % SEQ, h = (it / SEQ) % 4, b = it / (SEQ * 4);
        const size_t row = (size_t)b * SEQ + p;
        const u32x2 qw = *(const u32x2*)(P + row * INW + QM + h * 256 + 4 * lane); const float q0 = bf_lo(qw.x), q1 = bf_hi(qw.x), q2 = bf_lo(qw.y), q3 = bf_hi(qw.y);
        float m = -1e30f, ls = 0.f, o0 = 0.f, o1 = 0.f, o2 = 0.f, o3 = 0.f;
#pragma unroll 4
        for (int j = 0; j < MEMT; ++j) {
            const size_t krow = (size_t)b * MEMT + j;
            const u32x2 kw = *(const u32x2*)(KV + krow * KVW + h * 256 + 4 * lane), vw = *(const u32x2*)(KV + krow * KVW + 1024 + h * 256 + 4 * lane);
            const float s = wave_sum((q0 * bf_lo(kw.x) + q1 * bf_hi(kw.x)) + (q2 * bf_lo(kw.y) + q3 * bf_hi(kw.y)), lane) * 0.0625f;
            const float mn = fmaxf(m, s), a = __expf(m - mn), pe = __expf(s - mn);
            ls = ls * a + pe; o0 = o0 * a + pe * bf_lo(vw.x); o1 = o1 * a + pe * bf_hi(vw.x); o2 = o2 * a + pe * bf_lo(vw.y); o3 = o3 * a + pe * bf_hi(vw.y); m = mn;
        }
        const u32x2 zw = *(const u32x2*)(P + row * INW + ZM + h * 256 + 4 * lane); const float inv = 1.0f / ls;
        u32x2 w; w.x = cvt_pk_bf16(o0 * inv * bf_lo(zw.x), o1 * inv * bf_hi(zw.x)); w.y = cvt_pk_bf16(o2 * inv * bf_lo(zw.y), o3 * inv * bf_hi(zw.y));
        *(u32x2*)(X + row * DM + 3072 + h * 256 + 4 * lane) = w;
    }
}


namespace fa {
typedef float f32x16 __attribute__((ext_vector_type(16)));
typedef short s16x4 __attribute__((ext_vector_type(4)));
constexpr int SHM_V = 16384, SHM_K = 16384;
constexpr int OFF_V = 0, OFF_K = 32768, OFF_OST = 65536  , OFF_WS = RING_BYTES + 2048, OFF_TBL = RING_BYTES + 4096, TBL_PAD = 256;
constexpr int OFF_WS_MEM = RING_BYTES + 1024, OFF_OST_MEM = RING_BYTES + 16384;
constexpr float THR2 = 11.5f;
constexpr float NEG = -1e30f;
#define FA_KSWZ(row, colB) ((row) * 256 + ((colB) ^ (((row) & 7) << 4)))
#define FA_SBAR() __builtin_amdgcn_sched_barrier(0)
__device__ __forceinline__ int crow(int r, int hi) { return (r & 3) + 8 * (r >> 2) + 4 * hi; }
__device__ __forceinline__ int v_st(int k, int c) { const int kk = (k & ~0xC) | ((k & 4) << 1) | ((k & 8) >> 1); return ((kk >> 3) * 4 + (c >> 5)) * 512 + ((kk & 7) * 32 + (c & 31)) * 2; }
__device__ __forceinline__ int v_rd_base(int lane) { return ((lane & 3) << 3) | (((lane >> 2) & 3) << 6) | (((lane >> 4) & 1) << 5) | (((lane >> 5) & 1) << 8); }
constexpr int v_rd_off(int d0, int ks, int half) { return d0 * 512 + ks * 4096 + half * 2048; }
template <int OFF> __device__ __forceinline__ s16x4 tr_read(int vb) { s16x4 r; asm volatile("ds_read_b64_tr_b16 %0, %1 offset:%2" : "=&v"(r) : "v"(vb), "i"(OFF) : "memory"); return r; }
template <int D0> __device__ __forceinline__ void pv_one(f32x16& od, int vb, bf16x8 pa0, bf16x8 pa1, bf16x8 pa2, bf16x8 pa3) {
    const s16x4 l0 = tr_read<v_rd_off(D0, 0, 0)>(vb), h0 = tr_read<v_rd_off(D0, 0, 1)>(vb), l1 = tr_read<v_rd_off(D0, 1, 0)>(vb), h1 = tr_read<v_rd_off(D0, 1, 1)>(vb);
    const s16x4 l2 = tr_read<v_rd_off(D0, 2, 0)>(vb), h2 = tr_read<v_rd_off(D0, 2, 1)>(vb), l3 = tr_read<v_rd_off(D0, 3, 0)>(vb), h3 = tr_read<v_rd_off(D0, 3, 1)>(vb);
    asm volatile("s_waitcnt lgkmcnt(0)" ::: "memory"); FA_SBAR();
#define FA_PK(L, H) (bf16x8){L[0], L[1], L[2], L[3], H[0], H[1], H[2], H[3]}
    od = __builtin_amdgcn_mfma_f32_32x32x16_bf16(pa0, FA_PK(l0, h0), od, 0, 0, 0);
    od = __builtin_amdgcn_mfma_f32_32x32x16_bf16(pa1, FA_PK(l1, h1), od, 0, 0, 0);
    od = __builtin_amdgcn_mfma_f32_32x32x16_bf16(pa2, FA_PK(l2, h2), od, 0, 0, 0);
    od = __builtin_amdgcn_mfma_f32_32x32x16_bf16(pa3, FA_PK(l3, h3), od, 0, 0, 0);
#undef FA_PK
}
__device__ __forceinline__ void pv_d0(f32x16* o, int vb, bf16x8 pa0, bf16x8 pa1, bf16x8 pa2, bf16x8 pa3) {
    pv_one<0>(o[0], vb, pa0, pa1, pa2, pa3); pv_one<1>(o[1], vb, pa0, pa1, pa2, pa3); pv_one<2>(o[2], vb, pa0, pa1, pa2, pa3); pv_one<3>(o[3], vb, pa0, pa1, pa2, pa3);
}
template <int P1T> __device__ __forceinline__ void qkt(f32x16& p0, f32x16& p1, const LAS unsigned char* Ks, const bf16x8* qr, int r32, int hi, const LAS float* tb) {
#pragma unroll
    for (int r = 0; r < 16; ++r) { const int k0 = (r & 3) + 8 * (r >> 2); p0[r] = tb[k0]; p1[r] = tb[P1T + k0]; }
#ifndef FA_KBATCH
#define FA_KBATCH 2
#endif
#pragma unroll
    for (int g = 0; g < 8 / FA_KBATCH; ++g) { bf16x8 kf0[FA_KBATCH], kf1[FA_KBATCH];
#pragma unroll
        for (int d = 0; d < FA_KBATCH; ++d) { const int cb = ((g * FA_KBATCH + d) * 16 + hi * 8) * 2; kf0[d] = *(const LAS bf16x8*)(Ks + FA_KSWZ(r32, cb)); kf1[d] = *(const LAS bf16x8*)(Ks + FA_KSWZ(32 + r32, cb)); }
        FA_SBAR();
#pragma unroll
        for (int d = 0; d < FA_KBATCH; ++d) { p0 = __builtin_amdgcn_mfma_f32_32x32x16_bf16(kf0[d], qr[g * FA_KBATCH + d], p0, 0, 0, 0); p1 = __builtin_amdgcn_mfma_f32_32x32x16_bf16(kf1[d], qr[g * FA_KBATCH + d], p1, 0, 0, 0); }
        FA_SBAR(); }
}
template <int P1V> __device__ __forceinline__ void apply_bias(f32x16& p0, f32x16& p1, int vb, unsigned vl0, unsigned vl1, float C) {
#pragma unroll
    for (int r = 0; r < 16; ++r) { const int k0 = (r & 3) + 8 * (r >> 2);
        const float x0 = p0[r] * C, x1 = p1[r] * C;
        p0[r] = ((unsigned)(vb + k0) < vl0) ? x0 : NEG; p1[r] = ((unsigned)(vb + P1V + k0) < vl1) ? x1 : NEG; }
}
__device__ __forceinline__ void partialSM(f32x16& p0, f32x16& p1, float& m_reg, float& alpha) {
    float pmax = p0[0];
#pragma unroll
    for (int r = 1; r < 16; ++r) pmax = fmaxf(pmax, p0[r]);
#pragma unroll
    for (int r = 0; r < 16; ++r) pmax = fmaxf(pmax, p1[r]);
    { auto rr = __builtin_amdgcn_permlane32_swap(__float_as_uint(pmax), __float_as_uint(pmax), false, false); pmax = fmaxf(__uint_as_float(rr[0]), __uint_as_float(rr[1])); }
    if (__builtin_expect(__all(pmax - m_reg <= THR2), 1)) { alpha = 1.f; }
    else { const float mn = fmaxf(m_reg, pmax); alpha = __builtin_amdgcn_exp2f(m_reg - mn); m_reg = mn; }
#pragma unroll
    for (int r = 0; r < 16; ++r) { p0[r] = __builtin_amdgcn_exp2f(p0[r] - m_reg); p1[r] = p1[r] - m_reg; }
}
#define FA_PK4(P, BASE, OUT) do { const unsigned a0 = cvt_pk_bf16(P[BASE + 0], P[BASE + 1]), a1 = cvt_pk_bf16(P[BASE + 2], P[BASE + 3]);   \
    const unsigned b0 = cvt_pk_bf16(P[BASE + 4], P[BASE + 5]), b1 = cvt_pk_bf16(P[BASE + 6], P[BASE + 7]);                              \
    auto r0 = __builtin_amdgcn_permlane32_swap(a0, b0, false, false); auto r1 = __builtin_amdgcn_permlane32_swap(a1, b1, false, false); \
    u32x4 w = {r0[0], r1[0], r0[1], r1[1]}; OUT = __builtin_bit_cast(bf16x8, w); } while (0)
__device__ __forceinline__ void finishSM(f32x16& p0, f32x16& p1, float alpha, float& l_reg, bf16x8& pa0, bf16x8& pa1, bf16x8& pa2, bf16x8& pa3) {
#pragma unroll
    for (int r = 0; r < 16; ++r) p1[r] = __builtin_amdgcn_exp2f(p1[r]);
    float ps = 0.f;
#pragma unroll
    for (int r = 0; r < 16; ++r) ps += p0[r];
#pragma unroll
    for (int r = 0; r < 16; ++r) ps += p1[r];
    { auto rr = __builtin_amdgcn_permlane32_swap(__float_as_uint(ps), __float_as_uint(ps), false, false); ps = __uint_as_float(rr[0]) + __uint_as_float(rr[1]); }
    l_reg = l_reg * alpha + ps;
    FA_PK4(p0, 0, pa0); FA_PK4(p0, 8, pa1); FA_PK4(p1, 0, pa2); FA_PK4(p1, 8, pa3);
}

struct FlashUnit {
    const bf16_t *Q, *K, *V, *Z; bf16_t* O;
    int NT, jlo, jhi;
    int tblo;
    float tv; int tcnt;
    int rsl;
    int lane_off, jstride, vbase, vstride; unsigned vlim;
    float m_init, l_init, C;
};
template <bool NA2>
__device__ __forceinline__ void flash_unit(LAS unsigned char* lds, const FlashUnit& U, int tid) {
    const int wid = __builtin_amdgcn_readfirstlane(tid >> 6), lane = tid & 63, r32 = lane & 31, hi = lane >> 5;
    constexpr int EHI = NA2 ? 64 : 16, KROW1 = NA2 ? 64 : 32, KTILE = NA2 ? 128 : 64, P1T = NA2 ? 31 : 32, P1V = NA2 ? 0 : 32;
    constexpr int KP = GATES_FP8 ? 128 : INW;
    const int ebase = NA2 ? wid * 128 : wid * 32;
    LAS unsigned char* V_lds = lds + OFF_V; LAS unsigned char* K_lds = lds + OFF_K;
    LAS float* wsx = (LAS float*)(lds + OFF_WS) + wid * 64; LAS float* li_l = wsx; LAS float* al_l = wsx + 32;
    const LAS float* tbl = (const LAS float*)(lds + U.tblo) + TBL_PAD + U.lane_off;
    float m_reg = U.m_init, l_reg = U.l_init; f32x16 o[4] = {}; bf16x8 qr[8];
    { const GAS char* Qw = (const GAS char*)U.Q; const unsigned qo = (unsigned)((ebase + (r32 & 15) + (r32 >> 4) * EHI) * INW + hi * 8) * 2u;
#pragma unroll
      for (int d0 = 0; d0 < 8; ++d0) qr[d0] = *(const GAS bf16x8*)(Qw + qo + d0 * 32); }
    const int sr = tid >> 4, sc = (tid & 15) * 8, vst0 = v_st(sr, sc), vst1 = v_st(32 + sr, sc), kst0 = FA_KSWZ(sr, sc * 2), kst1 = FA_KSWZ(32 + sr, sc * 2);
    const int vb0 = (int)(unsigned)(size_t)V_lds + v_rd_base(lane);
    const unsigned go0 = (unsigned)(sr * KP + sc) * 2u, go1 = (unsigned)((KROW1 + sr) * KP + sc) * 2u;
    constexpr size_t TILE_B = (size_t)KTILE * KP * 2;
    bf16x8 sv0[2], sv1[2], sk0[2], sk1[2];
#define FA_SLOAD(i, j) do { const GAS char* kt = (const GAS char*)U.K + (size_t)(j) * TILE_B; const GAS char* vt = (const GAS char*)U.V + (size_t)(j) * TILE_B; \
    sv0[i] = *(const GAS bf16x8*)(vt + go0); sv1[i] = *(const GAS bf16x8*)(vt + go1); sk0[i] = *(const GAS bf16x8*)(kt + go0); sk1[i] = *(const GAS bf16x8*)(kt + go1); } while (0)
#define FA_SWRITE(b, i) do { *(LAS bf16x8*)(V_lds + (b) * SHM_V + vst0) = sv0[i]; *(LAS bf16x8*)(V_lds + (b) * SHM_V + vst1) = sv1[i]; \
    *(LAS bf16x8*)(K_lds + (b) * SHM_K + kst0) = sk0[i]; *(LAS bf16x8*)(K_lds + (b) * SHM_K + kst1) = sk1[i]; } while (0)
    const int NT = U.NT;
    FA_SLOAD(0, 0); if (1 < NT) FA_SLOAD(1, 1);
    __builtin_amdgcn_sched_barrier(0);
    if (tid < U.tcnt) ((LAS float*)(lds + U.tblo))[TBL_PAD + tid] = U.tv * 11.313708498984761f;
#define FA_TILE(j, BUF) do { \
    FA_SWRITE(BUF, BUF); __syncthreads(); \
    if ((j) + 2 < NT) FA_SLOAD(BUF, (j) + 2); \
    if ((j) >= U.jlo && (j) < U.jhi) { f32x16 p0, p1; float alpha; bf16x8 pa0, pa1, pa2, pa3; \
        qkt<P1T>(p0, p1, K_lds + (BUF) * SHM_K, qr, r32, hi, tbl + (j) * U.jstride); \
        unsigned vl0 = U.vlim, vl1 = U.vlim; if constexpr (NA2) { vl0 = ((unsigned)(2 * (j) - U.rsl) < 8u) ? 16u : 0u; vl1 = ((unsigned)(2 * (j) + 1 - U.rsl) < 8u) ? 16u : 0u; } \
        apply_bias<P1V>(p0, p1, U.vbase + (j) * U.vstride, vl0, vl1, U.C); \
        partialSM(p0, p1, m_reg, alpha); finishSM(p0, p1, alpha, l_reg, pa0, pa1, pa2, pa3); \
        if (__any(alpha < 1.f)) { if (hi == 0) al_l[r32] = alpha; asm volatile("s_waitcnt lgkmcnt(0)" ::: "memory"); \
            _Pragma("unroll") for (int d = 0; d < 4; ++d) _Pragma("unroll") for (int r = 0; r < 16; ++r) o[d][r] *= al_l[crow(r, hi)]; } \
        pv_d0(o, vb0 + (BUF) * SHM_V, pa0, pa1, pa2, pa3); } } while (0)
    int j = 0;
    for (; j + 1 < NT; j += 2) { FA_TILE(j, 0); FA_TILE(j + 1, 1); }
    if (j < NT) FA_TILE(j, 0);
    { const GAS bf16_t* zb = (const GAS bf16_t*)U.Z + (size_t)ebase * INW; GAS bf16_t* ob = (GAS bf16_t*)U.O + (size_t)ebase * DM;
      int ln2 = lane; asm volatile("" : "+v"(ln2));
      u32x4 zv[8];
#pragma unroll
      for (int k = 0; k < 8; ++k) { const int ch = ln2 + 64 * k, row = ch >> 4, c16 = ch & 15, grow = (row & 15) + (row >> 4) * EHI; zv[k] = *(const GAS u32x4*)(zb + (size_t)grow * INW + c16 * 8); }
      if (hi == 0) li_l[r32] = l_reg; asm volatile("s_waitcnt lgkmcnt(0)" ::: "memory");
      LAS unsigned char* stg = lds + OFF_OST + wid * 8192;
#pragma unroll
      for (int r = 0; r < 16; ++r) { const int lr = crow(r, hi); const float rl = __builtin_amdgcn_rcpf(li_l[lr]);
#pragma unroll
          for (int d0 = 0; d0 < 4; ++d0) *(LAS bf16_t*)(stg + lr * 256 + (d0 * 32 + r32) * 2) = (bf16_t)f2bf(o[d0][r] * rl); }
      asm volatile("s_waitcnt lgkmcnt(0)" ::: "memory"); __builtin_amdgcn_sched_barrier(0);
#pragma unroll
      for (int k = 0; k < 8; ++k) { const int ch = ln2 + 64 * k, row = ch >> 4, c16 = ch & 15, grow = (row & 15) + (row >> 4) * EHI; const u32x4 ov = *(const LAS u32x4*)(stg + row * 256 + c16 * 16); const u32x4 z = zv[k];
          u32x4 w; w.x = cvt_pk_bf16(bf_lo(ov.x) * bf_lo(z.x), bf_hi(ov.x) * bf_hi(z.x)); w.y = cvt_pk_bf16(bf_lo(ov.y) * bf_lo(z.y), bf_hi(ov.y) * bf_hi(z.y));
          w.z = cvt_pk_bf16(bf_lo(ov.z) * bf_lo(z.z), bf_hi(ov.z) * bf_hi(z.z)); w.w = cvt_pk_bf16(bf_lo(ov.w) * bf_lo(z.w), bf_hi(ov.w) * bf_hi(z.w));
          *(GAS u32x4*)(ob + (size_t)grow * DM + c16 * 8) = w; } }
#undef FA_SLOAD
#undef FA_SWRITE
#undef FA_TILE
}

__device__ __forceinline__ void mem_unit(LAS unsigned char* lds, const bf16_t* Qb, const bf16_t* KVg, const bf16_t* Zb, bf16_t* Ob, int tid) {
    const int wid = __builtin_amdgcn_readfirstlane(tid >> 6), lane = tid & 63, r32 = lane & 31, hi = lane >> 5;
    bf16x8 kv[16];
#pragma unroll
    for (int i = 0; i < 16; ++i) { const int ch = i * 512 + tid, key = ch >> 5, c16 = ch & 31; kv[i] = *(const GAS bf16x8*)((const GAS bf16_t*)KVg + (size_t)key * KVW + c16 * 8); }
    __syncthreads();
#pragma unroll
    for (int i = 0; i < 16; ++i) { const int ch = i * 512 + tid, key = ch >> 5, c16 = ch & 31; *(LAS bf16x8*)(lds + key * 512 + ((c16 * 16) ^ ((key & 7) << 4))) = kv[i]; }
    __syncthreads();
    f32x16 p[8];
#pragma unroll
    for (int kb = 0; kb < 8; ++kb) p[kb] = (f32x16){};
    const GAS bf16_t* Qw = (const GAS bf16_t*)Qb + (size_t)(wid * 32 + r32) * INW + hi * 8;
#pragma unroll
    for (int d0 = 0; d0 < 16; ++d0) { const bf16x8 qf = *(const GAS bf16x8*)(Qw + d0 * 16); const int cb = (d0 * 32 + hi * 16) ^ ((r32 & 7) << 4);
#pragma unroll
        for (int kb = 0; kb < 8; ++kb) { const bf16x8 kf = *(const LAS bf16x8*)(lds + (kb * 32 + r32) * 512 + cb); p[kb] = __builtin_amdgcn_mfma_f32_32x32x16_bf16(kf, qf, p[kb], 0, 0, 0); } }
#pragma unroll
    for (int i = 0; i < 16; ++i) { const int ch = i * 512 + tid, key = ch >> 5, c16 = ch & 31; kv[i] = *(const GAS bf16x8*)((const GAS bf16_t*)KVg + (size_t)key * KVW + 1024 + c16 * 8); }
    constexpr float C2 = 0.0625f * LOG2E;
    float mx = p[0][0];
#pragma unroll
    for (int kb = 0; kb < 8; ++kb)
#pragma unroll
        for (int r = 0; r < 16; ++r) mx = fmaxf(mx, p[kb][r]);
    { auto rr = __builtin_amdgcn_permlane32_swap(__float_as_uint(mx), __float_as_uint(mx), false, false); mx = fmaxf(__uint_as_float(rr[0]), __uint_as_float(rr[1])); }
    const float mc = -mx * C2; float ls = 0.f;
#pragma unroll
    for (int kb = 0; kb < 8; ++kb)
#pragma unroll
        for (int r = 0; r < 16; ++r) { const float e = __builtin_amdgcn_exp2f(fmaf(p[kb][r], C2, mc)); p[kb][r] = e; ls += e; }
    { auto rr = __builtin_amdgcn_permlane32_swap(__float_as_uint(ls), __float_as_uint(ls), false, false); ls = __uint_as_float(rr[0]) + __uint_as_float(rr[1]); }
    bf16x8 pa[4][4];
#pragma unroll
    for (int g = 0; g < 4; ++g) { FA_PK4(p[2 * g], 0, pa[g][0]); FA_PK4(p[2 * g], 8, pa[g][1]); FA_PK4(p[2 * g + 1], 0, pa[g][2]); FA_PK4(p[2 * g + 1], 8, pa[g][3]); }
    __syncthreads();
#pragma unroll
    for (int i = 0; i < 16; ++i) { const int ch = i * 512 + tid, key = ch >> 5, c16 = ch & 31, d = c16 * 8;
        *(LAS bf16x8*)(lds + ((key >> 6) * 2 + (d >> 7)) * 16384 + v_st(key & 63, d & 127)) = kv[i]; }
    __syncthreads();
    const int vb0 = (int)(unsigned)(size_t)lds + v_rd_base(lane);
    LAS float* li_l = (LAS float*)(lds + OFF_WS_MEM) + wid * 32;
    if (hi == 0) li_l[r32] = ls; asm volatile("s_waitcnt lgkmcnt(0)" ::: "memory");
    LAS unsigned char* stg = lds + OFF_OST_MEM + wid * 2048;
#pragma unroll
    for (int dh = 0; dh < 2; ++dh) {
        int ln2 = lane; asm volatile("" : "+v"(ln2));
        const GAS bf16_t* zb = (const GAS bf16_t*)Zb + (size_t)(wid * 32) * INW + dh * 128; GAS bf16_t* ob = (GAS bf16_t*)Ob + (size_t)(wid * 32) * DM + dh * 128;
        u32x4 zv[8];
#pragma unroll
        for (int k = 0; k < 8; ++k) { const int ch = ln2 + 64 * k, row = ch >> 4, c16 = ch & 15; zv[k] = *(const GAS u32x4*)(zb + (size_t)row * INW + c16 * 8); }
        f32x16 o[4] = {};
#pragma unroll
        for (int g = 0; g < 4; ++g) pv_d0(o, vb0 + (g * 2 + dh) * 16384, pa[g][0], pa[g][1], pa[g][2], pa[g][3]);
#pragma unroll
        for (int p = 0; p < 4; ++p) {
#pragma unroll
            for (int q = 0; q < 4; ++q) { const int r = 4 * p + q, lr8 = q + 4 * hi; const float rl = __builtin_amdgcn_rcpf(li_l[8 * p + lr8]);
#pragma unroll
                for (int d0 = 0; d0 < 4; ++d0) *(LAS bf16_t*)(stg + lr8 * 256 + (d0 * 32 + r32) * 2) = (bf16_t)f2bf(o[d0][r] * rl); }
            asm volatile("s_waitcnt lgkmcnt(0)" ::: "memory");
#pragma unroll
            for (int k = 0; k < 2; ++k) { const int ch = ln2 + 64 * k, row8 = ch >> 4, c16 = ch & 15; const u32x4 ov = *(const LAS u32x4*)(stg + row8 * 256 + c16 * 16); const u32x4 z = zv[2 * p + k];
                u32x4 w; w.x = cvt_pk_bf16(bf_lo(ov.x) * bf_lo(z.x), bf_hi(ov.x) * bf_hi(z.x)); w.y = cvt_pk_bf16(bf_lo(ov.y) * bf_lo(z.y), bf_hi(ov.y) * bf_hi(z.y));
                w.z = cvt_pk_bf16(bf_lo(ov.z) * bf_lo(z.z), bf_hi(ov.z) * bf_hi(z.z)); w.w = cvt_pk_bf16(bf_lo(ov.w) * bf_lo(z.w), bf_hi(ov.w) * bf_hi(z.w));
                *(GAS u32x4*)(ob + (size_t)(8 * p + row8) * DM + c16 * 8) = w; }
            asm volatile("s_waitcnt lgkmcnt(0)" ::: "memory");
        }
    }
}
}

#ifndef FLASH_NA
#define FLASH_NA 1
#endif
#ifndef FLASH_SW
#define FLASH_SW 1
#endif
#ifndef FLASH_MEM
#define FLASH_MEM 1
#endif
__device__ __forceinline__ void attention_phase(Frame& F, int l, int mask = 7) {
    LAS unsigned char* lds = F.lds; const int tid = F.tid, G = F.G;
    int tpar = 0;
    const int wid = F.wave;
    if (FLASH_NA && (mask & 1)) for (int i = 0;; ++i) {
        const int u = i * G + F.vcu; if (u >= 1152) break;
        const int bh = u >> 3, blk = u & 7, b = bh / 12, h = bh % 12;
        const int ln = lane_id_hw(), r32 = ln & 31, hi = ln >> 5;
        fa::FlashUnit U; U.C = 0.08838834764831845f * LOG2E; U.tblo = fa::OFF_TBL + tpar * 4096; tpar ^= 1;
        const int rb = blk >> 2, cb = blk & 3, lo = rb ? 12 : 0; U.NT = 10;
        int c0 = 16 * cb - 8; c0 = c0 < 0 ? 0 : (c0 > 32 ? 32 : c0);
        const size_t tok0 = (size_t)b * SEQ + rb * 1024 + cb * 16;
        const int qr = 16 * rb + 2 * wid + (r32 >> 4), qc = 16 * cb + (r32 & 15);
        int rs = qr - 4; rs = rs < 0 ? 0 : (rs > 24 ? 24 : rs); int cs = qc - 8; cs = cs < 0 ? 0 : (cs > 48 ? 48 : cs);
        int rsA = 16 * rb + 2 * wid - 4; rsA = rsA < 0 ? 0 : (rsA > 24 ? 24 : rsA); int rsB = 16 * rb + 2 * wid - 3; rsB = rsB < 0 ? 0 : (rsB > 24 ? 24 : rsB);
        U.Q = F.P + tok0 * INW + QA + h * 128; if (GATES_FP8) { const size_t ko = ((size_t)(b * 12 + h) * SEQ + lo * 64 + c0) * 128; U.K = (const bf16_t*)(F.ws + WS_KNA) + ko; U.V = (const bf16_t*)(F.ws + WS_VNA) + ko; }
        else { U.K = F.P + ((size_t)b * SEQ + lo * 64 + c0) * INW + KA + h * 128; U.V = U.K + (VA - KA); } U.Z = F.P + tok0 * INW + ZA + h * 128; U.O = F.X + tok0 * DM + h * 128;
        U.jlo = (rsA - lo) >> 1; U.jhi = ((rsB + 7 - lo) >> 1) + 1; U.rsl = rs - lo;
        U.lane_off = (lo - qr + 7) * 31 + (c0 - qc + 15) + 4 * hi; U.jstride = 62; U.vbase = c0 - cs + 4 * hi; U.vstride = 0; U.vlim = 16u;
        U.m_init = -30000.f; U.l_init = 0.f;
        const float* rp = F.rpb + (size_t)(l * 12 + h) * 465;
        { const int k = wid * 64 + ln; U.tcnt = 465; U.tv = (k < 465) ? ((const GAS float*)rp)[k] : 0.f; }
        if (mask & 8) U.jhi = U.jlo;
        fa::flash_unit<true>(lds, U, wid * 64 + ln);
    }
    if (FLASH_SW && (mask & 2)) for (int i = 0;; ++i) {
        int u = i * G + F.vcu; if (u >= 1152) break;
        int bh, blk;
        if (u < 864) { bh = u / 6; blk = 1 + u % 6; } else { u -= 864; bh = u >> 1; blk = (u & 1) * 7; }
        const int b = bh / 12, h = bh % 12;
        const int ln = lane_id_hw(), r32 = ln & 31, hi = ln >> 5;
        fa::FlashUnit U; U.C = 0.08838834764831845f * LOG2E; U.tblo = fa::OFF_TBL + tpar * 4096; tpar ^= 1; const size_t row0 = (size_t)b * SEQ + blk * 256;
        const int t0 = 256 * blk, kt0 = (blk == 0) ? 0 : t0 - 128; U.NT = (blk == 0 || blk == 7) ? 6 : 8;
        const int tq = t0 + 32 * wid + r32;
        U.Q = F.P + row0 * INW + QB + h * 128; if (GATES_FP8) { const size_t ko = ((size_t)(b * 4 + h / 3) * SEQ + kt0) * 128; U.K = (const bf16_t*)(F.ws + WS_KSW) + ko; U.V = (const bf16_t*)(F.ws + WS_VSW) + ko; }
        else { U.K = F.P + ((size_t)b * SEQ + kt0) * INW + KB + (h / 3) * 128; U.V = U.K + (VB - KB); } U.Z = F.P + row0 * INW + ZB + h * 128; U.O = F.X + row0 * DM + 1536 + h * 128;
        const int a = t0 + 32 * wid - 128 - kt0, bnd = t0 + 32 * wid + 159 - kt0; U.jlo = a <= 0 ? 0 : (a >> 6); { const int jh = (bnd >> 6) + 1; U.jhi = jh < U.NT ? jh : U.NT; }
        U.lane_off = kt0 - tq + 128 + 4 * hi; U.jstride = 64; U.vbase = U.lane_off; U.vstride = 64; U.vlim = 257u;
        U.m_init = F.sink[l * 12 + h] * LOG2E; U.l_init = 1.f; U.rsl = 0;
        { const int k = wid * 64 + ln; U.tcnt = 257; U.tv = (k < 257) ? ((const GAS float*)F.t5)[t5_bucket(k - 128) * 12 + h] : 0.f; }
        if (mask & 8) U.jhi = U.jlo;
        fa::flash_unit<false>(lds, U, wid * 64 + ln);
    }
    __syncthreads();
#if FLASH_MEM
    const bf16_t* KV = F.KVM + (size_t)l * MROWS * KVW;
    if (mask & 4) for (int i = 0;; ++i) {
        const int u = i * G + (G - 1 - F.vcu); if (u >= 384) break;
        const int bh = u >> 3, qb = u & 7, b = bh >> 2, h = bh & 3; const size_t row0 = (size_t)b * SEQ + qb * 256;
        fa::mem_unit(lds, F.P + row0 * INW + QM + h * 256, KV + (size_t)b * MEMT * KVW + h * 256, F.P + row0 * INW + ZM + h * 256, F.X + row0 * DM + 3072 + h * 256, F.wave * 64 + lane_id_hw());
    }
    __syncthreads();
#endif
}

__device__ __forceinline__ const float* x_row(const Frame& F, int m) { return m < TP ? F.xp + (size_t)m * DM : F.xs + (size_t)(m - TP) * DM; }

__device__ __forceinline__ void p0_prologue(Frame& F) {
    LAS float* scr = (LAS float*)(F.lds + F.wave * 16384);
    const int gw = F.vcu * NWAVES + F.wave, NGW = F.G * NWAVES;
    constexpr int I_IN = (DM / 64) * (INW / 32), I_KV = (DM / 64) * (KVW / 32), I_A = (1536 / 64) * (DM / 32), I_M = (1024 / 64) * (DM / 32), I_O = (DM / 64) * (DM / 32);
    constexpr int PER_L = I_IN + I_KV + 2 * I_A + I_M + I_O;
    auto decode = [&](int it, TItem& t) {
        const int l = it / PER_L; int r = it - l * PER_L; t.gain = nullptr; t.W8 = nullptr; t.n8 = 0; t.koff = 0; t.ldwt = DM;
        if (r < I_IN) { t.W = F.w_in + (size_t)l * DM * INW; t.N = INW; t.WT = F.WinT + (size_t)l * INW * DM; t.W8 = GATES_FP8 ? F.W8 + (size_t)l * NGATE * DM : nullptr; t.n8 = GA; t.item = r; return; } r -= I_IN;
        if (r < I_KV) { t.W = F.w_kv + (size_t)l * DM * KVW; t.N = KVW; t.WT = F.WkvT + (size_t)l * KVW * DM; t.gain = F.mem_norm + l * DM; t.item = r; return; } r -= I_KV;
        bf16_t* wc = F.WcatT + (size_t)l * DM * DM; t.N = DM; t.WT = wc;
        if (r < I_A) { t.W = F.w_a + (size_t)l * 1536 * DM; t.item = r; return; } r -= I_A;
        if (r < I_A) { t.W = F.w_b + (size_t)l * 1536 * DM; t.koff = 1536; t.item = r; return; } r -= I_A;
        if (r < I_M) { t.W = F.w_m + (size_t)l * 1024 * DM; t.koff = 3072; t.item = r; return; } r -= I_M;
        t.W = F.w_out + (size_t)l * DM * DM; t.WT = F.WoutT + (size_t)l * DM * DM; t.item = r; };
    { constexpr int TOT = DEPTH * PER_L; int it = gw; TItem A, B; float va[32], vb[32];
      if (it < TOT) { decode(it, A); titem_load(A, va, F.lane);
        for (;;) {
            bool hn = it + NGW < TOT; if (hn) { decode(it + NGW, B); titem_load(B, vb, F.lane); }
            titem_finish(A, va, scr, F.lane); if (!hn) break; it += NGW;
            hn = it + NGW < TOT; if (hn) { decode(it + NGW, A); titem_load(A, va, F.lane); }
            titem_finish(B, vb, scr, F.lane); if (!hn) break; it += NGW; } } }
    { f32x4 gv[16], va[16], vb[16]; const int lane = F.lane;
#pragma unroll
      for (int j = 0; j < 16; ++j) gv[j] = ((const GAS f32x4*)F.pre_norm)[lane + 64 * j];
      int m = gw;
      if (m < T) { rms_row_load(va, x_row(F, m), lane);
        for (;;) {
            bool hn = m + NGW < T; if (hn) rms_row_load(vb, x_row(F, m + NGW), lane);
            rms_row_finish(va, gv, F.H + (size_t)m * DM, GATES_FP8 ? F.H8 + (size_t)m * DM : nullptr, lane); if (!hn) break; m += NGW;
            hn = m + NGW < T; if (hn) rms_row_load(va, x_row(F, m + NGW), lane);
            rms_row_finish(vb, gv, F.H + (size_t)m * DM, GATES_FP8 ? F.H8 + (size_t)m * DM : nullptr, lane); if (!hn) break; m += NGW; } } }
    for (int m = gw; m < MROWS; m += NGW) rms_row_to_bf16(m < 4 * MEMT ? F.memp + (size_t)m * DM : F.mems + (size_t)(m - 4 * MEMT) * DM, nullptr, F.MEMH + (size_t)m * DM, F.lane);
}
__device__ __forceinline__ void pnl_load(const Frame& F, int m, int lane, u32x2 (&xw)[16], u32x2 (&ov)[16]) {
    const GAS u32x2* x1row = (const GAS u32x2*)(F.P + (size_t)m * INW + 18432) + lane; const GAS u32x2* orow = (const GAS u32x2*)(F.X + (size_t)m * DM) + lane;
#pragma unroll
    for (int j = 0; j < 16; ++j) { xw[j] = x1row[64 * j]; ov[j] = orow[64 * j]; }
}
__device__ __forceinline__ void pnl_finish(const Frame& F, int m, int lane, const u32x2 (&xw)[16], const u32x2 (&ov)[16], const f32x4 (&gv)[16]) {
    GAS f32x4* yo = (GAS f32x4*)(F.out + (size_t)m * DM) + lane;
    const float ss = wave_sum(F.RSQ[(size_t)m * 64 + lane], lane);
    const float r = 1.0f / sqrtf(ss * (1.0f / DM) + RMS_EPS);
#pragma unroll
    for (int j = 0; j < 16; ++j) { const u32x2 x = xw[j], ow = ov[j]; const f32x4 g = gv[j];
        f32x4 y; y.x = bf_lo(x.x) + bf_lo(ow.x) * r * g.x; y.y = bf_hi(x.x) + bf_hi(ow.x) * r * g.y; y.z = bf_lo(x.y) + bf_lo(ow.y) * r * g.z; y.w = bf_hi(x.y) + bf_hi(ow.y) * r * g.w;
        yo[64 * j] = y; }
}
__device__ __forceinline__ void post_norm_phase(Frame& F, int l) {
    const int gw = F.vcu * NWAVES + F.wave, NGW = F.G * NWAVES, lane = F.lane;
    const float* pg = F.post_norm + l * DM; const float* npre = (l + 1 < DEPTH) ? F.pre_norm + (l + 1) * DM : nullptr;
    if (l > 0 && !npre) {
        f32x4 gv[16]; u32x2 xa[16], oa[16], xb[16], ob[16];
#pragma unroll
        for (int j = 0; j < 16; ++j) gv[j] = ((const GAS f32x4*)pg)[lane + 64 * j];
        int m = gw; if (m >= T) return;
        pnl_load(F, m, lane, xa, oa);
        for (;;) {
            bool hn = m + NGW < T; if (hn) pnl_load(F, m + NGW, lane, xb, ob);
            pnl_finish(F, m, lane, xa, oa, gv); if (!hn) break; m += NGW;
            hn = m + NGW < T; if (hn) pnl_load(F, m + NGW, lane, xa, oa);
            pnl_finish(F, m, lane, xb, ob, gv); if (!hn) break; m += NGW; }
        return; }
    for (int m = gw; m < T; m += NGW) {
        const GAS u32x2* orow = (const GAS u32x2*)(F.X + (size_t)m * DM) + lane;
        GAS u32x2* x1row = (GAS u32x2*)(F.P + (size_t)m * INW + 18432) + lane;
        GAS f32x4* yo = (GAS f32x4*)(F.out + (size_t)m * DM) + lane;
        f32x4 v[16]; u32x2 ov[16]; float s2 = 0.f;
        if (l == 0) { const GAS f32x4* xr = (const GAS f32x4*)x_row(F, m) + lane;
#pragma unroll
            for (int j = 0; j < 16; ++j) { v[j] = xr[64 * j]; ov[j] = orow[64 * j]; } }
        else {
#pragma unroll
            for (int j = 0; j < 16; ++j) { const u32x2 xw = x1row[64 * j]; ov[j] = orow[64 * j]; v[j].x = bf_lo(xw.x); v[j].y = bf_hi(xw.x); v[j].z = bf_lo(xw.y); v[j].w = bf_hi(xw.y); } }
        f32x4 gv[16];
#pragma unroll
        for (int j = 0; j < 16; ++j) gv[j] = ((const GAS f32x4*)pg)[lane + 64 * j];
        __builtin_amdgcn_sched_barrier(0);
        const float ss = wave_sum(F.RSQ[(size_t)m * 64 + lane], lane);
        const float r = 1.0f / sqrtf(ss * (1.0f / DM) + RMS_EPS);
#pragma unroll
        for (int j = 0; j < 16; ++j) { const f32x4 x = v[j]; const u32x2 ow = ov[j]; const f32x4 g = gv[j];
            f32x4 y; y.x = x.x + bf_lo(ow.x) * r * g.x; y.y = x.y + bf_hi(ow.x) * r * g.y; y.z = x.z + bf_lo(ow.y) * r * g.z; y.w = x.w + bf_hi(ow.y) * r * g.w;
            v[j] = y; s2 += (y.x * y.x + y.y * y.y) + (y.z * y.z + y.w * y.w);
            if (npre) { u32x2 w; w.x = cvt_pk_bf16(y.x, y.y); w.y = cvt_pk_bf16(y.z, y.w); x1row[64 * j] = w; } else yo[64 * j] = y; }
        if (npre) {
#pragma unroll
            for (int j = 0; j < 16; ++j) gv[j] = ((const GAS f32x4*)npre)[lane + 64 * j];
            __builtin_amdgcn_sched_barrier(0);
            const float r2 = 1.0f / sqrtf(wave_sum(s2, lane) * (1.0f / DM) + RMS_EPS);
            GAS u32x2* h8 = (GAS u32x2*)(F.H + (size_t)m * DM) + lane;
#pragma unroll
            for (int j = 0; j < 16; ++j) { const f32x4 g = gv[j];
                const float y0 = v[j].x * r2 * g.x, y1 = v[j].y * r2 * g.y, y2 = v[j].z * r2 * g.z, y3 = v[j].w * r2 * g.w;
                u32x2 w; w.x = cvt_pk_bf16(y0, y1); w.y = cvt_pk_bf16(y2, y3); h8[64 * j] = w;
                if (GATES_FP8) ((GAS unsigned*)(F.H8 + (size_t)m * DM))[lane + 64 * j] = pk4_fp8(y0 * H8_SCALE, y1 * H8_SCALE, y2 * H8_SCALE, y3 * H8_SCALE); }
        }
    }
}

constexpr int N_PHASES = 1 + 5 * DEPTH;
__global__ void __launch_bounds__(NWAVES * 64, 2) fwd(Args args) {
    extern __shared__ __attribute__((aligned(16))) unsigned char lds_raw[];
    LAS unsigned char* lds = (LAS unsigned char*)lds_raw;
    const int wave_s = __builtin_amdgcn_readfirstlane((int)threadIdx.x >> 6);
    for (int u = wave_s * 64 + lane_id_hw(); u < (LDS_BYTES - LDSCTL_OFF) / 4; u += NWAVES * 64) ((LAS unsigned*)(lds + LDSCTL_OFF))[u] = 0u;
    __syncthreads();
    unsigned* const barw = (unsigned*)(args.ws + WS_CTL) + CW_BAR;
    XcdBarrier bar; bar.bar = barw; bar.x = 0; bar.st = nullptr;
    if (MK_ONE_LAUNCH) bar = xcd_barrier_post(barw, (volatile LAS unsigned*)(lds + MISC_OFF) + 8, wave_s == 0 && lane_id_hw() == 0);
    const int lo = args.ph_lo, hi = args.ph_hi;
#define IN(k) (lo <= (k) && (k) < hi)
#define SEAM(k) do { if (IN(k) && IN((k) + 1)) xcd_barrier(bar, wave_s == 0 && lane_id_hw() == 0); } while (0)

    const int probe_phase = args.probe_phase, n_iter = DEPTH + args.probe_reps;
    if (IN(0)) { Frame F; make_frame(F, lds, wave_s); p0_prologue(F); SEAM(0); }
    for (int it = 0; it < n_iter; ++it) {
        const bool probing = it >= DEPTH; const int l = probing ? ((it - DEPTH) & 1) : it;
        const int pb = 1 + 5 * l;
        if (probing && it == DEPTH) xcd_barrier(bar, wave_s == 0 && lane_id_hw() == 0);
#define RUN(k) (probing ? (probe_phase == (k)) : IN(pb + (k) - 1))
#define SEAM2(k) do { if (probing || (IN(pb + (k) - 1) && IN(pb + (k)))) xcd_barrier(bar, wave_s == 0 && lane_id_hw() == 0); } while (0)
        if (RUN(1)) {
            Frame F; make_frame(F, lds, wave_s);
            SchedIn S; S.G = F.G; S.c = (int)blockIdx.x; S.nextra = (l == 0) ? 2 * 96 : 0; S.A = (unsigned)WS_H; S.B = (unsigned)(WS_WIN + (size_t)l * INW * DM * 2);
            S.memA = (unsigned)WS_MEMH; S.memB0 = (unsigned)WS_WKV; S.memB1 = (unsigned)(WS_WKV + (size_t)KVW * DM * 2);
            EpiIn E{F.P, F.KVM, F.KVM + (size_t)MROWS * KVW, (bf16_t*)F.ws};
            pg8::gemm_phase<EpiIn, SchedIn>(lds, (const char*)F.ws, S, E, wave_s);
            SEAM2(1);
        }
        if (RUN(2)) { Frame F; make_frame(F, lds, wave_s); attention_phase(F, l); if (!(FLASH_NA && FLASH_SW && FLASH_MEM)) naive_attention(F, l); if (!GATES_FP8) SEAM2(2); }
        if (GATES_FP8 && RUN(2)) {
            Frame F; make_frame(F, lds, wave_s);
            SchedIn8 S8; S8.G = F.G; S8.c = (int)blockIdx.x; S8.A = (unsigned)WS_H8; S8.B = (unsigned)(WS_W8 + (size_t)l * NGATE * DM);
            EpiIn8 E8{F.P};
            pg8::gemm_phase<EpiIn8, SchedIn8, 4096, true>(lds, (const char*)F.ws, S8, E8, wave_s);
            SEAM2(2);
        }
        if (probing && probe_phase >= 6) { Frame F; make_frame(F, lds, wave_s); attention_phase(F, l, probe_phase == 6 ? 1 : probe_phase == 7 ? 2 : probe_phase == 8 ? 4 : probe_phase == 9 ? 9 : 10); xcd_barrier(bar, wave_s == 0 && lane_id_hw() == 0); }
        if (RUN(3)) {
            Frame F; make_frame(F, lds, wave_s);
            SchedBr S; S.G = F.G; S.c = (int)blockIdx.x; S.A = (unsigned)WS_X; S.B = (unsigned)(WS_WCAT + (size_t)l * DM * DM * 2);
            EpiBr E{F.P, F.H};
            pg8::gemm_phase<EpiBr, SchedBr>(lds, (const char*)F.ws, S, E, wave_s);
            SEAM2(3);
        }
        if (RUN(4)) {
            Frame F; make_frame(F, lds, wave_s);
            SchedOut S; S.G = F.G; S.c = (int)blockIdx.x; S.A = (unsigned)WS_H; S.B = (unsigned)(WS_WOUT + (size_t)l * DM * DM * 2);
            EpiOut E{F.X, F.RSQ};
            pg8::gemm_phase<EpiOut, SchedOut>(lds, (const char*)F.ws, S, E, wave_s);
            SEAM2(4);
        }
        if (RUN(5)) { Frame F; make_frame(F, lds, wave_s); if (probing) F.out = (float*)F.P; post_norm_phase(F, probing ? 0 : l); SEAM2(5); }
#undef RUN
#undef SEAM2
    }
#undef IN
#undef SEAM
}

extern "C" void kernel_launch(void* const* d_in, const int* in_sizes, int n_in, void* d_out, int out_size, void* d_ws, size_t ws_size, hipStream_t stream) {
    static int grid = 0;
    if (grid == 0) {
        if (n_in != 16 || in_sizes[0] != TP * DM || in_sizes[1] != (T - TP) * DM || out_size != T * DM || ws_size < WS_END) {
            fprintf(stderr, "kernel_launch: shape mismatch (n_in %d, in0 %d, in1 %d, out %d, ws %zu need %zu); nothing launched\n", n_in, n_in > 0 ? in_sizes[0] : -1, n_in > 1 ? in_sizes[1] : -1, out_size, ws_size, (size_t)WS_END); grid = -1; return; }
        int dev = 0, cus = 0, per_cu = 0;
        if (hipGetDevice(&dev) != hipSuccess || hipDeviceGetAttribute(&cus, hipDeviceAttributeMultiprocessorCount, dev) != hipSuccess) { grid = -1; return; }
        if (hipFuncSetAttribute((const void*)fwd, hipFuncAttributeMaxDynamicSharedMemorySize, LDS_BYTES) != hipSuccess) { fprintf(stderr, "kernel_launch: hipFuncSetAttribute failed\n"); grid = -1; return; }
        if (hipOccupancyMaxActiveBlocksPerMultiprocessor(&per_cu, (const void*)fwd, NWAVES * 64, LDS_BYTES) != hipSuccess || per_cu < 1)
            fprintf(stderr, "kernel_launch: note: occupancy query reports %d workgroups per CU\n", per_cu);
        (void)hipGetLastError();
        grid = cus;
    }
    if (grid < 0) return;
    if (hipMemsetAsync((char*)d_ws + WS_CTL, 0, CTL_ZERO_BYTES, stream) != hipSuccess) { fprintf(stderr, "kernel_launch: memset failed\n"); return; }
    Args a{};
    for (int i = 0; i < 16; ++i) a.in[i] = (const float*)d_in[i];
    a.out = (float*)d_out; a.ws = (unsigned char*)d_ws; a.probe_phase = PROBE_PHASE; a.probe_reps = PROBE_REPS;
#if MK_ONE_LAUNCH
    a.ph_lo = 0; a.ph_hi = N_PHASES;
    hipLaunchKernelGGL(fwd, dim3(grid), dim3(NWAVES * 64), LDS_BYTES, stream, a);
#else
    for (int p = 0; p < N_PHASES; ++p) { a.ph_lo = p; a.ph_hi = p + 1; hipLaunchKernelGGL(fwd, dim3(grid), dim3(NWAVES * 64), LDS_BYTES, stream, a); }
#endif
    const hipError_t le = hipPeekAtLastError();
    if (le != hipSuccess) fprintf(stderr, "kernel_launch: launch failed: %s\n", hipGetErrorName(le));
}
```
